# Optimizing an MI355X kernel written in HIP

```python
import jax, jax.numpy as jnp
from jax import lax
import numpy as np

D_MODEL = 1024
BATCH = 4
SEQ = 8192
DEPTH = 4

N_HEADS = 16
N_KV_HEADS = 2
HEAD_DIM = 64
GROUP = N_HEADS // N_KV_HEADS
ROT_DIM = HEAD_DIM // 4
ROPE_THETA = 500000.0
WINDOW = 128
BLOCK = 128
CONV_CH = D_MODEL // 2
CONV_WIDTH = 31
D_FF = -(-(8 * D_MODEL) // (3 * 256)) * 256
EPS = 1e-6
Q_W = N_HEADS * HEAD_DIM
KV_W = N_KV_HEADS * HEAD_DIM
IN_W = Q_W + 2 * KV_W + 2 * CONV_CH + 2 * D_MODEL
SPLITS = tuple(int(s) for s in np.cumsum([Q_W, KV_W, KV_W, CONV_CH, CONV_CH, D_MODEL])[:])

kernel_name = "hybrid_swa_sink_conformer_gated"


def rmsnorm(x, g):
    xf = x.astype(jnp.float32)
    y = xf * lax.rsqrt(jnp.mean(xf * xf, axis=-1, keepdims=True) + EPS)
    return (y * g.astype(jnp.float32)).astype(x.dtype)


def layernorm(x, g, b):
    xf = x.astype(jnp.float32)
    mu = jnp.mean(xf, axis=-1, keepdims=True)
    var = jnp.mean(jnp.square(xf - mu), axis=-1, keepdims=True)
    y = (xf - mu) * lax.rsqrt(var + EPS)
    return (y * g.astype(jnp.float32) + b.astype(jnp.float32)).astype(x.dtype)


def rope_tables(seq):
    inv_freq = ROPE_THETA ** (-jnp.arange(0, ROT_DIM, 2, dtype=jnp.float32) / ROT_DIM)
    ang = jnp.arange(seq, dtype=jnp.float32)[:, None] * inv_freq[None, :]
    return jnp.cos(ang), jnp.sin(ang)


def partial_rope(x, cos, sin):
    half = ROT_DIM // 2
    c = cos[None, :, None, :].astype(x.dtype)
    s = sin[None, :, None, :].astype(x.dtype)
    x1, x2, xp = x[..., :half], x[..., half:ROT_DIM], x[..., ROT_DIM:]
    return jnp.concatenate([x1 * c - x2 * s, x2 * c + x1 * s, xp], axis=-1)


def sliding_window_attention(q, k, v, sinks):
    B, T = q.shape[0], q.shape[1]
    nb = T // BLOCK
    qb = q.reshape(B, nb, BLOCK, N_KV_HEADS, GROUP, HEAD_DIM)

    def band(t):
        tp = jnp.pad(t, ((0, 0), (BLOCK, 0), (0, 0), (0, 0)))
        tp = tp.reshape(B, nb + 1, BLOCK, N_KV_HEADS, HEAD_DIM)
        return jnp.concatenate([tp[:, :-1], tp[:, 1:]], axis=2)

    kb, vb = band(k), band(v)
    scale = HEAD_DIM ** -0.5
    s = jnp.einsum('bnqkgd,bnskd->bnkgqs', qb, kb,
                   preferred_element_type=jnp.float32) * scale
    qi = jnp.arange(BLOCK)[:, None]
    sj = jnp.arange(2 * BLOCK)[None, :]
    rel = qi + BLOCK - sj
    kpos = jnp.arange(nb)[:, None, None] * BLOCK - BLOCK + sj
    mask = (rel >= 0) & (rel < WINDOW) & (kpos >= 0)
    s = jnp.where(mask[None, :, None, None], s, -jnp.inf)
    sink = sinks.astype(jnp.float32).reshape(N_KV_HEADS, GROUP)[None, None, :, :, None, None]
    m = jnp.maximum(jnp.max(s, axis=-1, keepdims=True), sink)
    p = jnp.exp(s - m)
    p = p / (jnp.sum(p, axis=-1, keepdims=True) + jnp.exp(sink - m))
    o = jnp.einsum('bnkgqs,bnskd->bnqkgd', p.astype(v.dtype), vb)
    return o.reshape(B, T, N_HEADS * HEAD_DIM)


def conformer_conv(u, ug, w_dw, b_dw, ln_g, ln_b, w_pw):
    a = u * jax.nn.sigmoid(ug)
    y = lax.conv_general_dilated(
        a, w_dw[:, None, :].astype(a.dtype), window_strides=(1,),
        padding=[(CONV_WIDTH - 1, 0)],
        dimension_numbers=('NWC', 'WIO', 'NWC'),
        feature_group_count=CONV_CH) + b_dw.astype(a.dtype)
    y = layernorm(y, ln_g, ln_b)
    y = jax.nn.silu(y)
    return jnp.einsum('btc,cd->btd', y, w_pw)


def setup_inputs(seed: int = 0) -> dict:
    key = jax.random.key(seed)
    ks = jax.random.split(key, 16)
    f32 = jnp.float32

    def nrm(k, shape, scale):
        return jax.random.normal(k, shape, f32) * scale

    return {
        "x": nrm(ks[0], (BATCH, SEQ, D_MODEL), 1.0),
        "norm_mix": 1.0 + nrm(ks[1], (DEPTH, D_MODEL), 0.02),
        "w_in": nrm(ks[2], (DEPTH, D_MODEL, IN_W), D_MODEL ** -0.5),
        "q_norm": 1.0 + nrm(ks[3], (DEPTH, HEAD_DIM), 0.02),
        "k_norm": 1.0 + nrm(ks[4], (DEPTH, HEAD_DIM), 0.02),
        "sinks": nrm(ks[5], (DEPTH, N_HEADS), 0.5),
        "conv_w": nrm(ks[6], (DEPTH, CONV_WIDTH, CONV_CH), CONV_WIDTH ** -0.5),
        "conv_b": nrm(ks[7], (DEPTH, CONV_CH), 0.02),
        "conv_ln_g": 1.0 + nrm(ks[8], (DEPTH, CONV_CH), 0.02),
        "conv_ln_b": nrm(ks[9], (DEPTH, CONV_CH), 0.02),
        "w_conv_out": nrm(ks[10], (DEPTH, CONV_CH, D_MODEL), CONV_CH ** -0.5),
        "w_out": nrm(ks[11], (DEPTH, D_MODEL, D_MODEL), D_MODEL ** -0.5),
        "norm_ffn": 1.0 + nrm(ks[12], (DEPTH, D_MODEL), 0.02),
        "w_gate_up": nrm(ks[13], (DEPTH, D_MODEL, 2 * D_FF), D_MODEL ** -0.5),
        "w_down": nrm(ks[14], (DEPTH, D_FF, D_MODEL), D_FF ** -0.5),
    }


def reference(x, norm_mix, w_in, q_norm, k_norm, sinks, conv_w, conv_b, conv_ln_g,
              conv_ln_b, w_conv_out, w_out, norm_ffn, w_gate_up, w_down):
    B, T = x.shape[0], x.shape[1]
    cos, sin = rope_tables(T)
    for l in range(DEPTH):
        h = rmsnorm(x, norm_mix[l])
        proj = jnp.einsum('btd,de->bte', h, w_in[l])
        q, k, v, u, ug, ga, gb = jnp.split(proj, SPLITS, axis=-1)
        q = q.reshape(B, T, N_HEADS, HEAD_DIM)
        k = k.reshape(B, T, N_KV_HEADS, HEAD_DIM)
        v = v.reshape(B, T, N_KV_HEADS, HEAD_DIM)
        q = partial_rope(rmsnorm(q, q_norm[l]), cos, sin)
        k = partial_rope(rmsnorm(k, k_norm[l]), cos, sin)
        a_out = sliding_window_attention(q, k, v, sinks[l])
        c_out = conformer_conv(u, ug, conv_w[l], conv_b[l], conv_ln_g[l],
                               conv_ln_b[l], w_conv_out[l])
        merged = jax.nn.sigmoid(ga) * a_out + jax.nn.sigmoid(gb) * c_out
        x = x + jnp.einsum('btd,de->bte', merged, w_out[l])
        h2 = rmsnorm(x, norm_ffn[l])
        gu = jnp.einsum('btd,df->btf', h2, w_gate_up[l])
        g, up = jnp.split(gu, 2, axis=-1)
        x = x + jnp.einsum('btf,fd->btd', jax.nn.silu(g) * up, w_down[l])
    return x
```

```cpp
#include <hip/hip_runtime.h>
#include <hip/hip_cooperative_groups.h>
#include <cstdio>
#include <cstdint>
namespace cg = cooperative_groups;
namespace pg8 {
#define PG8_LAS __attribute__((address_space(3)))
typedef unsigned short bf16_t;
typedef short bf16x8 __attribute__((ext_vector_type(8)));
typedef float f32x4 __attribute__((ext_vector_type(4)));
typedef unsigned u32x4 __attribute__((ext_vector_type(4)));
constexpr int BM = 256, BK = 64, HALF = 128, HTB = HALF * BK * 2  , STAGE_BYTES = 8 * HTB, NXCD = 8, WGM = 8;

__host__ __device__ __forceinline__ int lds_byte(int r, int c) { const int st = (r >> 4) * 2 + (c >> 5), rr = r & 15, cc = c & 31, ob = rr * 64 + cc * 2; return st * 1024 + (ob ^ (((ob >> 9) & 1) << 5)); }
__host__ __device__ __forceinline__ void stage_rc(int b, int& R, int& C) { const int st = b / 1024, sb = b % 1024, swz = sb ^ (((sb >> 9) & 1) << 5); R = (st >> 1) * 16 + swz / 64; C = (st & 1) * 32 + (swz % 64) / 2; }
__host__ __device__ __forceinline__ int perm32(int rho) { const int n = rho >> 4, i = rho & 15; return 8 * (i >> 2) + 4 * n + (i & 3); }

struct Unit { int pm, pn; };
struct Gemm { const bf16_t* A; const bf16_t* Bt; int M, N, K; };

struct StaticOrder {
    int nM, nN, nwg, G, c;
    __host__ __device__ void init(int M, int N, int G_, int c_) { nM = M / BM; nN = N / BM; nwg = nM * nN; G = G_; c = c_; }
    __host__ __device__ bool next(int i, Unit& u) const {
        const long L = (long)i * G + c; if (L >= nwg) return false;
        int wgid = (int)L; { const int q = nwg / NXCD, r = nwg % NXCD, xcd = wgid % NXCD, off = wgid / NXCD; wgid = (xcd < r ? xcd * (q + 1) : r * (q + 1) + (xcd - r) * q) + off; }
        const int nig = WGM * nN, gid = wgid / nig, fm = gid * WGM, gsz = (nM - fm) < WGM ? (nM - fm) : WGM;
        u.pm = fm + ((wgid % nig) % gsz); u.pn = (wgid % nig) / gsz; return true;
    }
    __device__ __forceinline__ void a_ready(const Unit&) const {}
    __device__ __forceinline__ void done(const Unit&) const {}
};
typedef float f32x2_t __attribute__((ext_vector_type(2))); typedef __bf16 bf16x2_t __attribute__((ext_vector_type(2)));
typedef unsigned u32x2 __attribute__((ext_vector_type(2)));
__device__ __forceinline__ unsigned pk2(float lo, float hi) { f32x2_t v = {lo, hi}; bf16x2_t b = __builtin_convertvector(v, bf16x2_t); return __builtin_bit_cast(unsigned, b); }
__device__ __forceinline__ float bflo(unsigned u) { return __uint_as_float(u << 16); }
__device__ __forceinline__ float bfhi(unsigned u) { return __uint_as_float(u & 0xffff0000u); }
__device__ __forceinline__ float sigm(float x) { return __builtin_amdgcn_rcpf(1.0f + __builtin_amdgcn_exp2f(x * -1.4426950408889634f)); }
constexpr float NORM_EPS = 1e-6f;
__device__ __forceinline__ float row_rstd(const float* P, int row) { const f32x4* p = (const f32x4*)(P + (size_t)row * 16); const f32x4 a = p[0], b = p[1], c = p[2], d = p[3];
    const float s = ((a[0] + a[1]) + (a[2] + a[3])) + ((b[0] + b[1]) + (b[2] + b[3])) + ((c[0] + c[1]) + (c[2] + c[3])) + ((d[0] + d[1]) + (d[2] + d[3])); return rsqrtf(s * (1.0f / 1024.0f) + NORM_EPS); }

struct EpiIn {
    static constexpr bool PERM = true, AFTER_DRAIN = false;
    bf16_t *Q, *KV, *A, *G; const float* ss;
    __device__ __forceinline__ void operator()(const f32x4 (&acc)[2][2][4][2], const Unit& u, int wr, int wc, int fr, int fq) const {
        const int row0 = u.pm * BM + wr * 64 + fr, pn = u.pn, cw = wc * 32 + 8 * fq;
        if (pn >= 5 && pn < 9) {
#pragma unroll
            for (int ai = 0; ai < 2; ++ai)
#pragma unroll
                for (int m = 0; m < 4; ++m) { const int row = row0 + ai * HALF + m * 16; const float rs = row_rstd(ss, row);
                    const f32x4 u0 = acc[ai][0][m][0] * rs, u1 = acc[ai][0][m][1] * rs, g0 = acc[ai][1][m][0] * rs, g1 = acc[ai][1][m][1] * rs;
                    u32x4 w; w.x = pk2(u0[0] * sigm(g0[0]), u0[1] * sigm(g0[1])); w.y = pk2(u0[2] * sigm(g0[2]), u0[3] * sigm(g0[3]));
                    w.z = pk2(u1[0] * sigm(g1[0]), u1[1] * sigm(g1[1])); w.w = pk2(u1[2] * sigm(g1[2]), u1[3] * sigm(g1[3]));
                    *(u32x4*)(A + (size_t)row * 512 + (pn - 5) * 128 + cw) = w; }
        } else {
            bf16_t* base; int pitch; const bool sg = pn >= 9;
            if (pn < 4) { base = Q + pn * 256 + cw; pitch = 1024; } else if (pn == 4) { base = KV + cw; pitch = 256; } else { base = G + (pn - 9) * 256 + cw; pitch = 2048; }
#pragma unroll
            for (int ai = 0; ai < 2; ++ai)
#pragma unroll
                for (int m = 0; m < 4; ++m) { const int row = row0 + ai * HALF + m * 16; const float rs = row_rstd(ss, row);
                    bf16_t* rowp = base + (size_t)row * pitch;
#pragma unroll
                    for (int bj = 0; bj < 2; ++bj) { f32x4 v0 = acc[ai][bj][m][0] * rs, v1 = acc[ai][bj][m][1] * rs;
                        if (sg) { v0 = (f32x4){sigm(v0[0]), sigm(v0[1]), sigm(v0[2]), sigm(v0[3])}; v1 = (f32x4){sigm(v1[0]), sigm(v1[1]), sigm(v1[2]), sigm(v1[3])}; }
                        u32x4 w; w.x = pk2(v0[0], v0[1]); w.y = pk2(v0[2], v0[3]); w.z = pk2(v1[0], v1[1]); w.w = pk2(v1[2], v1[3]);
                        *(u32x4*)(rowp + bj * HALF) = w; } }
        }
    }
};
struct EpiMerge {
    static constexpr bool PERM = true, AFTER_DRAIN = false;
    bf16_t* AO; const bf16_t* G;
    __device__ __forceinline__ void operator()(const f32x4 (&acc)[2][2][4][2], const Unit& u, int wr, int wc, int fr, int fq) const {
        const int row0 = u.pm * BM + wr * 64 + fr, col0 = u.pn * BM + wc * 32 + 8 * fq;
#pragma unroll
        for (int ai = 0; ai < 2; ++ai)
#pragma unroll
            for (int m = 0; m < 4; ++m) { const int row = row0 + ai * HALF + m * 16;
#pragma unroll
                for (int bj = 0; bj < 2; ++bj) { const int col = col0 + bj * HALF;
                    bf16_t* aop = AO + (size_t)row * 1024 + col; const bf16_t* gp = G + (size_t)row * 2048 + col;
                    const u32x4 ao = *(const u32x4*)aop, ga = *(const u32x4*)gp, gb = *(const u32x4*)(gp + 1024);
                    const f32x4 c0 = acc[ai][bj][m][0], c1 = acc[ai][bj][m][1];
                    u32x4 w;
                    w.x = pk2(bflo(ga.x) * bflo(ao.x) + bflo(gb.x) * c0[0], bfhi(ga.x) * bfhi(ao.x) + bfhi(gb.x) * c0[1]);
                    w.y = pk2(bflo(ga.y) * bflo(ao.y) + bflo(gb.y) * c0[2], bfhi(ga.y) * bfhi(ao.y) + bfhi(gb.y) * c0[3]);
                    w.z = pk2(bflo(ga.z) * bflo(ao.z) + bflo(gb.z) * c1[0], bfhi(ga.z) * bfhi(ao.z) + bfhi(gb.z) * c1[1]);
                    w.w = pk2(bflo(ga.w) * bflo(ao.w) + bflo(gb.w) * c1[2], bfhi(ga.w) * bfhi(ao.w) + bfhi(gb.w) * c1[3]);
                    *(u32x4*)aop = w; }
                if (m & 1) asm volatile("" ::: "memory"); }
    }
};
struct EpiRes {
    static constexpr bool PERM = false, AFTER_DRAIN = false;
    const float* xin; float* xout; bf16_t* XB; float* ssn; int nxt;
    __device__ __forceinline__ void operator()(const f32x4 (&acc)[2][2][4][2], const Unit& u, int wr, int wc, int fr, int fq) const {
        const int row0 = u.pm * BM + wr * 64 + fr, col0 = u.pn * BM + wc * 32 + 4 * fq;
#pragma unroll
        for (int ai = 0; ai < 2; ++ai)
#pragma unroll
            for (int m = 0; m < 4; ++m) { const int row = row0 + ai * HALF + m * 16; const size_t off = (size_t)row * 1024 + col0; float sq = 0.f;
#pragma unroll
                for (int bj = 0; bj < 2; ++bj)
#pragma unroll
                    for (int n = 0; n < 2; ++n) { const size_t o = off + bj * HALF + n * 16; const f32x4 v = *(const f32x4*)(xin + o) + acc[ai][bj][m][n];
                        *(f32x4*)(xout + o) = v;
                        if (nxt) { u32x2 w; w.x = pk2(v[0], v[1]); w.y = pk2(v[2], v[3]); *(u32x2*)(XB + o) = w; sq += (v[0] * v[0] + v[1] * v[1]) + (v[2] * v[2] + v[3] * v[3]); } }
                if (nxt) { sq += __shfl_xor(sq, 16); sq += __shfl_xor(sq, 32); if (fq == 0) ssn[(size_t)row * 16 + u.pn * 4 + wc] = sq; }
                if (m & 1) asm volatile("" ::: "memory"); }
    }
};
struct EpiSwiglu {
    static constexpr bool PERM = true, AFTER_DRAIN = false;
    bf16_t* ACT; const float* ss;
    __device__ __forceinline__ void operator()(const f32x4 (&acc)[2][2][4][2], const Unit& u, int wr, int wc, int fr, int fq) const {
        const int row0 = u.pm * BM + wr * 64 + fr, col = u.pn * 128 + wc * 32 + 8 * fq;
#pragma unroll
        for (int ai = 0; ai < 2; ++ai)
#pragma unroll
            for (int m = 0; m < 4; ++m) { const int row = row0 + ai * HALF + m * 16; const float rs = row_rstd(ss, row);
                const f32x4 g0 = acc[ai][0][m][0] * rs, g1 = acc[ai][0][m][1] * rs, u0 = acc[ai][1][m][0] * rs, u1 = acc[ai][1][m][1] * rs;
                u32x4 w; w.x = pk2(g0[0] * sigm(g0[0]) * u0[0], g0[1] * sigm(g0[1]) * u0[1]); w.y = pk2(g0[2] * sigm(g0[2]) * u0[2], g0[3] * sigm(g0[3]) * u0[3]);
                w.z = pk2(g1[0] * sigm(g1[0]) * u1[0], g1[1] * sigm(g1[1]) * u1[1]); w.w = pk2(g1[2] * sigm(g1[2]) * u1[2], g1[3] * sigm(g1[3]) * u1[3]);
                *(u32x4*)(ACT + (size_t)row * 2816 + col) = w; }
    }
};
template <class Epi, class Sched, bool ALIGN_EPI = false, bool SP2 = false>
__device__ __forceinline__ void gemm_phase(PG8_LAS unsigned char* lds, const Gemm g, const Sched& S, const Epi& E) {
    int tid_l = threadIdx.x; asm volatile("" : "+v"(tid_l));
    const int tid = tid_l, wid = __builtin_amdgcn_readfirstlane(tid >> 6), lane = tid & 63, wr = wid >> 2, wc = wid & 3, fr = lane & 15, fq = lane >> 4;
    const int K = g.K, nt = K / BK;
    unsigned voffA[2], voffB[2];
#pragma unroll
    for (int i = 0; i < 2; ++i) { int R, C; stage_rc(tid * 16 + i * 8192, R, C); const int Rb = Epi::PERM ? ((R & ~31) + perm32(R & 31)) : R;
        voffA[i] = (unsigned)(R * K + C) * 2u; voffB[i] = (unsigned)(Rb * K + C) * 2u; }
    const size_t kstep = (size_t)(BK * 2);
    const size_t hstep = (size_t)HALF * K * 2;
    const size_t tstep = 2 * hstep;
    const unsigned ldsw = (unsigned)wid * 1024u;
    const int aoff = lds_byte(wr * 64 + fr, fq * 8), boff = lds_byte(wc * 32 + fr, fq * 8);
#define PG8_SA(b, h) (((b) * 2 + (h)) * HTB)
#define PG8_SB(b, h) ((4 + (b) * 2 + (h)) * HTB)
#define PG8_STAGE(bufoff, gbase, voff) do { _Pragma("unroll") for (int _i = 0; _i < 2; ++_i) \
        __builtin_amdgcn_global_load_lds((const unsigned*)((const char*)(gbase) + (voff)[_i]), (PG8_LAS unsigned*)(lds + (bufoff) + ldsw + _i * 8192), 16, 0, 0); } while (0)
#define PG8_LDA(dst, b, h) do { _Pragma("unroll") for (int m = 0; m < 4; ++m) _Pragma("unroll") for (int k = 0; k < 2; ++k) dst[m][k] = *(const PG8_LAS bf16x8*)(lds + PG8_SA(b, h) + aoff + m * 2048 + k * 1024); } while (0)
#define PG8_LDB(dst, b, h) do { _Pragma("unroll") for (int n = 0; n < 2; ++n) _Pragma("unroll") for (int k = 0; k < 2; ++k) dst[n][k] = *(const PG8_LAS bf16x8*)(lds + PG8_SB(b, h) + boff + n * 2048 + k * 1024); } while (0)
#define PG8_MMA(ai, bj, At, Bt) do { __builtin_amdgcn_s_setprio(1); _Pragma("unroll") for (int m = 0; m < 4; ++m) _Pragma("unroll") for (int n = 0; n < 2; ++n) _Pragma("unroll") for (int k = 0; k < 2; ++k) \
        acc[ai][bj][m][n] = __builtin_amdgcn_mfma_f32_16x16x32_bf16(Bt[n][k], At[m][k], acc[ai][bj][m][n], 0, 0, 0); __builtin_amdgcn_s_setprio(0); } while (0)
#define PG8_WAIT_V(n) asm volatile("s_waitcnt vmcnt(" #n ")" ::: "memory")
#define PG8_WAIT_L(n) asm volatile("s_waitcnt lgkmcnt(" #n ")" ::: "memory")
#define PG8_BAR __builtin_amdgcn_s_barrier()
#define PG8_SCHED __builtin_amdgcn_sched_barrier(0)
    Unit cur, nxt; int ui = 0;
    if (!S.next(0, cur)) return;
    f32x4 acc[2][2][4][2];
#pragma unroll
    for (int a = 0; a < 2; ++a)
#pragma unroll
        for (int b = 0; b < 2; ++b)
#pragma unroll
            for (int m = 0; m < 4; ++m)
#pragma unroll
                for (int n = 0; n < 2; ++n) acc[a][b][m][n] = (f32x4){0.f, 0.f, 0.f, 0.f};
    bf16x8 At[4][2], B0[2][2], B1[2][2];
    const char* cA = (const char*)g.A + (size_t)cur.pm * tstep; const char* cB = (const char*)g.Bt + (size_t)cur.pn * tstep;
    S.a_ready(cur);
    if constexpr (SP2) {
        PG8_STAGE(PG8_SB(0, 0), cB, voffB); PG8_STAGE(PG8_SB(0, 1), cB + hstep, voffB); PG8_STAGE(PG8_SA(0, 0), cA, voffA); PG8_STAGE(PG8_SA(0, 1), cA + hstep, voffA);
        if (wr == 1) PG8_BAR;
        PG8_WAIT_V(2); PG8_BAR;
        PG8_STAGE(PG8_SB(1, 0), cB + kstep, voffB); PG8_STAGE(PG8_SA(1, 0), cA + kstep, voffA); PG8_STAGE(PG8_SB(1, 1), cB + hstep + kstep, voffB);
        PG8_WAIT_V(6); PG8_BAR;
    } else {
        PG8_STAGE(PG8_SB(0, 0), cB, voffB); PG8_STAGE(PG8_SA(0, 0), cA, voffA); PG8_STAGE(PG8_SB(0, 1), cB + hstep, voffB); PG8_STAGE(PG8_SA(0, 1), cA + hstep, voffA);
        if (wr == 1) PG8_BAR;
        PG8_WAIT_V(4); PG8_BAR;
        PG8_STAGE(PG8_SB(1, 0), cB + kstep, voffB); PG8_STAGE(PG8_SA(1, 0), cA + kstep, voffA); PG8_STAGE(PG8_SB(1, 1), cB + hstep + kstep, voffB);
        PG8_WAIT_V(6); PG8_BAR;
    }
    for (;;) {
        const bool has_next = S.next(ui + 1, nxt);
        const char* nA = has_next ? (const char*)g.A + (size_t)nxt.pm * tstep : cA; const char* nB = has_next ? (const char*)g.Bt + (size_t)nxt.pn * tstep : cB;
        for (int t = 0; t < nt; t += 2) {
            const bool last = (t == nt - 2);
            const char* a1 = cA + (size_t)(t + 1) * kstep;
            const char* a2 = last ? nA : cA + (size_t)(t + 2) * kstep; const char* b2 = last ? nB : cB + (size_t)(t + 2) * kstep;
            const char* a3 = a2 + kstep; const char* b3 = b2 + kstep;
            if (last && has_next) S.a_ready(nxt);
            if constexpr (SP2) {
            PG8_LDB(B0, 0, 0); PG8_LDB(B1, 0, 1); PG8_SCHED; PG8_LDA(At, 0, 0); PG8_STAGE(PG8_SA(1, 1), a1 + hstep, voffA);
            PG8_WAIT_V(8); PG8_WAIT_L(0); PG8_BAR; PG8_MMA(0, 0, At, B0); PG8_MMA(0, 1, At, B1); PG8_BAR; PG8_SCHED;
            PG8_LDA(At, 0, 1); PG8_STAGE(PG8_SB(0, 0), b2, voffB); PG8_STAGE(PG8_SB(0, 1), b2 + hstep, voffB); PG8_STAGE(PG8_SA(0, 0), a2, voffA);
            PG8_WAIT_V(8); PG8_WAIT_L(0); PG8_BAR; PG8_MMA(1, 0, At, B0); PG8_MMA(1, 1, At, B1); PG8_BAR; PG8_SCHED;
            PG8_LDB(B0, 1, 0); PG8_LDB(B1, 1, 1); PG8_SCHED; PG8_LDA(At, 1, 0); PG8_STAGE(PG8_SA(0, 1), a2 + hstep, voffA);
            PG8_WAIT_V(8); PG8_WAIT_L(0); PG8_BAR; PG8_MMA(0, 0, At, B0); PG8_MMA(0, 1, At, B1); PG8_BAR; PG8_SCHED;
            PG8_LDA(At, 1, 1); PG8_STAGE(PG8_SB(1, 0), b3, voffB); PG8_STAGE(PG8_SB(1, 1), b3 + hstep, voffB); PG8_STAGE(PG8_SA(1, 0), a3, voffA);
            PG8_WAIT_V(8); PG8_WAIT_L(0); PG8_BAR; PG8_MMA(1, 0, At, B0); PG8_MMA(1, 1, At, B1); PG8_BAR; PG8_SCHED;
            } else {
            PG8_LDB(B0, 0, 0); PG8_SCHED; PG8_LDA(At, 0, 0); PG8_STAGE(PG8_SA(1, 1), a1 + hstep, voffA);
            PG8_WAIT_L(8); PG8_BAR; PG8_WAIT_L(0); PG8_MMA(0, 0, At, B0); PG8_BAR; PG8_SCHED;
            PG8_LDB(B1, 0, 1); PG8_STAGE(PG8_SB(0, 0), b2, voffB);
            PG8_BAR; PG8_WAIT_L(0); PG8_MMA(0, 1, At, B1); PG8_BAR;
            PG8_LDA(At, 0, 1); PG8_STAGE(PG8_SA(0, 0), a2, voffA);
            PG8_BAR; PG8_WAIT_L(0); PG8_MMA(1, 0, At, B0); PG8_BAR; PG8_SCHED;
            PG8_STAGE(PG8_SB(0, 1), b2 + hstep, voffB);
            PG8_WAIT_V(6); PG8_BAR; PG8_MMA(1, 1, At, B1); PG8_BAR;
            PG8_LDB(B0, 1, 0); PG8_SCHED; PG8_LDA(At, 1, 0); PG8_STAGE(PG8_SA(0, 1), a2 + hstep, voffA);
            PG8_WAIT_L(8); PG8_BAR; PG8_WAIT_L(0); PG8_MMA(0, 0, At, B0); PG8_BAR; PG8_SCHED;
            PG8_LDB(B1, 1, 1); PG8_STAGE(PG8_SB(1, 0), b3, voffB);
            PG8_BAR; PG8_WAIT_L(0); PG8_MMA(0, 1, At, B1); PG8_BAR;
            PG8_LDA(At, 1, 1); PG8_STAGE(PG8_SA(1, 0), a3, voffA);
            PG8_BAR; PG8_WAIT_L(0); PG8_MMA(1, 0, At, B0); PG8_BAR; PG8_SCHED;
            PG8_STAGE(PG8_SB(1, 1), b3 + hstep, voffB);
            PG8_WAIT_V(6); PG8_BAR; PG8_MMA(1, 1, At, B1); PG8_BAR;
            }
        }
        if constexpr (ALIGN_EPI) { if (wr == 0) PG8_BAR; }
        if constexpr (!Epi::AFTER_DRAIN) { E(acc, cur, wr, wc, fr, fq); S.done(cur); }
        if (!has_next) break;
#pragma unroll
        for (int a = 0; a < 2; ++a)
#pragma unroll
            for (int b = 0; b < 2; ++b)
#pragma unroll
                for (int m = 0; m < 4; ++m)
#pragma unroll
                    for (int n = 0; n < 2; ++n) acc[a][b][m][n] = (f32x4){0.f, 0.f, 0.f, 0.f};
        cur = nxt; cA = nA; cB = nB; ++ui;
        if constexpr (ALIGN_EPI) { if (wr == 1) PG8_BAR; }
    }
    PG8_WAIT_V(0);
    if constexpr (!ALIGN_EPI) { if (wr == 0) PG8_BAR; }
    PG8_BAR;
    if constexpr (Epi::AFTER_DRAIN) { E.fused(acc, cur, wr, wc, fr, fq, lds, wid, lane); S.done(cur); }
#undef PG8_SA
#undef PG8_SB
#undef PG8_STAGE
#undef PG8_LDA
#undef PG8_LDB
#undef PG8_MMA
#undef PG8_WAIT_V
#undef PG8_WAIT_L
#undef PG8_BAR
#undef PG8_SCHED
}
}
using pg8::bf16_t; using pg8::f32x4; using pg8::u32x4; using pg8::bf16x8; using pg8::u32x2; using pg8::pk2; using pg8::bflo; using pg8::bfhi; using pg8::sigm; using pg8::NORM_EPS;
#define LAS __attribute__((address_space(3)))
constexpr int NB = 4, T = 8192, M = NB * T, D = 1024, INW = 4352, CC = 512, FF = 2816, GU = 2 * FF, DEPTH = 4, NHEAD = 16;
constexpr size_t MiB = 1u << 20;
constexpr size_t WS_SS = 450 * MiB, SS_BUF = 2 * MiB;
constexpr size_t WS_ROPE = 1 * MiB;
constexpr size_t WS_W = 2 * MiB, W_LAYER = 28 * MiB;
constexpr size_t WO_IN = 0, WO_PW = 8 * MiB + MiB / 2, WO_OUT = WO_PW + 1 * MiB, WO_GU = WO_OUT + 2 * MiB, WO_DN = WO_GU + 11 * MiB;
constexpr size_t WS_XB = 114 * MiB, WS_QO = 178 * MiB, WS_KV = 242 * MiB, WS_A = 258 * MiB, WS_G = 290 * MiB, WS_Y = 418 * MiB, WS_END = 454 * MiB;
constexpr size_t WS_ACT = 178 * MiB;
static_assert(WO_DN + (size_t)D * FF * 2 == W_LAYER && WS_W + DEPTH * W_LAYER == WS_XB && WS_ACT + (size_t)M * FF * 2 <= WS_Y, "ws map");
constexpr int LDS_BYTES = 132096;

__device__ __forceinline__ float wave_sum(float v) {
#pragma unroll
    for (int o = 1; o < 64; o <<= 1) v += __shfl_xor(v, o);
    return v;
}

namespace att {
typedef __attribute__((ext_vector_type(16))) float f32x16;
typedef __attribute__((ext_vector_type(4))) short s16x4;
constexpr int KPB = 144, VPB = 520, OFF_V = 256 * KPB;
constexpr float LOG2E = 1.4426950408889634f;
__device__ __forceinline__ int crow(int r, int hi) { return (r & 3) + 8 * (r >> 2) + 4 * hi; }

__device__ __forceinline__ void unit(LAS unsigned char* lds, int b, int kvh, int blk, bf16_t* QO, const bf16_t* KV, const float* qn, const float* kn, const float* sinks,
                                     const float* rope, int tid, int lane, int wave) {
    {
        const int row = tid >> 1, half = tid & 1, pos = blk * 128 - 128 + row; const bool valid = pos >= 0;
        const bf16_t* src = KV + (size_t)(b * T + pos) * 256 + kvh * 64 + half * 32;
        float x[32]; float ssq = 0.f;
#pragma unroll
        for (int i = 0; i < 4; ++i) { u32x4 r = (u32x4){0u, 0u, 0u, 0u}; if (valid) r = *(const u32x4*)(src + 8 * i);
            x[8 * i + 0] = bflo(r.x); x[8 * i + 1] = bfhi(r.x); x[8 * i + 2] = bflo(r.y); x[8 * i + 3] = bfhi(r.y); x[8 * i + 4] = bflo(r.z); x[8 * i + 5] = bfhi(r.z); x[8 * i + 6] = bflo(r.w); x[8 * i + 7] = bfhi(r.w); }
#pragma unroll
        for (int i = 0; i < 32; ++i) ssq += x[i] * x[i];
        ssq += __shfl_xor(ssq, 1);
        const float rstd = rsqrtf(ssq * (1.0f / 64.0f) + NORM_EPS);
#pragma unroll
        for (int i = 0; i < 8; ++i) { const f32x4 g = *(const f32x4*)(kn + half * 32 + 4 * i); x[4 * i] *= rstd * g[0]; x[4 * i + 1] *= rstd * g[1]; x[4 * i + 2] *= rstd * g[2]; x[4 * i + 3] *= rstd * g[3]; }
        if (half == 0 && valid) { const float* cs = rope + pos * 16;
#pragma unroll
            for (int i = 0; i < 8; ++i) { const float c = cs[i], s = cs[8 + i], x1 = x[i], x2 = x[8 + i]; x[i] = x1 * c - x2 * s; x[8 + i] = x2 * c + x1 * s; } }
#pragma unroll
        for (int i = 0; i < 4; ++i) { u32x4 w; w.x = pk2(x[8 * i], x[8 * i + 1]); w.y = pk2(x[8 * i + 2], x[8 * i + 3]); w.z = pk2(x[8 * i + 4], x[8 * i + 5]); w.w = pk2(x[8 * i + 6], x[8 * i + 7]);
            *(LAS u32x4*)(lds + row * KPB + half * 64 + 16 * i) = w; }
    }
    {
        const int rp = tid >> 2, c = tid & 3, pos0 = blk * 128 - 128 + 2 * rp; const bool valid = pos0 >= 0;
        const bf16_t* src = KV + (size_t)(b * T + pos0) * 256 + 128 + kvh * 64 + 16 * c;
        u32x4 r0[2], r1[2];
#pragma unroll
        for (int i = 0; i < 2; ++i) { r0[i] = (u32x4){0u, 0u, 0u, 0u}; r1[i] = r0[i]; if (valid) { r0[i] = *(const u32x4*)(src + 8 * i); r1[i] = *(const u32x4*)(src + 256 + 8 * i); } }
#pragma unroll
        for (int w = 0; w < 8; ++w) { const unsigned a = r0[w >> 2][w & 3], bb = r1[w >> 2][w & 3]; const int d = 16 * c + 2 * w;
            *(LAS unsigned*)(lds + OFF_V + d * VPB + rp * 4) = (a & 0xffffu) | (bb << 16);
            *(LAS unsigned*)(lds + OFF_V + (d + 1) * VPB + rp * 4) = (a >> 16) | (bb & 0xffff0000u); }
    }
    __syncthreads();
    const int h = kvh * 8 + wave, q = lane & 31, hi = lane >> 5;
    const float sink2 = sinks[h] * LOG2E;
#pragma unroll 1
    for (int sub = 0; sub < 4; ++sub) {
        const int tq = blk * 128 + 32 * sub + q; const size_t grow = (size_t)(b * T + tq);
        bf16_t* qp = QO + grow * 1024 + h * 64 + 8 * hi;
        float x[4][8]; float ssq = 0.f;
#pragma unroll
        for (int d0 = 0; d0 < 4; ++d0) { const u32x4 r = *(const u32x4*)(qp + 16 * d0);
            x[d0][0] = bflo(r.x); x[d0][1] = bfhi(r.x); x[d0][2] = bflo(r.y); x[d0][3] = bfhi(r.y); x[d0][4] = bflo(r.z); x[d0][5] = bfhi(r.z); x[d0][6] = bflo(r.w); x[d0][7] = bfhi(r.w); }
#pragma unroll
        for (int d0 = 0; d0 < 4; ++d0)
#pragma unroll
            for (int i = 0; i < 8; ++i) ssq += x[d0][i] * x[d0][i];
        ssq += __shfl_xor(ssq, 32);
        const float rstd = rsqrtf(ssq * (1.0f / 64.0f) + NORM_EPS) * (0.125f * LOG2E);
#pragma unroll
        for (int d0 = 0; d0 < 4; ++d0) { const f32x4 g0 = *(const f32x4*)(qn + 16 * d0 + 8 * hi), g1 = *(const f32x4*)(qn + 16 * d0 + 8 * hi + 4);
            x[d0][0] *= rstd * g0[0]; x[d0][1] *= rstd * g0[1]; x[d0][2] *= rstd * g0[2]; x[d0][3] *= rstd * g0[3]; x[d0][4] *= rstd * g1[0]; x[d0][5] *= rstd * g1[1]; x[d0][6] *= rstd * g1[2]; x[d0][7] *= rstd * g1[3]; }
        { const float* cs = rope + tq * 16;
#pragma unroll
            for (int i = 0; i < 8; ++i) { const float c = cs[i], s = cs[8 + i], me = x[0][i], ot = __shfl_xor(me, 32); x[0][i] = hi == 0 ? me * c - ot * s : me * c + ot * s; } }
        bf16x8 qf[4];
#pragma unroll
        for (int d0 = 0; d0 < 4; ++d0) { u32x4 w; w.x = pk2(x[d0][0], x[d0][1]); w.y = pk2(x[d0][2], x[d0][3]); w.z = pk2(x[d0][4], x[d0][5]); w.w = pk2(x[d0][6], x[d0][7]); qf[d0] = __builtin_bit_cast(bf16x8, w); }
        f32x16 p[5];
#pragma unroll
        for (int kt = 0; kt < 5; ++kt) {
#pragma unroll
            for (int r = 0; r < 16; ++r) p[kt][r] = 0.f;
#pragma unroll
            for (int d0 = 0; d0 < 4; ++d0) { const bf16x8 kf = *(const LAS bf16x8*)(lds + (32 * (sub + kt) + q) * KPB + (16 * d0 + 8 * hi) * 2);
                p[kt] = __builtin_amdgcn_mfma_f32_32x32x16_bf16(kf, qf[d0], p[kt], 0, 0, 0); } }
        const bool first = (blk == 0);
        float mx = sink2;
#pragma unroll
        for (int kt = 0; kt < 5; ++kt) { const bool dead = first && (sub + kt < 4);
#pragma unroll
            for (int r = 0; r < 16; ++r) { const int j = crow(r, hi); bool ok = true; if (kt == 0) ok = j > q; if (kt == 4) ok = j <= q; if (dead) ok = false;
                const float v = ok ? p[kt][r] : -INFINITY; p[kt][r] = v; mx = fmaxf(mx, v); } }
        mx = fmaxf(mx, __shfl_xor(mx, 32));
        float lsum = 0.f;
#pragma unroll
        for (int kt = 0; kt < 5; ++kt)
#pragma unroll
            for (int r = 0; r < 16; ++r) { const float e = __builtin_amdgcn_exp2f(p[kt][r] - mx); p[kt][r] = e; lsum += e; }
        lsum += __shfl_xor(lsum, 32); lsum += __builtin_amdgcn_exp2f(sink2 - mx);
        const float inv = 1.0f / lsum;
        f32x16 o[2];
#pragma unroll
        for (int r = 0; r < 16; ++r) { o[0][r] = 0.f; o[1][r] = 0.f; }
#pragma unroll
        for (int kt = 0; kt < 5; ++kt)
#pragma unroll
            for (int s = 0; s < 2; ++s) { u32x4 w; w.x = pk2(p[kt][8 * s], p[kt][8 * s + 1]); w.y = pk2(p[kt][8 * s + 2], p[kt][8 * s + 3]); w.z = pk2(p[kt][8 * s + 4], p[kt][8 * s + 5]); w.w = pk2(p[kt][8 * s + 6], p[kt][8 * s + 7]);
                const bf16x8 pf = __builtin_bit_cast(bf16x8, w);
#pragma unroll
                for (int d0 = 0; d0 < 2; ++d0) { const LAS unsigned char* vp = lds + OFF_V + (32 * d0 + q) * VPB + (32 * (sub + kt) + 16 * s + 4 * hi) * 2;
                    const s16x4 lo = *(const LAS s16x4*)vp, hi4 = *(const LAS s16x4*)(vp + 16);
                    const bf16x8 vf = (bf16x8){lo[0], lo[1], lo[2], lo[3], hi4[0], hi4[1], hi4[2], hi4[3]};
                    o[d0] = __builtin_amdgcn_mfma_f32_32x32x16_bf16(vf, pf, o[d0], 0, 0, 0); } }
        bf16_t* op = QO + grow * 1024 + h * 64 + 4 * hi;
#pragma unroll
        for (int d0 = 0; d0 < 2; ++d0)
#pragma unroll
            for (int g = 0; g < 4; ++g) { u32x2 w; w.x = pk2(o[d0][4 * g] * inv, o[d0][4 * g + 1] * inv); w.y = pk2(o[d0][4 * g + 2] * inv, o[d0][4 * g + 3] * inv);
                *(u32x2*)(op + 32 * d0 + 8 * g) = w; }
    }
    __syncthreads();
}
}

namespace cv {
constexpr int ROWS = 62, OFF_Y = ROWS * 1024;
__device__ __forceinline__ void unit(LAS unsigned char* lds, int un, const bf16_t* A, bf16_t* Y, const float* cw, const float* cb, const float* lg, const float* lb, int tid, int lane, int wave) {
    const int t0 = un * 32, p0 = t0 & (T - 1);
    for (int idx = tid; idx < ROWS * 64; idx += 512) { const int r = idx >> 6, ch = idx & 63; u32x4 v = (u32x4){0u, 0u, 0u, 0u};
        if (p0 - 30 + r >= 0) v = *(const u32x4*)(A + (size_t)(t0 - 30 + r) * CC + ch * 8);
        *(LAS u32x4*)(lds + r * 1024 + ch * 16) = v; }
    __syncthreads();
    {
        const int cp = tid & 255, tg = tid >> 8;
        float w0[31], w1[31];
#pragma unroll
        for (int j = 0; j < 31; ++j) { const pg8::f32x2_t w = *(const pg8::f32x2_t*)(cw + j * CC + 2 * cp); w0[j] = w.x; w1[j] = w.y; }
        const pg8::f32x2_t bias = *(const pg8::f32x2_t*)(cb + 2 * cp);
#pragma unroll 1
        for (int sb = 0; sb < 2; ++sb) { const int tb = 16 * tg + 8 * sb;
            float a0[8], a1[8];
#pragma unroll
            for (int i = 0; i < 8; ++i) { a0[i] = bias.x; a1[i] = bias.y; }
#pragma unroll
            for (int rr = 0; rr < 38; ++rr) { const unsigned v = *(const LAS unsigned*)(lds + (tb + rr) * 1024 + cp * 4); const float v0 = bflo(v), v1 = bfhi(v);
#pragma unroll
                for (int i = 0; i < 8; ++i) { const int j = rr - i; if (j >= 0 && j <= 30) { a0[i] += w0[j] * v0; a1[i] += w1[j] * v1; } } }
#pragma unroll
            for (int i = 0; i < 8; ++i) *(LAS pg8::f32x2_t*)(lds + OFF_Y + (tb + i) * 2048 + cp * 8) = (pg8::f32x2_t){a0[i], a1[i]}; }
    }
    __syncthreads();
    {
        const f32x4 g0 = *(const f32x4*)(lg + 4 * lane), g1 = *(const f32x4*)(lg + 256 + 4 * lane), b0 = *(const f32x4*)(lb + 4 * lane), b1 = *(const f32x4*)(lb + 256 + 4 * lane);
#pragma unroll
        for (int k = 0; k < 4; ++k) { const int tok = 4 * wave + k;
            f32x4 v0 = *(const LAS f32x4*)(lds + OFF_Y + tok * 2048 + lane * 16), v1 = *(const LAS f32x4*)(lds + OFF_Y + tok * 2048 + 1024 + lane * 16);
            const float mean = wave_sum((v0[0] + v0[1]) + (v0[2] + v0[3]) + (v1[0] + v1[1]) + (v1[2] + v1[3])) * (1.0f / 512.0f);
            v0 = v0 - mean; v1 = v1 - mean;
            const float var = wave_sum((v0[0] * v0[0] + v0[1] * v0[1]) + (v0[2] * v0[2] + v0[3] * v0[3]) + (v1[0] * v1[0] + v1[1] * v1[1]) + (v1[2] * v1[2] + v1[3] * v1[3])) * (1.0f / 512.0f);
            const float rstd = rsqrtf(var + NORM_EPS);
            v0 = v0 * rstd * g0 + b0; v1 = v1 * rstd * g1 + b1;
            u32x2 w0, w1; w0.x = pk2(v0[0] * sigm(v0[0]), v0[1] * sigm(v0[1])); w0.y = pk2(v0[2] * sigm(v0[2]), v0[3] * sigm(v0[3]));
            w1.x = pk2(v1[0] * sigm(v1[0]), v1[1] * sigm(v1[1])); w1.y = pk2(v1[2] * sigm(v1[2]), v1[3] * sigm(v1[3]));
            bf16_t* yp = Y + (size_t)(t0 + tok) * CC + 4 * lane; *(u32x2*)yp = w0; *(u32x2*)(yp + 256) = w1; }
    }
    __syncthreads();
}
}
__device__ __forceinline__ void transpose_item(const float* W, int K, int N, bf16_t* WT, int k0, int n0s, int n0d, const float* gain, LAS float* scr, int lane) {
#pragma unroll 8
    for (int i = 0; i < 32; ++i) { const int kk = 2 * i + (lane >> 5); float w = W[(size_t)(k0 + kk) * N + n0s + (lane & 31)]; if (gain) w *= gain[k0 + kk]; scr[kk * 33 + (lane & 31)] = w; }
    asm volatile("s_waitcnt lgkmcnt(0)" ::: "memory");
    const int c = lane & 7;
#pragma unroll
    for (int j = 0; j < 4; ++j) { const int n = (lane >> 3) + 8 * j; const LAS float* s = scr + (8 * c) * 33 + n;
        u32x4 o; o.x = pk2(s[0 * 33], s[1 * 33]); o.y = pk2(s[2 * 33], s[3 * 33]); o.z = pk2(s[4 * 33], s[5 * 33]); o.w = pk2(s[6 * 33], s[7 * 33]);
        *(u32x4*)(WT + (size_t)(n0d + n) * K + k0 + 8 * c) = o; }
    asm volatile("s_waitcnt lgkmcnt(0)" ::: "memory");
}
__device__ __forceinline__ int perm_in(int n0d) { const int pn = n0d >> 8, h = (n0d >> 7) & 1, j = n0d & 127; if (pn >= 5 && pn < 9) return (h ? 1792 : 1280) + 128 * (pn - 5) + j; return n0d; }
__device__ __forceinline__ int perm_gu(int n0d) { const int pn = n0d >> 8, h = (n0d >> 7) & 1, j = n0d & 127; return (h ? FF : 0) + 128 * pn + j; }

struct Args { const float* in[15]; float* out; unsigned char* ws; int ph_lo, ph_hi; };
enum { I_X = 0, I_NMIX, I_WIN, I_QN, I_KN, I_SINK, I_CW, I_CB, I_LG, I_LB, I_WPW, I_WOUT, I_NFFN, I_WGU, I_WDN };

__device__ __forceinline__ void prologue(const Args& a, LAS unsigned char* lds, int tid, int lane, int wave) {
    LAS float* scr = (LAS float*)(lds + wave * 16384);
    const int gw = blockIdx.x * 8 + wave, NGW = gridDim.x * 8;
    constexpr int I_IN = (D / 64) * (INW / 32), I_PW = (CC / 64) * (D / 32), I_OUT = (D / 64) * (D / 32), I_GU = (D / 64) * (GU / 32), I_DN = (FF / 64) * (D / 32), PER_L = I_IN + I_PW + I_OUT + I_GU + I_DN;
    for (int it = gw; it < DEPTH * PER_L; it += NGW) {
        const int l = it / PER_L; int r = it % PER_L; unsigned char* wb = a.ws + WS_W + (size_t)l * W_LAYER;
        if (r < I_IN) { const int nblk = INW / 32, kb = r / nblk, nb = r % nblk; transpose_item(a.in[I_WIN] + (size_t)l * D * INW, D, INW, (bf16_t*)(wb + WO_IN), 64 * kb, perm_in(32 * nb), 32 * nb, a.in[I_NMIX] + l * D, scr, lane); continue; } r -= I_IN;
        if (r < I_PW) { const int nblk = D / 32, kb = r / nblk, nb = r % nblk; transpose_item(a.in[I_WPW] + (size_t)l * CC * D, CC, D, (bf16_t*)(wb + WO_PW), 64 * kb, 32 * nb, 32 * nb, nullptr, scr, lane); continue; } r -= I_PW;
        if (r < I_OUT) { const int nblk = D / 32, kb = r / nblk, nb = r % nblk; transpose_item(a.in[I_WOUT] + (size_t)l * D * D, D, D, (bf16_t*)(wb + WO_OUT), 64 * kb, 32 * nb, 32 * nb, nullptr, scr, lane); continue; } r -= I_OUT;
        if (r < I_GU) { const int nblk = GU / 32, kb = r / nblk, nb = r % nblk; transpose_item(a.in[I_WGU] + (size_t)l * D * GU, D, GU, (bf16_t*)(wb + WO_GU), 64 * kb, perm_gu(32 * nb), 32 * nb, a.in[I_NFFN] + l * D, scr, lane); continue; } r -= I_GU;
        { const int nblk = D / 32, kb = r / nblk, nb = r % nblk; transpose_item(a.in[I_WDN] + (size_t)l * FF * D, FF, D, (bf16_t*)(wb + WO_DN), 64 * kb, 32 * nb, 32 * nb, nullptr, scr, lane); }
    }
    float* ss = (float*)(a.ws + WS_SS); bf16_t* XB = (bf16_t*)(a.ws + WS_XB);
    for (int m = gw; m < M; m += NGW) { const f32x4* xr = (const f32x4*)(a.in[I_X] + (size_t)m * D) + lane; u32x2* xo = (u32x2*)(XB + (size_t)m * D) + lane; float s = 0.f;
#pragma unroll
        for (int j = 0; j < 4; ++j) { const f32x4 v = xr[64 * j]; s += (v[0] * v[0] + v[1] * v[1]) + (v[2] * v[2] + v[3] * v[3]); u32x2 w; w.x = pk2(v[0], v[1]); w.y = pk2(v[2], v[3]); xo[64 * j] = w; }
        s = wave_sum(s); if (lane < 16) ss[(size_t)m * 16 + lane] = lane == 0 ? s : 0.f; }
    float* rope = (float*)(a.ws + WS_ROPE);
    for (int i = blockIdx.x * 512 + tid; i < T * 8; i += gridDim.x * 512) { const int t = i >> 3, f = i & 7;
        double fr = 1.0; for (int k = 0; k < f; ++k) fr *= 0.19392274474868576;
        const float inv_freq = (float)fr; const float ang = (float)t * inv_freq;
        const double x = (double)ang, kq = __builtin_rint(x * 0.6366197723675814);
        const double r = __builtin_fma(-kq, 6.123233995736766e-17, __builtin_fma(-kq, 1.5707963267948966, x)), r2 = r * r;
        const double sp = r * (1.0 + r2 * (-1.0 / 6 + r2 * (1.0 / 120 + r2 * (-1.0 / 5040 + r2 * (1.0 / 362880 + r2 * (-1.0 / 39916800 + r2 * (1.0 / 6227020800.0)))))));
        const double cp = 1.0 + r2 * (-0.5 + r2 * (1.0 / 24 + r2 * (-1.0 / 720 + r2 * (1.0 / 40320 + r2 * (-1.0 / 3628800 + r2 * (1.0 / 479001600 + r2 * (-1.0 / 87178291200.0)))))));
        const int qd = ((int)kq) & 3;
        const double sn = qd == 0 ? sp : qd == 1 ? cp : qd == 2 ? -sp : -cp, cn = qd == 0 ? cp : qd == 1 ? -sp : qd == 2 ? -cp : sp;
        rope[t * 16 + f] = (float)cn; rope[t * 16 + 8 + f] = (float)sn; }
}

constexpr int N_PHASES = 1 + 6 * DEPTH;
__global__ void __launch_bounds__(512, 2) fwd_kernel(Args a) {
    extern __shared__ __attribute__((aligned(16))) unsigned char lds_raw[];
    LAS unsigned char* lds = (LAS unsigned char*)lds_raw;
    cg::grid_group grid = cg::this_grid();
    const int G = gridDim.x, bx = blockIdx.x;
    unsigned char* ws = a.ws;
    float* ss = (float*)(ws + WS_SS); const float* rope = (const float*)(ws + WS_ROPE);
    bf16_t* XB = (bf16_t*)(ws + WS_XB); bf16_t* QO = (bf16_t*)(ws + WS_QO); bf16_t* KV = (bf16_t*)(ws + WS_KV); bf16_t* AB = (bf16_t*)(ws + WS_A);
    bf16_t* GB = (bf16_t*)(ws + WS_G); bf16_t* YB = (bf16_t*)(ws + WS_Y); bf16_t* ACT = (bf16_t*)(ws + WS_ACT);
#pragma unroll 1
    for (int ph = a.ph_lo; ph < a.ph_hi; ++ph) {
        if (ph > a.ph_lo) grid.sync();
        int tid_l = threadIdx.x; asm volatile("" : "+v"(tid_l));
        const int tid = tid_l, lane = tid & 63, wave = __builtin_amdgcn_readfirstlane(tid >> 6);
        if (ph == 0) { prologue(a, lds, tid, lane, wave); continue; }
        const int l = (ph - 1) / 6, s = (ph - 1) % 6;
        const unsigned char* wb = ws + WS_W + (size_t)l * W_LAYER;
        if (s == 0) {
            pg8::Gemm g{XB, (const bf16_t*)(wb + WO_IN), M, INW, D}; pg8::StaticOrder S; S.init(M, INW, G, bx);
            pg8::EpiIn E{QO, KV, AB, GB, ss};
            pg8::gemm_phase<pg8::EpiIn, pg8::StaticOrder, true, true>(lds, g, S, E);
        } else if (s == 1) {
            for (int u = bx; u < NB * 2 * (T / 128); u += G) { const int blk = u & 63, kvh = (u >> 6) & 1, b = u >> 7;
                att::unit(lds, b, kvh, blk, QO, KV, a.in[I_QN] + l * 64, a.in[I_KN] + l * 64, a.in[I_SINK] + l * NHEAD, rope, tid, lane, wave); }
            for (int u = bx; u < M / 32; u += G)
                cv::unit(lds, u, AB, YB, a.in[I_CW] + (size_t)l * 31 * CC, a.in[I_CB] + l * CC, a.in[I_LG] + l * CC, a.in[I_LB] + l * CC, tid, lane, wave);
        } else if (s == 2) {
            pg8::Gemm g{YB, (const bf16_t*)(wb + WO_PW), M, D, CC}; pg8::StaticOrder S; S.init(M, D, G, bx);
            pg8::EpiMerge E{QO, GB};
            pg8::gemm_phase<pg8::EpiMerge, pg8::StaticOrder, true, true>(lds, g, S, E);
        } else if (s == 3) {
            pg8::Gemm g{QO, (const bf16_t*)(wb + WO_OUT), M, D, D}; pg8::StaticOrder S; S.init(M, D, G, bx);
            pg8::EpiRes E{l == 0 ? a.in[I_X] : a.out, a.out, XB, ss + (size_t)M * 16, 1};
            pg8::gemm_phase<pg8::EpiRes, pg8::StaticOrder, true, true>(lds, g, S, E);
        } else if (s == 4) {
            pg8::Gemm g{XB, (const bf16_t*)(wb + WO_GU), M, GU, D}; pg8::StaticOrder S; S.init(M, GU, G, bx);
            pg8::EpiSwiglu E{ACT, ss + (size_t)M * 16};
            pg8::gemm_phase<pg8::EpiSwiglu, pg8::StaticOrder, true, true>(lds, g, S, E);
        } else {
            pg8::Gemm g{ACT, (const bf16_t*)(wb + WO_DN), M, D, FF}; pg8::StaticOrder S; S.init(M, D, G, bx);
            pg8::EpiRes E{a.out, a.out, XB, ss, l + 1 < DEPTH ? 1 : 0};
            pg8::gemm_phase<pg8::EpiRes, pg8::StaticOrder, true, true>(lds, g, S, E);
        }
    }
}

#ifndef MK_PER_PHASE
#define MK_PER_PHASE 1
#endif
extern "C" void kernel_launch(void* const* d_in, const int* in_sizes, int n_in, void* d_out, int out_size, void* d_ws, size_t ws_size, hipStream_t stream) {
    static int grid = 0;
    if (grid == 0) {
        if (n_in != 15 || in_sizes[0] != M * D || out_size != M * D || ws_size < WS_END) { fprintf(stderr, "kernel_launch: unexpected shapes / workspace (n_in %d, ws %zu)\n", n_in, ws_size); grid = -1; return; }
        int dev = 0, cus = 0, per_cu = 0;
        (void)hipGetDevice(&dev); (void)hipDeviceGetAttribute(&cus, hipDeviceAttributeMultiprocessorCount, dev);
        if (hipFuncSetAttribute((const void*)fwd_kernel, hipFuncAttributeMaxDynamicSharedMemorySize, LDS_BYTES) != hipSuccess) { fprintf(stderr, "kernel_launch: hipFuncSetAttribute failed\n"); grid = -1; return; }
        if (hipOccupancyMaxActiveBlocksPerMultiprocessor(&per_cu, (const void*)fwd_kernel, 512, LDS_BYTES) != hipSuccess || per_cu < 1) { fprintf(stderr, "kernel_launch: occupancy query says %d\n", per_cu); per_cu = 1; }
        (void)hipGetLastError();
        grid = cus * per_cu;
    }
    if (grid < 0) return;
    Args a{};
    for (int i = 0; i < 15; ++i) a.in[i] = (const float*)d_in[i];
    a.out = (float*)d_out; a.ws = (unsigned char*)d_ws;
#if MK_PER_PHASE
    for (int ph = 0; ph < N_PHASES; ++ph) { a.ph_lo = ph; a.ph_hi = ph + 1; hipLaunchKernelGGL(fwd_kernel, dim3(grid), dim3(512), LDS_BYTES, stream, a); }
#else
    a.ph_lo = 0; a.ph_hi = N_PHASES;
    void* args[] = {&a};
    hipError_t e = hipLaunchCooperativeKernel((const void*)fwd_kernel, dim3(grid), dim3(512), args, LDS_BYTES, stream);
    if (e != hipSuccess) fprintf(stderr, "cooperative launch failed: %s (grid %d)\n", hipGetErrorString(e), grid);
#endif
}
```

```cpp
#include <hip/hip_runtime.h>
#include <hip/hip_cooperative_groups.h>
#include <cstdio>
#include <cstdint>
namespace cg = cooperative_groups;
namespace pg8 {
#define PG8_LAS __attribute__((address_space(3)))
typedef unsigned short bf16_t;
typedef short bf16x8 __attribute__((ext_vector_type(8)));
typedef float f32x4 __attribute__((ext_vector_type(4)));
typedef unsigned u32x4 __attribute__((ext_vector_type(4)));
constexpr int BM = 256, BK = 64, HALF = 128, HTB = HALF * BK * 2  , STAGE_BYTES = 8 * HTB, NXCD = 8, WGM = 8;

__host__ __device__ __forceinline__ int lds_byte(int r, int c) { const int st = (r >> 4) * 2 + (c >> 5), rr = r & 15, cc = c & 31, ob = rr * 64 + cc * 2; return st * 1024 + (ob ^ (((ob >> 9) & 1) << 5)); }
__host__ __device__ __forceinline__ void stage_rc(int b, int& R, int& C) { const int st = b / 1024, sb = b % 1024, swz = sb ^ (((sb >> 9) & 1) << 5); R = (st >> 1) * 16 + swz / 64; C = (st & 1) * 32 + (swz % 64) / 2; }
__host__ __device__ __forceinline__ int perm32(int rho) { const int n = rho >> 4, i = rho & 15; return 8 * (i >> 2) + 4 * n + (i & 3); }

struct Unit { int pm, pn; };
struct Gemm { const bf16_t* A; const bf16_t* Bt; int M, N, K; };

struct StaticOrder {
    int nM, nN, nwg, G, c;
    __host__ __device__ void init(int M, int N, int G_, int c_) { nM = M / BM; nN = N / BM; nwg = nM * nN; G = G_; c = c_; }
    __host__ __device__ bool next(int i, Unit& u) const {
        const long L = (long)i * G + c; if (L >= nwg) return false;
        int wgid = (int)L; { const int q = nwg / NXCD, r = nwg % NXCD, xcd = wgid % NXCD, off = wgid / NXCD; wgid = (xcd < r ? xcd * (q + 1) : r * (q + 1) + (xcd - r) * q) + off; }
        const int nig = WGM * nN, gid = wgid / nig, fm = gid * WGM, gsz = (nM - fm) < WGM ? (nM - fm) : WGM;
        u.pm = fm + ((wgid % nig) % gsz); u.pn = (wgid % nig) / gsz; return true;
    }
    __device__ __forceinline__ void a_ready(const Unit&) const {}
    __device__ __forceinline__ void done(const Unit&) const {}
};
typedef float f32x2_t __attribute__((ext_vector_type(2))); typedef __bf16 bf16x2_t __attribute__((ext_vector_type(2)));
typedef unsigned u32x2 __attribute__((ext_vector_type(2)));
__device__ __forceinline__ unsigned pk2(float lo, float hi) { f32x2_t v = {lo, hi}; bf16x2_t b = __builtin_convertvector(v, bf16x2_t); return __builtin_bit_cast(unsigned, b); }
__device__ __forceinline__ float bflo(unsigned u) { return __uint_as_float(u << 16); }
__device__ __forceinline__ float bfhi(unsigned u) { return __uint_as_float(u & 0xffff0000u); }
__device__ __forceinline__ float sigm(float x) { return __builtin_amdgcn_rcpf(1.0f + __builtin_amdgcn_exp2f(x * -1.4426950408889634f)); }
constexpr float NORM_EPS = 1e-6f;
__device__ __forceinline__ float row_rstd(const float* P, int row) { const f32x4* p = (const f32x4*)(P + (size_t)row * 16); const f32x4 a = p[0], b = p[1], c = p[2], d = p[3];
    const float s = ((a[0] + a[1]) + (a[2] + a[3])) + ((b[0] + b[1]) + (b[2] + b[3])) + ((c[0] + c[1]) + (c[2] + c[3])) + ((d[0] + d[1]) + (d[2] + d[3])); return rsqrtf(s * (1.0f / 1024.0f) + NORM_EPS); }

struct EpiIn {
    static constexpr bool PERM = true, AFTER_DRAIN = false;
    bf16_t *Q, *KV, *A, *G; const float* ss;
    __device__ __forceinline__ void operator()(const f32x4 (&acc)[2][2][4][2], const Unit& u, int wr, int wc, int fr, int fq) const {
        const int row0 = u.pm * BM + wr * 64 + fr, pn = u.pn, cw = wc * 32 + 8 * fq;
        if (pn >= 5 && pn < 9) {
#pragma unroll
            for (int ai = 0; ai < 2; ++ai)
#pragma unroll
                for (int m = 0; m < 4; ++m) { const int row = row0 + ai * HALF + m * 16; const float rs = row_rstd(ss, row);
                    const f32x4 u0 = acc[ai][0][m][0] * rs, u1 = acc[ai][0][m][1] * rs, g0 = acc[ai][1][m][0] * rs, g1 = acc[ai][1][m][1] * rs;
                    u32x4 w; w.x = pk2(u0[0] * sigm(g0[0]), u0[1] * sigm(g0[1])); w.y = pk2(u0[2] * sigm(g0[2]), u0[3] * sigm(g0[3]));
                    w.z = pk2(u1[0] * sigm(g1[0]), u1[1] * sigm(g1[1])); w.w = pk2(u1[2] * sigm(g1[2]), u1[3] * sigm(g1[3]));
                    *(u32x4*)(A + (size_t)row * 512 + (pn - 5) * 128 + cw) = w; }
        } else {
            bf16_t* base; int pitch; const bool sg = pn >= 9;
            if (pn < 4) { base = Q + pn * 256 + cw; pitch = 1024; } else if (pn == 4) { base = KV + cw; pitch = 256; } else { base = G + (pn - 9) * 256 + cw; pitch = 2048; }
#pragma unroll
            for (int ai = 0; ai < 2; ++ai)
#pragma unroll
                for (int m = 0; m < 4; ++m) { const int row = row0 + ai * HALF + m * 16; const float rs = row_rstd(ss, row);
                    bf16_t* rowp = base + (size_t)row * pitch;
#pragma unroll
                    for (int bj = 0; bj < 2; ++bj) { f32x4 v0 = acc[ai][bj][m][0] * rs, v1 = acc[ai][bj][m][1] * rs;
                        if (sg) { v0 = (f32x4){sigm(v0[0]), sigm(v0[1]), sigm(v0[2]), sigm(v0[3])}; v1 = (f32x4){sigm(v1[0]), sigm(v1[1]), sigm(v1[2]), sigm(v1[3])}; }
                        u32x4 w; w.x = pk2(v0[0], v0[1]); w.y = pk2(v0[2], v0[3]); w.z = pk2(v1[0], v1[1]); w.w = pk2(v1[2], v1[3]);
                        *(u32x4*)(rowp + bj * HALF) = w; } }
        }
    }
};
struct EpiMerge {
    static constexpr bool PERM = true, AFTER_DRAIN = false;
    bf16_t* AO; const bf16_t* G;
    __device__ __forceinline__ void operator()(const f32x4 (&acc)[2][2][4][2], const Unit& u, int wr, int wc, int fr, int fq) const {
        const int row0 = u.pm * BM + wr * 64 + fr, col0 = u.pn * BM + wc * 32 + 8 * fq;
#pragma unroll
        for (int ai = 0; ai < 2; ++ai)
#pragma unroll
            for (int m = 0; m < 4; ++m) { const int row = row0 + ai * HALF + m * 16;
#pragma unroll
                for (int bj = 0; bj < 2; ++bj) { const int col = col0 + bj * HALF;
                    bf16_t* aop = AO + (size_t)row * 1024 + col; const bf16_t* gp = G + (size_t)row * 2048 + col;
                    const u32x4 ao = *(const u32x4*)aop, ga = *(const u32x4*)gp, gb = *(const u32x4*)(gp + 1024);
                    const f32x4 c0 = acc[ai][bj][m][0], c1 = acc[ai][bj][m][1];
                    u32x4 w;
                    w.x = pk2(bflo(ga.x) * bflo(ao.x) + bflo(gb.x) * c0[0], bfhi(ga.x) * bfhi(ao.x) + bfhi(gb.x) * c0[1]);
                    w.y = pk2(bflo(ga.y) * bflo(ao.y) + bflo(gb.y) * c0[2], bfhi(ga.y) * bfhi(ao.y) + bfhi(gb.y) * c0[3]);
                    w.z = pk2(bflo(ga.z) * bflo(ao.z) + bflo(gb.z) * c1[0], bfhi(ga.z) * bfhi(ao.z) + bfhi(gb.z) * c1[1]);
                    w.w = pk2(bflo(ga.w) * bflo(ao.w) + bflo(gb.w) * c1[2], bfhi(ga.w) * bfhi(ao.w) + bfhi(gb.w) * c1[3]);
                    *(u32x4*)aop = w; }
                if (m & 1) asm volatile("" ::: "memory"); }
    }
};
struct EpiRes {
    static constexpr bool PERM = false, AFTER_DRAIN = false;
    const float* xin; float* xout; bf16_t* XB; float* ssn; int nxt;
    __device__ __forceinline__ void operator()(const f32x4 (&acc)[2][2][4][2], const Unit& u, int wr, int wc, int fr, int fq) const {
        const int row0 = u.pm * BM + wr * 64 + fr, col0 = u.pn * BM + wc * 32 + 4 * fq;
#pragma unroll
        for (int ai = 0; ai < 2; ++ai)
#pragma unroll
            for (int m = 0; m < 4; ++m) { const int row = row0 + ai * HALF + m * 16; const size_t off = (size_t)row * 1024 + col0; float sq = 0.f;
#pragma unroll
                for (int bj = 0; bj < 2; ++bj)
#pragma unroll
                    for (int n = 0; n < 2; ++n) { const size_t o = off + bj * HALF + n * 16; const f32x4 v = *(const f32x4*)(xin + o) + acc[ai][bj][m][n];
                        *(f32x4*)(xout + o) = v;
                        if (nxt) { u32x2 w; w.x = pk2(v[0], v[1]); w.y = pk2(v[2], v[3]); *(u32x2*)(XB + o) = w; sq += (v[0] * v[0] + v[1] * v[1]) + (v[2] * v[2] + v[3] * v[3]); } }
                if (nxt) { sq += __shfl_xor(sq, 16); sq += __shfl_xor(sq, 32); if (fq == 0) ssn[(size_t)row * 16 + u.pn * 4 + wc] = sq; }
                if (m & 1) asm volatile("" ::: "memory"); }
    }
};
struct EpiSwiglu {
    static constexpr bool PERM = true, AFTER_DRAIN = false;
    bf16_t* ACT; const float* ss;
    __device__ __forceinline__ void operator()(const f32x4 (&acc)[2][2][4][2], const Unit& u, int wr, int wc, int fr, int fq) const {
        const int row0 = u.pm * BM + wr * 64 + fr, col = u.pn * 128 + wc * 32 + 8 * fq;
#pragma unroll
        for (int ai = 0; ai < 2; ++ai)
#pragma unroll
            for (int m = 0; m < 4; ++m) { const int row = row0 + ai * HALF + m * 16; const float rs = row_rstd(ss, row);
                const f32x4 g0 = acc[ai][0][m][0] * rs, g1 = acc[ai][0][m][1] * rs, u0 = acc[ai][1][m][0] * rs, u1 = acc[ai][1][m][1] * rs;
                u32x4 w; w.x = pk2(g0[0] * sigm(g0[0]) * u0[0], g0[1] * sigm(g0[1]) * u0[1]); w.y = pk2(g0[2] * sigm(g0[2]) * u0[2], g0[3] * sigm(g0[3]) * u0[3]);
                w.z = pk2(g1[0] * sigm(g1[0]) * u1[0], g1[1] * sigm(g1[1]) * u1[1]); w.w = pk2(g1[2] * sigm(g1[2]) * u1[2], g1[3] * sigm(g1[3]) * u1[3]);
                *(u32x4*)(ACT + (size_t)row * 2816 + col) = w; }
    }
};
template <class Epi, class Sched, bool ALIGN_EPI = false, bool SP2 = false>
__device__ __forceinline__ void gemm_phase(PG8_LAS unsigned char* lds, const Gemm g, const Sched& S, const Epi& E) {
    int tid_l = threadIdx.x; asm volatile("" : "+v"(tid_l));
    const int tid = tid_l, wid = __builtin_amdgcn_readfirstlane(tid >> 6), lane = tid & 63, wr = wid >> 2, wc = wid & 3, fr = lane & 15, fq = lane >> 4;
    const int K = g.K, nt = K / BK;
    unsigned voffA[2], voffB[2];
#pragma unroll
    for (int i = 0; i < 2; ++i) { int R, C; stage_rc(tid * 16 + i * 8192, R, C); const int Rb = Epi::PERM ? ((R & ~31) + perm32(R & 31)) : R;
        voffA[i] = (unsigned)(R * K + C) * 2u; voffB[i] = (unsigned)(Rb * K + C) * 2u; }
    const size_t kstep = (size_t)(BK * 2);
    const size_t hstep = (size_t)HALF * K * 2;
    const size_t tstep = 2 * hstep;
    const unsigned ldsw = (unsigned)wid * 1024u;
    const int aoff = lds_byte(wr * 64 + fr, fq * 8), boff = lds_byte(wc * 32 + fr, fq * 8);
#define PG8_SA(b, h) (((b) * 2 + (h)) * HTB)
#define PG8_SB(b, h) ((4 + (b) * 2 + (h)) * HTB)
#define PG8_STAGE(bufoff, gbase, voff) do { _Pragma("unroll") for (int _i = 0; _i < 2; ++_i) \
        __builtin_amdgcn_global_load_lds((const unsigned*)((const char*)(gbase) + (voff)[_i]), (PG8_LAS unsigned*)(lds + (bufoff) + ldsw + _i * 8192), 16, 0, 0); } while (0)
#define PG8_LDA(dst, b, h) do { _Pragma("unroll") for (int m = 0; m < 4; ++m) _Pragma("unroll") for (int k = 0; k < 2; ++k) dst[m][k] = *(const PG8_LAS bf16x8*)(lds + PG8_SA(b, h) + aoff + m * 2048 + k * 1024); } while (0)
#define PG8_LDB(dst, b, h) do { _Pragma("unroll") for (int n = 0; n < 2; ++n) _Pragma("unroll") for (int k = 0; k < 2; ++k) dst[n][k] = *(const PG8_LAS bf16x8*)(lds + PG8_SB(b, h) + boff + n * 2048 + k * 1024); } while (0)
#define PG8_MMA(ai, bj, At, Bt) do { __builtin_amdgcn_s_setprio(1); _Pragma("unroll") for (int m = 0; m < 4; ++m) _Pragma("unroll") for (int n = 0; n < 2; ++n) _Pragma("unroll") for (int k = 0; k < 2; ++k) \
        acc[ai][bj][m][n] = __builtin_amdgcn_mfma_f32_16x16x32_bf16(Bt[n][k], At[m][k], acc[ai][bj][m][n], 0, 0, 0); __builtin_amdgcn_s_setprio(0); } while (0)
#define PG8_WAIT_V(n) asm volatile("s_waitcnt vmcnt(" #n ")" ::: "memory")
#define PG8_WAIT_L(n) asm volatile("s_waitcnt lgkmcnt(" #n ")" ::: "memory")
#define PG8_BAR __builtin_amdgcn_s_barrier()
#define PG8_SCHED __builtin_amdgcn_sched_barrier(0)
    Unit cur, nxt; int ui = 0;
    if (!S.next(0, cur)) return;
    f32x4 acc[2][2][4][2];
#pragma unroll
    for (int a = 0; a < 2; ++a)
#pragma unroll
        for (int b = 0; b < 2; ++b)
#pragma unroll
            for (int m = 0; m < 4; ++m)
#pragma unroll
                for (int n = 0; n < 2; ++n) acc[a][b][m][n] = (f32x4){0.f, 0.f, 0.f, 0.f};
    bf16x8 At[4][2], B0[2][2], B1[2][2];
    const char* cA = (const char*)g.A + (size_t)cur.pm * tstep; const char* cB = (const char*)g.Bt + (size_t)cur.pn * tstep;
    S.a_ready(cur);
    if constexpr (SP2) {
        PG8_STAGE(PG8_SB(0, 0), cB, voffB); PG8_STAGE(PG8_SB(0, 1), cB + hstep, voffB); PG8_STAGE(PG8_SA(0, 0), cA, voffA); PG8_STAGE(PG8_SA(0, 1), cA + hstep, voffA);
        if (wr == 1) PG8_BAR;
        PG8_WAIT_V(2); PG8_BAR;
        PG8_STAGE(PG8_SB(1, 0), cB + kstep, voffB); PG8_STAGE(PG8_SA(1, 0), cA + kstep, voffA); PG8_STAGE(PG8_SB(1, 1), cB + hstep + kstep, voffB);
        PG8_WAIT_V(6); PG8_BAR;
    } else {
        PG8_STAGE(PG8_SB(0, 0), cB, voffB); PG8_STAGE(PG8_SA(0, 0), cA, voffA); PG8_STAGE(PG8_SB(0, 1), cB + hstep, voffB); PG8_STAGE(PG8_SA(0, 1), cA + hstep, voffA);
        if (wr == 1) PG8_BAR;
        PG8_WAIT_V(4); PG8_BAR;
        PG8_STAGE(PG8_SB(1, 0), cB + kstep, voffB); PG8_STAGE(PG8_SA(1, 0), cA + kstep, voffA); PG8_STAGE(PG8_SB(1, 1), cB + hstep + kstep, voffB);
        PG8_WAIT_V(6); PG8_BAR;
    }
    for (;;) {
        const bool has_next = S.next(ui + 1, nxt);
        const char* nA = has_next ? (const char*)g.A + (size_t)nxt.pm * tstep : cA; const char* nB = has_next ? (const char*)g.Bt + (size_t)nxt.pn * tstep : cB;
        for (int t = 0; t < nt; t += 2) {
            const bool last = (t == nt - 2);
            const char* a1 = cA + (size_t)(t + 1) * kstep;
            const char* a2 = last ? nA : cA + (size_t)(t + 2) * kstep; const char* b2 = last ? nB : cB + (size_t)(t + 2) * kstep;
            const char* a3 = a2 + kstep; const char* b3 = b2 + kstep;
            if (last && has_next) S.a_ready(nxt);
            if constexpr (SP2) {
            PG8_LDB(B0, 0, 0); PG8_LDB(B1, 0, 1); PG8_SCHED; PG8_LDA(At, 0, 0); PG8_STAGE(PG8_SA(1, 1), a1 + hstep, voffA);
            PG8_WAIT_V(8); PG8_WAIT_L(0); PG8_BAR; PG8_MMA(0, 0, At, B0); PG8_MMA(0, 1, At, B1); PG8_BAR; PG8_SCHED;
            PG8_LDA(At, 0, 1); PG8_STAGE(PG8_SB(0, 0), b2, voffB); PG8_STAGE(PG8_SB(0, 1), b2 + hstep, voffB); PG8_STAGE(PG8_SA(0, 0), a2, voffA);
            PG8_WAIT_V(8); PG8_WAIT_L(0); PG8_BAR; PG8_MMA(1, 0, At, B0); PG8_MMA(1, 1, At, B1); PG8_BAR; PG8_SCHED;
            PG8_LDB(B0, 1, 0); PG8_LDB(B1, 1, 1); PG8_SCHED; PG8_LDA(At, 1, 0); PG8_STAGE(PG8_SA(0, 1), a2 + hstep, voffA);
            PG8_WAIT_V(8); PG8_WAIT_L(0); PG8_BAR; PG8_MMA(0, 0, At, B0); PG8_MMA(0, 1, At, B1); PG8_BAR; PG8_SCHED;
            PG8_LDA(At, 1, 1); PG8_STAGE(PG8_SB(1, 0), b3, voffB); PG8_STAGE(PG8_SB(1, 1), b3 + hstep, voffB); PG8_STAGE(PG8_SA(1, 0), a3, voffA);
            PG8_WAIT_V(8); PG8_WAIT_L(0); PG8_BAR; PG8_MMA(1, 0, At, B0); PG8_MMA(1, 1, At, B1); PG8_BAR; PG8_SCHED;
            } else {
            PG8_LDB(B0, 0, 0); PG8_SCHED; PG8_LDA(At, 0, 0); PG8_STAGE(PG8_SA(1, 1), a1 + hstep, voffA);
            PG8_WAIT_L(8); PG8_BAR; PG8_WAIT_L(0); PG8_MMA(0, 0, At, B0); PG8_BAR; PG8_SCHED;
            PG8_LDB(B1, 0, 1); PG8_STAGE(PG8_SB(0, 0), b2, voffB);
            PG8_BAR; PG8_WAIT_L(0); PG8_MMA(0, 1, At, B1); PG8_BAR;
            PG8_LDA(At, 0, 1); PG8_STAGE(PG8_SA(0, 0), a2, voffA);
            PG8_BAR; PG8_WAIT_L(0); PG8_MMA(1, 0, At, B0); PG8_BAR; PG8_SCHED;
            PG8_STAGE(PG8_SB(0, 1), b2 + hstep, voffB);
            PG8_WAIT_V(6); PG8_BAR; PG8_MMA(1, 1, At, B1); PG8_BAR;
            PG8_LDB(B0, 1, 0); PG8_SCHED; PG8_LDA(At, 1, 0); PG8_STAGE(PG8_SA(0, 1), a2 + hstep, voffA);
            PG8_WAIT_L(8); PG8_BAR; PG8_WAIT_L(0); PG8_MMA(0, 0, At, B0); PG8_BAR; PG8_SCHED;
            PG8_LDB(B1, 1, 1); PG8_STAGE(PG8_SB(1, 0), b3, voffB);
            PG8_BAR; PG8_WAIT_L(0); PG8_MMA(0, 1, At, B1); PG8_BAR;
            PG8_LDA(At, 1, 1); PG8_STAGE(PG8_SA(1, 0), a3, voffA);
            PG8_BAR; PG8_WAIT_L(0); PG8_MMA(1, 0, At, B0); PG8_BAR; PG8_SCHED;
            PG8_STAGE(PG8_SB(1, 1), b3 + hstep, voffB);
            PG8_WAIT_V(6); PG8_BAR; PG8_MMA(1, 1, At, B1); PG8_BAR;
            }
        }
        if constexpr (ALIGN_EPI) { if (wr == 0) PG8_BAR; }
        if constexpr (!Epi::AFTER_DRAIN) { E(acc, cur, wr, wc, fr, fq); S.done(cur); }
        if (!has_next) break;
#pragma unroll
        for (int a = 0; a < 2; ++a)
#pragma unroll
            for (int b = 0; b < 2; ++b)
#pragma unroll
                for (int m = 0; m < 4; ++m)
#pragma unroll
                    for (int n = 0; n < 2; ++n) acc[a][b][m][n] = (f32x4){0.f, 0.f, 0.f, 0.f};
        cur = nxt; cA = nA; cB = nB; ++ui;
        if constexpr (ALIGN_EPI) { if (wr == 1) PG8_BAR; }
    }
    PG8_WAIT_V(0);
    if constexpr (!ALIGN_EPI) { if (wr == 0) PG8_BAR; }
    PG8_BAR;
    if constexpr (Epi::AFTER_DRAIN) { E.fused(acc, cur, wr, wc, fr, fq, lds, wid, lane); S.done(cur); }
#undef PG8_SA
#undef PG8_SB
#undef PG8_STAGE
#undef PG8_LDA
#undef PG8_LDB
#undef PG8_MMA
#undef PG8_WAIT_V
#undef PG8_WAIT_L
#undef PG8_BAR
#undef PG8_SCHED
}
}
using pg8::bf16_t; using pg8::f32x4; using pg8::u32x4; using pg8::bf16x8; using pg8::u32x2; using pg8::pk2; using pg8::bflo; using pg8::bfhi; using pg8::sigm; using pg8::NORM_EPS;
#define LAS __attribute__((address_space(3)))
constexpr int NB = 4, T = 8192, M = NB * T, D = 1024, INW = 4352, CC = 512, FF = 2816, GU = 2 * FF, DEPTH = 4, NHEAD = 16;
constexpr size_t MiB = 1u << 20;
constexpr size_t WS_SS = 450 * MiB, SS_BUF = 2 * MiB;
constexpr size_t WS_ROPE = 1 * MiB;
constexpr size_t WS_W = 2 * MiB, W_LAYER = 28 * MiB;
constexpr size_t WO_IN = 0, WO_PW = 8 * MiB + MiB / 2, WO_OUT = WO_PW + 1 * MiB, WO_GU = WO_OUT + 2 * MiB, WO_DN = WO_GU + 11 * MiB;
constexpr size_t WS_XB = 114 * MiB, WS_QO = 178 * MiB, WS_KV = 242 * MiB, WS_A = 258 * MiB, WS_G = 290 * MiB, WS_Y = 418 * MiB, WS_END = 454 * MiB;
constexpr size_t WS_ACT = 178 * MiB;
static_assert(WO_DN + (size_t)D * FF * 2 == W_LAYER && WS_W + DEPTH * W_LAYER == WS_XB && WS_ACT + (size_t)M * FF * 2 <= WS_Y, "ws map");
constexpr int LDS_BYTES = 132096;

__device__ __forceinline__ float wave_sum(float v) {
#pragma unroll
    for (int o = 1; o < 64; o <<= 1) v += __shfl_xor(v, o);
    return v;
}

namespace att {
typedef __attribute__((ext_vector_type(16))) float f32x16;
typedef __attribute__((ext_vector_type(4))) short s16x4;
constexpr int KPB = 144, VPB = 520, OFF_V = 256 * KPB;
constexpr float LOG2E = 1.4426950408889634f;
__device__ __forceinline__ int crow(int r, int hi) { return (r & 3) + 8 * (r >> 2) + 4 * hi; }

__device__ __forceinline__ void unit(LAS unsigned char* lds, int b, int kvh, int blk, bf16_t* QO, const bf16_t* KV, const float* qn, const float* kn, const float* sinks,
                                     const float* rope, int tid, int lane, int wave) {
    {
        const int row = tid >> 1, half = tid & 1, pos = blk * 128 - 128 + row; const bool valid = pos >= 0;
        const bf16_t* src = KV + (size_t)(b * T + pos) * 256 + kvh * 64 + half * 32;
        float x[32]; float ssq = 0.f;
#pragma unroll
        for (int i = 0; i < 4; ++i) { u32x4 r = (u32x4){0u, 0u, 0u, 0u}; if (valid) r = *(const u32x4*)(src + 8 * i);
            x[8 * i + 0] = bflo(r.x); x[8 * i + 1] = bfhi(r.x); x[8 * i + 2] = bflo(r.y); x[8 * i + 3] = bfhi(r.y); x[8 * i + 4] = bflo(r.z); x[8 * i + 5] = bfhi(r.z); x[8 * i + 6] = bflo(r.w); x[8 * i + 7] = bfhi(r.w); }
#pragma unroll
        for (int i = 0; i < 32; ++i) ssq += x[i] * x[i];
        ssq += __shfl_xor(ssq, 1);
        const float rstd = rsqrtf(ssq * (1.0f / 64.0f) + NORM_EPS);
#pragma unroll
        for (int i = 0; i < 8; ++i) { const f32x4 g = *(const f32x4*)(kn + half * 32 + 4 * i); x[4 * i] *= rstd * g[0]; x[4 * i + 1] *= rstd * g[1]; x[4 * i + 2] *= rstd * g[2]; x[4 * i + 3] *= rstd * g[3]; }
        if (half == 0 && valid) { const float* cs = rope + pos * 16;
#pragma unroll
            for (int i = 0; i < 8; ++i) { const float c = cs[i], s = cs[8 + i], x1 = x[i], x2 = x[8 + i]; x[i] = x1 * c - x2 * s; x[8 + i] = x2 * c + x1 * s; } }
#pragma unroll
        for (int i = 0; i < 4; ++i) { u32x4 w; w.x = pk2(x[8 * i], x[8 * i + 1]); w.y = pk2(x[8 * i + 2], x[8 * i + 3]); w.z = pk2(x[8 * i + 4], x[8 * i + 5]); w.w = pk2(x[8 * i + 6], x[8 * i + 7]);
            *(LAS u32x4*)(lds + row * KPB + half * 64 + 16 * i) = w; }
    }
    {
        const int rp = tid >> 2, c = tid & 3, pos0 = blk * 128 - 128 + 2 * rp; const bool valid = pos0 >= 0;
        const bf16_t* src = KV + (size_t)(b * T + pos0) * 256 + 128 + kvh * 64 + 16 * c;
        u32x4 r0[2], r1[2];
#pragma unroll
        for (int i = 0; i < 2; ++i) { r0[i] = (u32x4){0u, 0u, 0u, 0u}; r1[i] = r0[i]; if (valid) { r0[i] = *(const u32x4*)(src + 8 * i); r1[i] = *(const u32x4*)(src + 256 + 8 * i); } }
#pragma unroll
        for (int w = 0; w < 8; ++w) { const unsigned a = r0[w >> 2][w & 3], bb = r1[w >> 2][w & 3]; const int d = 16 * c + 2 * w;
            *(LAS unsigned*)(lds + OFF_V + d * VPB + rp * 4) = (a & 0xffffu) | (bb << 16);
            *(LAS unsigned*)(lds + OFF_V + (d + 1) * VPB + rp * 4) = (a >> 16) | (bb & 0xffff0000u); }
    }
    __syncthreads();
    const int h = kvh * 8 + wave, q = lane & 31, hi = lane >> 5;
    const float sink2 = sinks[h] * LOG2E;
#pragma unroll 1
    for (int sub = 0; sub < 4; ++sub) {
        const int tq = blk * 128 + 32 * sub + q; const size_t grow = (size_t)(b * T + tq);
        bf16_t* qp = QO + grow * 1024 + h * 64 + 8 * hi;
        float x[4][8]; float ssq = 0.f;
#pragma unroll
        for (int d0 = 0; d0 < 4; ++d0) { const u32x4 r = *(const u32x4*)(qp + 16 * d0);
            x[d0][0] = bflo(r.x); x[d0][1] = bfhi(r.x); x[d0][2] = bflo(r.y); x[d0][3] = bfhi(r.y); x[d0][4] = bflo(r.z); x[d0][5] = bfhi(r.z); x[d0][6] = bflo(r.w); x[d0][7] = bfhi(r.w); }
#pragma unroll
        for (int d0 = 0; d0 < 4; ++d0)
#pragma unroll
            for (int i = 0; i < 8; ++i) ssq += x[d0][i] * x[d0][i];
        ssq += __shfl_xor(ssq, 32);
        const float rstd = rsqrtf(ssq * (1.0f / 64.0f) + NORM_EPS) * (0.125f * LOG2E);
#pragma unroll
        for (int d0 = 0; d0 < 4; ++d0) { const f32x4 g0 = *(const f32x4*)(qn + 16 * d0 + 8 * hi), g1 = *(const f32x4*)(qn + 16 * d0 + 8 * hi + 4);
            x[d0][0] *= rstd * g0[0]; x[d0][1] *= rstd * g0[1]; x[d0][2] *= rstd * g0[2]; x[d0][3] *= rstd * g0[3]; x[d0][4] *= rstd * g1[0]; x[d0][5] *= rstd * g1[1]; x[d0][6] *= rstd * g1[2]; x[d0][7] *= rstd * g1[3]; }
        { const float* cs = rope + tq * 16;
#pragma unroll
            for (int i = 0; i < 8; ++i) { const float c = cs[i], s = cs[8 + i], me = x[0][i], ot = __shfl_xor(me, 32); x[0][i] = hi == 0 ? me * c - ot * s : me * c + ot * s; } }
        bf16x8 qf[4];
#pragma unroll
        for (int d0 = 0; d0 < 4; ++d0) { u32x4 w; w.x = pk2(x[d0][0], x[d0][1]); w.y = pk2(x[d0][2], x[d0][3]); w.z = pk2(x[d0][4], x[d0][5]); w.w = pk2(x[d0][6], x[d0][7]); qf[d0] = __builtin_bit_cast(bf16x8, w); }
        f32x16 p[5];
#pragma unroll
        for (int kt = 0; kt < 5; ++kt) {
#pragma unroll
            for (int r = 0; r < 16; ++r) p[kt][r] = 0.f;
#pragma unroll
            for (int d0 = 0; d0 < 4; ++d0) { const bf16x8 kf = *(const LAS bf16x8*)(lds + (32 * (sub + kt) + q) * KPB + (16 * d0 + 8 * hi) * 2);
                p[kt] = __builtin_amdgcn_mfma_f32_32x32x16_bf16(kf, qf[d0], p[kt], 0, 0, 0); } }
        const bool first = (blk == 0);
        float mx = sink2;
#pragma unroll
        for (int kt = 0; kt < 5; ++kt) { const bool dead = first && (sub + kt < 4);
#pragma unroll
            for (int r = 0; r < 16; ++r) { const int j = crow(r, hi); bool ok = true; if (kt == 0) ok = j > q; if (kt == 4) ok = j <= q; if (dead) ok = false;
                const float v = ok ? p[kt][r] : -INFINITY; p[kt][r] = v; mx = fmaxf(mx, v); } }
        mx = fmaxf(mx, __shfl_xor(mx, 32));
        float lsum = 0.f;
#pragma unroll
        for (int kt = 0; kt < 5; ++kt)
#pragma unroll
            for (int r = 0; r < 16; ++r) { const float e = __builtin_amdgcn_exp2f(p[kt][r] - mx); p[kt][r] = e; lsum += e; }
        lsum += __shfl_xor(lsum, 32); lsum += __builtin_amdgcn_exp2f(sink2 - mx);
        const float inv = 1.0f / lsum;
        f32x16 o[2];
#pragma unroll
        for (int r = 0; r < 16; ++r) { o[0][r] = 0.f; o[1][r] = 0.f; }
#pragma unroll
        for (int kt = 0; kt < 5; ++kt)
#pragma unroll
            for (int s = 0; s < 2; ++s) { u32x4 w; w.x = pk2(p[kt][8 * s], p[kt][8 * s + 1]); w.y = pk2(p[kt][8 * s + 2], p[kt][8 * s + 3]); w.z = pk2(p[kt][8 * s + 4], p[kt][8 * s + 5]); w.w = pk2(p[kt][8 * s + 6], p[kt][8 * s + 7]);
                const bf16x8 pf = __builtin_bit_cast(bf16x8, w);
#pragma unroll
                for (int d0 = 0; d0 < 2; ++d0) { const LAS unsigned char* vp = lds + OFF_V + (32 * d0 + q) * VPB + (32 * (sub + kt) + 16 * s + 4 * hi) * 2;
                    const s16x4 lo = *(const LAS s16x4*)vp, hi4 = *(const LAS s16x4*)(vp + 16);
                    const bf16x8 vf = (bf16x8){lo[0], lo[1], lo[2], lo[3], hi4[0], hi4[1], hi4[2], hi4[3]};
                    o[d0] = __builtin_amdgcn_mfma_f32_32x32x16_bf16(vf, pf, o[d0], 0, 0, 0); } }
        bf16_t* op = QO + grow * 1024 + h * 64 + 4 * hi;
#pragma unroll
        for (int d0 = 0; d0 < 2; ++d0)
#pragma unroll
            for (int g = 0; g < 4; ++g) { u32x2 w; w.x = pk2(o[d0][4 * g] * inv, o[d0][4 * g + 1] * inv); w.y = pk2(o[d0][4 * g + 2] * inv, o[d0][4 * g + 3] * inv);
                *(u32x2*)(op + 32 * d0 + 8 * g) = w; }
    }
    __syncthreads();
}
}

namespace cv {
constexpr int ROWS = 62, OFF_Y = ROWS * 1024;
__device__ __forceinline__ void unit(LAS unsigned char* lds, int un, const bf16_t* A, bf16_t* Y, const float* cw, const float* cb, const float* lg, const float* lb, int tid, int lane, int wave) {
    const int t0 = un * 32, p0 = t0 & (T - 1);
    for (int idx = tid; idx < ROWS * 64; idx += 512) { const int r = idx >> 6, ch = idx & 63; u32x4 v = (u32x4){0u, 0u, 0u, 0u};
        if (p0 - 30 + r >= 0) v = *(const u32x4*)(A + (size_t)(t0 - 30 + r) * CC + ch * 8);
        *(LAS u32x4*)(lds + r * 1024 + ch * 16) = v; }
    __syncthreads();
    {
        const int cp = tid & 255, tg = tid >> 8;
        float w0[31], w1[31];
#pragma unroll
        for (int j = 0; j < 31; ++j) { const pg8::f32x2_t w = *(const pg8::f32x2_t*)(cw + j * CC + 2 * cp); w0[j] = w.x; w1[j] = w.y; }
        const pg8::f32x2_t bias = *(const pg8::f32x2_t*)(cb + 2 * cp);
#pragma unroll 1
        for (int sb = 0; sb < 2; ++sb) { const int tb = 16 * tg + 8 * sb;
            float a0[8], a1[8];
#pragma unroll
            for (int i = 0; i < 8; ++i) { a0[i] = bias.x; a1[i] = bias.y; }
#pragma unroll
            for (int rr = 0; rr < 38; ++rr) { const unsigned v = *(const LAS unsigned*)(lds + (tb + rr) * 1024 + cp * 4); const float v0 = bflo(v), v1 = bfhi(v);
#pragma unroll
                for (int i = 0; i < 8; ++i) { const int j = rr - i; if (j >= 0 && j <= 30) { a0[i] += w0[j] * v0; a1[i] += w1[j] * v1; } } }
#pragma unroll
            for (int i = 0; i < 8; ++i) *(LAS pg8::f32x2_t*)(lds + OFF_Y + (tb + i) * 2048 + cp * 8) = (pg8::f32x2_t){a0[i], a1[i]}; }
    }
    __syncthreads();
    {
        const f32x4 g0 = *(const f32x4*)(lg + 4 * lane), g1 = *(const f32x4*)(lg + 256 + 4 * lane), b0 = *(const f32x4*)(lb + 4 * lane), b1 = *(const f32x4*)(lb + 256 + 4 * lane);
#pragma unroll
        for (int k = 0; k < 4; ++k) { const int tok = 4 * wave + k;
            f32x4 v0 = *(const LAS f32x4*)(lds + OFF_Y + tok * 2048 + lane * 16), v1 = *(const LAS f32x4*)(lds + OFF_Y + tok * 2048 + 1024 + lane * 16);
            const float mean = wave_sum((v0[0] + v0[1]) + (v0[2] + v0[3]) + (v1[0] + v1[1]) + (v1[2] + v1[3])) * (1.0f / 512.0f);
            v0 = v0 - mean; v1 = v1 - mean;
            const float var = wave_sum((v0[0] * v0[0] + v0[1] * v0[1]) + (v0[2] * v0[2] + v0[3] * v0[3]) + (v1[0] * v1[0] + v1[1] * v1[1]) + (v1[2] * v1[2] + v1[3] * v1[3])) * (1.0f / 512.0f);
            const float rstd = rsqrtf(var + NORM_EPS);
            v0 = v0 * rstd * g0 + b0; v1 = v1 * rstd * g1 + b1;
            u32x2 w0, w1; w0.x = pk2(v0[0] * sigm(v0[0]), v0[1] * sigm(v0[1])); w0.y = pk2(v0[2] * sigm(v0[2]), v0[3] * sigm(v0[3]));
            w1.x = pk2(v1[0] * sigm(v1[0]), v1[1] * sigm(v1[1])); w1.y = pk2(v1[2] * sigm(v1[2]), v1[3] * sigm(v1[3]));
            bf16_t* yp = Y + (size_t)(t0 + tok) * CC + 4 * lane; *(u32x2*)yp = w0; *(u32x2*)(yp + 256) = w1; }
    }
    __syncthreads();
}
}
__device__ __forceinline__ void transpose_item(const float* W, int K, int N, bf16_t* WT, int k0, int n0s, int n0d, const float* gain, LAS float* scr, int lane) {
#pragma unroll 8
    for (int i = 0; i < 32; ++i) { const int kk = 2 * i + (lane >> 5); float w = W[(size_t)(k0 + kk) * N + n0s + (lane & 31)]; if (gain) w *= gain[k0 + kk]; scr[kk * 33 + (lane & 31)] = w; }
    asm volatile("s_waitcnt lgkmcnt(0)" ::: "memory");
    const int c = lane & 7;
#pragma unroll
    for (int j = 0; j < 4; ++j) { const int n = (lane >> 3) + 8 * j; const LAS float* s = scr + (8 * c) * 33 + n;
        u32x4 o; o.x = pk2(s[0 * 33], s[1 * 33]); o.y = pk2(s[2 * 33], s[3 * 33]); o.z = pk2(s[4 * 33], s[5 * 33]); o.w = pk2(s[6 * 33], s[7 * 33]);
        *(u32x4*)(WT + (size_t)(n0d + n) * K + k0 + 8 * c) = o; }
    asm volatile("s_waitcnt lgkmcnt(0)" ::: "memory");
}
__device__ __forceinline__ int perm_in(int n0d) { const int pn = n0d >> 8, h = (n0d >> 7) & 1, j = n0d & 127; if (pn >= 5 && pn < 9) return (h ? 1792 : 1280) + 128 * (pn - 5) + j; return n0d; }
__device__ __forceinline__ int perm_gu(int n0d) { const int pn = n0d >> 8, h = (n0d >> 7) & 1, j = n0d & 127; return (h ? FF : 0) + 128 * pn + j; }

struct Args { const float* in[15]; float* out; unsigned char* ws; int ph_lo, ph_hi; };
enum { I_X = 0, I_NMIX, I_WIN, I_QN, I_KN, I_SINK, I_CW, I_CB, I_LG, I_LB, I_WPW, I_WOUT, I_NFFN, I_WGU, I_WDN };

__device__ __forceinline__ void prologue(const Args& a, LAS unsigned char* lds, int tid, int lane, int wave) {
    LAS float* scr = (LAS float*)(lds + wave * 16384);
    const int gw = blockIdx.x * 8 + wave, NGW = gridDim.x * 8;
    constexpr int I_IN = (D / 64) * (INW / 32), I_PW = (CC / 64) * (D / 32), I_OUT = (D / 64) * (D / 32), I_GU = (D / 64) * (GU / 32), I_DN = (FF / 64) * (D / 32), PER_L = I_IN + I_PW + I_OUT + I_GU + I_DN;
    for (int it = gw; it < DEPTH * PER_L; it += NGW) {
        const int l = it / PER_L; int r = it % PER_L; unsigned char* wb = a.ws + WS_W + (size_t)l * W_LAYER;
        if (r < I_IN) { const int nblk = INW / 32, kb = r / nblk, nb = r % nblk; transpose_item(a.in[I_WIN] + (size_t)l * D * INW, D, INW, (bf16_t*)(wb + WO_IN), 64 * kb, perm_in(32 * nb), 32 * nb, a.in[I_NMIX] + l * D, scr, lane); continue; } r -= I_IN;
        if (r < I_PW) { const int nblk = D / 32, kb = r / nblk, nb = r % nblk; transpose_item(a.in[I_WPW] + (size_t)l * CC * D, CC, D, (bf16_t*)(wb + WO_PW), 64 * kb, 32 * nb, 32 * nb, nullptr, scr, lane); continue; } r -= I_PW;
        if (r < I_OUT) { const int nblk = D / 32, kb = r / nblk, nb = r % nblk; transpose_item(a.in[I_WOUT] + (size_t)l * D * D, D, D, (bf16_t*)(wb + WO_OUT), 64 * kb, 32 * nb, 32 * nb, nullptr, scr, lane); continue; } r -= I_OUT;
        if (r < I_GU) { const int nblk = GU / 32, kb = r / nblk, nb = r % nblk; transpose_item(a.in[I_WGU] + (size_t)l * D * GU, D, GU, (bf16_t*)(wb + WO_GU), 64 * kb, perm_gu(32 * nb), 32 * nb, a.in[I_NFFN] + l * D, scr, lane); continue; } r -= I_GU;
        { const int nblk = D / 32, kb = r / nblk, nb = r % nblk; transpose_item(a.in[I_WDN] + (size_t)l * FF * D, FF, D, (bf16_t*)(wb + WO_DN), 64 * kb, 32 * nb, 32 * nb, nullptr, scr, lane); }
    }
    float* ss = (float*)(a.ws + WS_SS); bf16_t* XB = (bf16_t*)(a.ws + WS_XB);
    for (int m = gw; m < M; m += NGW) { const f32x4* xr = (const f32x4*)(a.in[I_X] + (size_t)m * D) + lane; u32x2* xo = (u32x2*)(XB + (size_t)m * D) + lane; float s = 0.f;
#pragma unroll
        for (int j = 0; j < 4; ++j) { const f32x4 v = xr[64 * j]; s += (v[0] * v[0] + v[1] * v[1]) + (v[2] * v[2] + v[3] * v[3]); u32x2 w; w.x = pk2(v[0], v[1]); w.y = pk2(v[2], v[3]); xo[64 * j] = w; }
        s = wave_sum(s); if (lane < 16) ss[(size_t)m * 16 + lane] = lane == 0 ? s : 0.f; }
    float* rope = (float*)(a.ws + WS_ROPE);
    for (int i = blockIdx.x * 512 + tid; i < T * 8; i += gridDim.x * 512) { const int t = i >> 3, f = i & 7;
        double fr = 1.0; for (int k = 0; k < f; ++k) fr *= 0.19392274474868576;
        const float inv_freq = (float)fr; const float ang = (float)t * inv_freq;
        const double x = (double)ang, kq = __builtin_rint(x * 0.6366197723675814);
        const double r = __builtin_fma(-kq, 6.123233995736766e-17, __builtin_fma(-kq, 1.5707963267948966, x)), r2 = r * r;
        const double sp = r * (1.0 + r2 * (-1.0 / 6 + r2 * (1.0 / 120 + r2 * (-1.0 / 5040 + r2 * (1.0 / 362880 + r2 * (-1.0 / 39916800 + r2 * (1.0 / 6227020800.0)))))));
        const double cp = 1.0 + r2 * (-0.5 + r2 * (1.0 / 24 + r2 * (-1.0 / 720 + r2 * (1.0 / 40320 + r2 * (-1.0 / 3628800 + r2 * (1.0 / 479001600 + r2 * (-1.0 / 87178291200.0)))))));
        const int qd = ((int)kq) & 3;
        const double sn = qd == 0 ? sp : qd == 1 ? cp : qd == 2 ? -sp : -cp, cn = qd == 0 ? cp : qd == 1 ? -sp : qd == 2 ? -cp : sp;
        rope[t * 16 + f] = (float)cn; rope[t * 16 + 8 + f] = (float)sn; }
}

constexpr int N_PHASES = 1 + 6 * DEPTH;
__global__ void __launch_bounds__(512, 2) fwd_kernel(Args a) {
    extern __shared__ __attribute__((aligned(16))) unsigned char lds_raw[];
    LAS unsigned char* lds = (LAS unsigned char*)lds_raw;
    cg::grid_group grid = cg::this_grid();
    const int G = gridDim.x, bx = blockIdx.x;
    unsigned char* ws = a.ws;
    float* ss = (float*)(ws + WS_SS); const float* rope = (const float*)(ws + WS_ROPE);
    bf16_t* XB = (bf16_t*)(ws + WS_XB); bf16_t* QO = (bf16_t*)(ws + WS_QO); bf16_t* KV = (bf16_t*)(ws + WS_KV); bf16_t* AB = (bf16_t*)(ws + WS_A);
    bf16_t* GB = (bf16_t*)(ws + WS_G); bf16_t* YB = (bf16_t*)(ws + WS_Y); bf16_t* ACT = (bf16_t*)(ws + WS_ACT);
#pragma unroll 1
    for (int ph = a.ph_lo; ph < a.ph_hi; ++ph) {
        if (ph > a.ph_lo) grid.sync();
        int tid_l = threadIdx.x; asm volatile("" : "+v"(tid_l));
        const int tid = tid_l, lane = tid & 63, wave = __builtin_amdgcn_readfirstlane(tid >> 6);
        if (ph == 0) { prologue(a, lds, tid, lane, wave); continue; }
        const int l = (ph - 1) / 6, s = (ph - 1) % 6;
        const unsigned char* wb = ws + WS_W + (size_t)l * W_LAYER;
        if (s == 0) {
            pg8::Gemm g{XB, (const bf16_t*)(wb + WO_IN), M, INW, D}; pg8::StaticOrder S; S.init(M, INW, G, bx);
            pg8::EpiIn E{QO, KV, AB, GB, ss};
            pg8::gemm_phase<pg8::EpiIn, pg8::StaticOrder, true, true>(lds, g, S, E);
        } else if (s == 1) {
            for (int u = bx; u < NB * 2 * (T / 128); u += G) { const int blk = u & 63, kvh = (u >> 6) & 1, b = u >> 7;
                att::unit(lds, b, kvh, blk, QO, KV, a.in[I_QN] + l * 64, a.in[I_KN] + l * 64, a.in[I_SINK] + l * NHEAD, rope, tid, lane, wave); }
            for (int u = bx; u < M / 32; u += G)
                cv::unit(lds, u, AB, YB, a.in[I_CW] + (size_t)l * 31 * CC, a.in[I_CB] + l * CC, a.in[I_LG] + l * CC, a.in[I_LB] + l * CC, tid, lane, wave);
        } else if (s == 2) {
            pg8::Gemm g{YB, (const bf16_t*)(wb + WO_PW), M, D, CC}; pg8::StaticOrder S; S.init(M, D, G, bx);
            pg8::EpiMerge E{QO, GB};
            pg8::gemm_phase<pg8::EpiMerge, pg8::StaticOrder, true, true>(lds, g, S, E);
        } else if (s == 3) {
            pg8::Gemm g{QO, (const bf16_t*)(wb + WO_OUT), M, D, D}; pg8::StaticOrder S; S.init(M, D, G, bx);
            pg8::EpiRes E{l == 0 ? a.in[I_X] : a.out, a.out, XB, ss + (size_t)M * 16, 1};
            pg8::gemm_phase<pg8::EpiRes, pg8::StaticOrder, true, true>(lds, g, S, E);
        } else if (s == 4) {
            pg8::Gemm g{XB, (const bf16_t*)(wb + WO_GU), M, GU, D}; pg8::StaticOrder S; S.init(M, GU, G, bx);
            pg8::EpiSwiglu E{ACT, ss + (size_t)M * 16};
            pg8::gemm_phase<pg8::EpiSwiglu, pg8::StaticOrder, true, true>(lds, g, S, E);
        } else {
            pg8::Gemm g{ACT, (const bf16_t*)(wb + WO_DN), M, D, FF}; pg8::StaticOrder S; S.init(M, D, G, bx);
            pg8::EpiRes E{a.out, a.out, XB, ss, l + 1 < DEPTH ? 1 : 0};
            pg8::gemm_phase<pg8::EpiRes, pg8::StaticOrder, true, true>(lds, g, S, E);
        }
    }
}

#ifndef MK_PER_PHASE
#define MK_PER_PHASE 0
#endif
extern "C" void kernel_launch(void* const* d_in, const int* in_sizes, int n_in, void* d_out, int out_size, void* d_ws, size_t ws_size, hipStream_t stream) {
    static int grid = 0;
    if (grid == 0) {
        if (n_in != 15 || in_sizes[0] != M * D || out_size != M * D || ws_size < WS_END) { fprintf(stderr, "kernel_launch: unexpected shapes / workspace (n_in %d, ws %zu)\n", n_in, ws_size); grid = -1; return; }
        int dev = 0, cus = 0, per_cu = 0;
        (void)hipGetDevice(&dev); (void)hipDeviceGetAttribute(&cus, hipDeviceAttributeMultiprocessorCount, dev);
        if (hipFuncSetAttribute((const void*)fwd_kernel, hipFuncAttributeMaxDynamicSharedMemorySize, LDS_BYTES) != hipSuccess) { fprintf(stderr, "kernel_launch: hipFuncSetAttribute failed\n"); grid = -1; return; }
        if (hipOccupancyMaxActiveBlocksPerMultiprocessor(&per_cu, (const void*)fwd_kernel, 512, LDS_BYTES) != hipSuccess || per_cu < 1) { fprintf(stderr, "kernel_launch: occupancy query says %d\n", per_cu); per_cu = 1; }
        (void)hipGetLastError();
        grid = cus * per_cu;
    }
    if (grid < 0) return;
    Args a{};
    for (int i = 0; i < 15; ++i) a.in[i] = (const float*)d_in[i];
    a.out = (float*)d_out; a.ws = (unsigned char*)d_ws;
#if MK_PER_PHASE
    for (int ph = 0; ph < N_PHASES; ++ph) { a.ph_lo = ph; a.ph_hi = ph + 1; hipLaunchKernelGGL(fwd_kernel, dim3(grid), dim3(512), LDS_BYTES, stream, a); }
#else
    a.ph_lo = 0; a.ph_hi = N_PHASES;
    void* args[] = {&a};
    hipError_t e = hipLaunchCooperativeKernel((const void*)fwd_kernel, dim3(grid), dim3(512), args, LDS_BYTES, stream);
    if (e != hipSuccess) fprintf(stderr, "cooperative launch failed: %s (grid %d)\n", hipGetErrorString(e), grid);
#endif
}
```

```cpp
#include <hip/hip_runtime.h>
#include <hip/hip_cooperative_groups.h>
#include <cstdio>
#include <cstdint>
namespace cg = cooperative_groups;
namespace pg8 {
#define PG8_LAS __attribute__((address_space(3)))
typedef unsigned short bf16_t;
typedef short bf16x8 __attribute__((ext_vector_type(8)));
typedef float f32x4 __attribute__((ext_vector_type(4)));
typedef unsigned u32x4 __attribute__((ext_vector_type(4)));
constexpr int BM = 256, BK = 64, HALF = 128, HTB = HALF * BK * 2  , STAGE_BYTES = 8 * HTB, NXCD = 8, WGM = 8;

__host__ __device__ __forceinline__ int lds_byte(int r, int c) { const int st = (r >> 4) * 2 + (c >> 5), rr = r & 15, cc = c & 31, ob = rr * 64 + cc * 2; return st * 1024 + (ob ^ (((ob >> 9) & 1) << 5)); }
__host__ __device__ __forceinline__ void stage_rc(int b, int& R, int& C) { const int st = b / 1024, sb = b % 1024, swz = sb ^ (((sb >> 9) & 1) << 5); R = (st >> 1) * 16 + swz / 64; C = (st & 1) * 32 + (swz % 64) / 2; }
__host__ __device__ __forceinline__ int perm32(int rho) { const int n = rho >> 4, i = rho & 15; return 8 * (i >> 2) + 4 * n + (i & 3); }

struct Unit { int pm, pn; };
struct Gemm { const bf16_t* A; const bf16_t* Bt; int M, N, K; };

struct StaticOrder {
    int nM, nN, nwg, G, c;
    __host__ __device__ void init(int M, int N, int G_, int c_) { nM = M / BM; nN = N / BM; nwg = nM * nN; G = G_; c = c_; }
    __host__ __device__ bool next(int i, Unit& u) const {
        const long L = (long)i * G + c; if (L >= nwg) return false;
        int wgid = (int)L; { const int q = nwg / NXCD, r = nwg % NXCD, xcd = wgid % NXCD, off = wgid / NXCD; wgid = (xcd < r ? xcd * (q + 1) : r * (q + 1) + (xcd - r) * q) + off; }
        const int nig = WGM * nN, gid = wgid / nig, fm = gid * WGM, gsz = (nM - fm) < WGM ? (nM - fm) : WGM;
        u.pm = fm + ((wgid % nig) % gsz); u.pn = (wgid % nig) / gsz; return true;
    }
    __device__ __forceinline__ void a_ready(const Unit&) const {}
    __device__ __forceinline__ void done(const Unit&) const {}
};
typedef float f32x2_t __attribute__((ext_vector_type(2))); typedef __bf16 bf16x2_t __attribute__((ext_vector_type(2)));
typedef unsigned u32x2 __attribute__((ext_vector_type(2)));
__device__ __forceinline__ unsigned pk2(float lo, float hi) { f32x2_t v = {lo, hi}; bf16x2_t b = __builtin_convertvector(v, bf16x2_t); return __builtin_bit_cast(unsigned, b); }
__device__ __forceinline__ float bflo(unsigned u) { return __uint_as_float(u << 16); }
__device__ __forceinline__ float bfhi(unsigned u) { return __uint_as_float(u & 0xffff0000u); }
__device__ __forceinline__ float sigm(float x) { return __builtin_amdgcn_rcpf(1.0f + __builtin_amdgcn_exp2f(x * -1.4426950408889634f)); }
constexpr float NORM_EPS = 1e-6f;
__device__ __forceinline__ float row_rstd(const float* P, int row) { const f32x4* p = (const f32x4*)(P + (size_t)row * 16); const f32x4 a = p[0], b = p[1], c = p[2], d = p[3];
    const float s = ((a[0] + a[1]) + (a[2] + a[3])) + ((b[0] + b[1]) + (b[2] + b[3])) + ((c[0] + c[1]) + (c[2] + c[3])) + ((d[0] + d[1]) + (d[2] + d[3])); return rsqrtf(s * (1.0f / 1024.0f) + NORM_EPS); }

#ifndef ER_DEPTH
#define ER_DEPTH 3
#endif
#ifndef EM_DEPTH
#define EM_DEPTH 6
#endif
__device__ __forceinline__ void wave_rstd(const float* P, int rbase, int lane, float& ra, float& rb) {
    const f32x4* p = (const f32x4*)(P + (size_t)(rbase + lane) * 16); const f32x4* q = p + 4 * HALF;
    const f32x4 a0 = p[0], a1 = p[1], a2 = p[2], a3 = p[3], b0 = q[0], b1 = q[1], b2 = q[2], b3 = q[3];
    const float sa = ((a0[0] + a0[1]) + (a0[2] + a0[3])) + ((a1[0] + a1[1]) + (a1[2] + a1[3])) + ((a2[0] + a2[1]) + (a2[2] + a2[3])) + ((a3[0] + a3[1]) + (a3[2] + a3[3]));
    const float sb = ((b0[0] + b0[1]) + (b0[2] + b0[3])) + ((b1[0] + b1[1]) + (b1[2] + b1[3])) + ((b2[0] + b2[1]) + (b2[2] + b2[3])) + ((b3[0] + b3[1]) + (b3[2] + b3[3]));
    ra = rsqrtf(sa * (1.0f / 1024.0f) + NORM_EPS); rb = rsqrtf(sb * (1.0f / 1024.0f) + NORM_EPS);
}
struct EpiIn {
    static constexpr bool PERM = true, AFTER_DRAIN = false;
    bf16_t *Q, *KV, *A, *G; const float* ss;
    __device__ __forceinline__ void operator()(const f32x4 (&acc)[2][2][4][2], const Unit& u, int wr, int wc, int fr, int fq) const {
        const int row0 = u.pm * BM + wr * 64 + fr, pn = u.pn, cw = wc * 32 + 8 * fq;
        float ra, rb; wave_rstd(ss, u.pm * BM + wr * 64, fr + 16 * fq, ra, rb);
        if (pn >= 5 && pn < 9) {
#pragma unroll
            for (int ai = 0; ai < 2; ++ai)
#pragma unroll
                for (int m = 0; m < 4; ++m) { const int row = row0 + ai * HALF + m * 16; const float rs = __shfl(ai ? rb : ra, 16 * m + fr);
                    const f32x4 u0 = acc[ai][0][m][0] * rs, u1 = acc[ai][0][m][1] * rs, g0 = acc[ai][1][m][0] * rs, g1 = acc[ai][1][m][1] * rs;
                    u32x4 w; w.x = pk2(u0[0] * sigm(g0[0]), u0[1] * sigm(g0[1])); w.y = pk2(u0[2] * sigm(g0[2]), u0[3] * sigm(g0[3]));
                    w.z = pk2(u1[0] * sigm(g1[0]), u1[1] * sigm(g1[1])); w.w = pk2(u1[2] * sigm(g1[2]), u1[3] * sigm(g1[3]));
                    *(u32x4*)(A + (size_t)row * 512 + (pn - 5) * 128 + cw) = w; }
        } else {
            bf16_t* base; int pitch; const bool sg = pn >= 9 && pn < 13;
            if (pn < 4) { base = Q + pn * 256 + cw; pitch = 1024; } else if (pn == 4) { base = KV + cw; pitch = 256; } else { base = G + (pn - 9) * 256 + cw; pitch = 2048; }
#pragma unroll
            for (int ai = 0; ai < 2; ++ai)
#pragma unroll
                for (int m = 0; m < 4; ++m) { const int row = row0 + ai * HALF + m * 16; const float rs = __shfl(ai ? rb : ra, 16 * m + fr);
                    bf16_t* rowp = base + (size_t)row * pitch;
#pragma unroll
                    for (int bj = 0; bj < 2; ++bj) { f32x4 v0 = acc[ai][bj][m][0] * rs, v1 = acc[ai][bj][m][1] * rs;
                        if (sg) { v0 = (f32x4){sigm(v0[0]), sigm(v0[1]), sigm(v0[2]), sigm(v0[3])}; v1 = (f32x4){sigm(v1[0]), sigm(v1[1]), sigm(v1[2]), sigm(v1[3])}; }
                        u32x4 w; w.x = pk2(v0[0], v0[1]); w.y = pk2(v0[2], v0[3]); w.z = pk2(v1[0], v1[1]); w.w = pk2(v1[2], v1[3]);
                        *(u32x4*)(rowp + bj * HALF) = w; } }
        }
    }
};
struct EpiMerge {
    static constexpr bool PERM = true, AFTER_DRAIN = false;
    bf16_t* AO; const bf16_t* G;
    __device__ __forceinline__ void operator()(const f32x4 (&acc)[2][2][4][2], const Unit& u, int wr, int wc, int fr, int fq) const {
        const int row0 = u.pm * BM + wr * 64 + fr, col0 = u.pn * BM + wc * 32 + 8 * fq;
        constexpr int MD = EM_DEPTH; u32x4 pa[MD], pgb[MD];
#define EM_ROW(hg) (row0 + ((hg) >> 3) * HALF + (((hg) >> 1) & 3) * 16)
#define EM_COL(hg) (col0 + ((hg) & 1) * HALF)
#define EM_LOAD(hg, s) do { pa[s] = *(const u32x4*)(AO + (size_t)EM_ROW(hg) * 1024 + EM_COL(hg)); pgb[s] = *(const u32x4*)(G + (size_t)EM_ROW(hg) * 2048 + 1024 + EM_COL(hg)); } while (0)
#pragma unroll
        for (int hg = 0; hg < MD; ++hg) EM_LOAD(hg, hg);
#pragma unroll
        for (int hg = 0; hg < 16; ++hg) { const int ai = hg >> 3, m = (hg >> 1) & 3, bj = hg & 1, s = hg % MD;
            const u32x4 ao = pa[s], gb = pgb[s]; const f32x4 c0 = acc[ai][bj][m][0], c1 = acc[ai][bj][m][1];
            u32x4 w;
            w.x = pk2(bflo(ao.x) + sigm(bflo(gb.x)) * c0[0], bfhi(ao.x) + sigm(bfhi(gb.x)) * c0[1]);
            w.y = pk2(bflo(ao.y) + sigm(bflo(gb.y)) * c0[2], bfhi(ao.y) + sigm(bfhi(gb.y)) * c0[3]);
            w.z = pk2(bflo(ao.z) + sigm(bflo(gb.z)) * c1[0], bfhi(ao.z) + sigm(bfhi(gb.z)) * c1[1]);
            w.w = pk2(bflo(ao.w) + sigm(bflo(gb.w)) * c1[2], bfhi(ao.w) + sigm(bfhi(gb.w)) * c1[3]);
            *(u32x4*)(AO + (size_t)EM_ROW(hg) * 1024 + EM_COL(hg)) = w;
            if (hg + MD < 16) EM_LOAD(hg + MD, s); }
#undef EM_ROW
#undef EM_COL
#undef EM_LOAD
    }
};
struct EpiRes {
    static constexpr bool PERM = true, AFTER_DRAIN = false;
    const bf16_t* lo_in; bf16_t* lo_out; bf16_t* XB; float* fout; float* ssn; int nxt;
    __device__ __forceinline__ void operator()(const f32x4 (&acc)[2][2][4][2], const Unit& u, int wr, int wc, int fr, int fq) const {
        const int row0 = u.pm * BM + wr * 64 + fr, col0 = u.pn * BM + wc * 32 + 8 * fq;
        constexpr int RD = ER_DEPTH; u32x4 ph[RD][2], pl[RD][2];
#define ER_ROW(g) (row0 + ((g) >> 2) * HALF + ((g) & 3) * 16)
#define ER_LOAD(g, s) do { const size_t o_ = (size_t)ER_ROW(g) * 1024 + col0; ph[s][0] = *(const u32x4*)(XB + o_); ph[s][1] = *(const u32x4*)(XB + o_ + HALF); pl[s][0] = *(const u32x4*)(lo_in + o_); pl[s][1] = *(const u32x4*)(lo_in + o_ + HALF); } while (0)
#pragma unroll
        for (int g = 0; g < RD; ++g) ER_LOAD(g, g);
#pragma unroll
        for (int g = 0; g < 8; ++g) { const int ai = g >> 2, m = g & 3, s = g % RD; const int row = ER_ROW(g); const size_t off = (size_t)row * 1024 + col0; float sq = 0.f;
#pragma unroll
            for (int bj = 0; bj < 2; ++bj) { const size_t o = off + bj * HALF; const u32x4 h = ph[s][bj], l = pl[s][bj];
                const f32x4 v0 = (f32x4){bflo(h.x) + bflo(l.x), bfhi(h.x) + bfhi(l.x), bflo(h.y) + bflo(l.y), bfhi(h.y) + bfhi(l.y)} + acc[ai][bj][m][0];
                const f32x4 v1 = (f32x4){bflo(h.z) + bflo(l.z), bfhi(h.z) + bfhi(l.z), bflo(h.w) + bflo(l.w), bfhi(h.w) + bfhi(l.w)} + acc[ai][bj][m][1];
                if (nxt) { u32x4 w; w.x = pk2(v0[0], v0[1]); w.y = pk2(v0[2], v0[3]); w.z = pk2(v1[0], v1[1]); w.w = pk2(v1[2], v1[3]); *(u32x4*)(XB + o) = w;
                    u32x4 r; r.x = pk2(v0[0] - bflo(w.x), v0[1] - bfhi(w.x)); r.y = pk2(v0[2] - bflo(w.y), v0[3] - bfhi(w.y)); r.z = pk2(v1[0] - bflo(w.z), v1[1] - bfhi(w.z)); r.w = pk2(v1[2] - bflo(w.w), v1[3] - bfhi(w.w));
                    *(u32x4*)(lo_out + o) = r;
                    sq += ((v0[0] * v0[0] + v0[1] * v0[1]) + (v0[2] * v0[2] + v0[3] * v0[3])) + ((v1[0] * v1[0] + v1[1] * v1[1]) + (v1[2] * v1[2] + v1[3] * v1[3])); }
                else { *(f32x4*)(fout + o) = v0; *(f32x4*)(fout + o + 4) = v1; } }
            if (nxt) { sq += __shfl_xor(sq, 16); sq += __shfl_xor(sq, 32); if (fq == 0) ssn[(size_t)row * 16 + u.pn * 4 + wc] = sq; }
            if (g + RD < 8) ER_LOAD(g + RD, s); }
#undef ER_ROW
#undef ER_LOAD
    }
};
struct EpiSwiglu {
    static constexpr bool PERM = true, AFTER_DRAIN = false;
    bf16_t* ACT; const float* ss;
    __device__ __forceinline__ void operator()(const f32x4 (&acc)[2][2][4][2], const Unit& u, int wr, int wc, int fr, int fq) const {
        const int row0 = u.pm * BM + wr * 64 + fr, col = u.pn * 128 + wc * 32 + 8 * fq;
        float ra, rb; wave_rstd(ss, u.pm * BM + wr * 64, fr + 16 * fq, ra, rb);
#pragma unroll
        for (int ai = 0; ai < 2; ++ai)
#pragma unroll
            for (int m = 0; m < 4; ++m) { const int row = row0 + ai * HALF + m * 16; const float rs = __shfl(ai ? rb : ra, 16 * m + fr);
                const f32x4 g0 = acc[ai][0][m][0] * rs, g1 = acc[ai][0][m][1] * rs, u0 = acc[ai][1][m][0] * rs, u1 = acc[ai][1][m][1] * rs;
                u32x4 w; w.x = pk2(g0[0] * sigm(g0[0]) * u0[0], g0[1] * sigm(g0[1]) * u0[1]); w.y = pk2(g0[2] * sigm(g0[2]) * u0[2], g0[3] * sigm(g0[3]) * u0[3]);
                w.z = pk2(g1[0] * sigm(g1[0]) * u1[0], g1[1] * sigm(g1[1]) * u1[1]); w.w = pk2(g1[2] * sigm(g1[2]) * u1[2], g1[3] * sigm(g1[3]) * u1[3]);
                *(u32x4*)(ACT + (size_t)row * 2816 + col) = w; }
    }
};
template <class Epi, class Sched, bool ALIGN_EPI = false, bool SP2 = false>
__device__ __forceinline__ void gemm_phase(PG8_LAS unsigned char* lds, const Gemm g, const Sched& S, const Epi& E) {
    int tid_l = threadIdx.x; asm volatile("" : "+v"(tid_l));
    const int tid = tid_l, wid = __builtin_amdgcn_readfirstlane(tid >> 6), lane = tid & 63, wr = wid >> 2, wc = wid & 3, fr = lane & 15, fq = lane >> 4;
    const int K = g.K, nt = K / BK;
    unsigned voffA[2], voffB[2];
#pragma unroll
    for (int i = 0; i < 2; ++i) { int R, C; stage_rc(tid * 16 + i * 8192, R, C); const int Rb = Epi::PERM ? ((R & ~31) + perm32(R & 31)) : R;
        voffA[i] = (unsigned)(R * K + C) * 2u; voffB[i] = (unsigned)(Rb * K + C) * 2u; }
    const size_t kstep = (size_t)(BK * 2);
    const size_t hstep = (size_t)HALF * K * 2;
    const size_t tstep = 2 * hstep;
    const unsigned ldsw = (unsigned)wid * 1024u;
    const int aoff = lds_byte(wr * 64 + fr, fq * 8), boff = lds_byte(wc * 32 + fr, fq * 8);
#define PG8_SA(b, h) (((b) * 2 + (h)) * HTB)
#define PG8_SB(b, h) ((4 + (b) * 2 + (h)) * HTB)
#define PG8_STAGE(bufoff, gbase, voff) do { _Pragma("unroll") for (int _i = 0; _i < 2; ++_i) \
        __builtin_amdgcn_global_load_lds((const unsigned*)((const char*)(gbase) + (voff)[_i]), (PG8_LAS unsigned*)(lds + (bufoff) + ldsw + _i * 8192), 16, 0, 0); } while (0)
#define PG8_LDA(dst, b, h) do { _Pragma("unroll") for (int m = 0; m < 4; ++m) _Pragma("unroll") for (int k = 0; k < 2; ++k) dst[m][k] = *(const PG8_LAS bf16x8*)(lds + PG8_SA(b, h) + aoff + m * 2048 + k * 1024); } while (0)
#define PG8_LDB(dst, b, h) do { _Pragma("unroll") for (int n = 0; n < 2; ++n) _Pragma("unroll") for (int k = 0; k < 2; ++k) dst[n][k] = *(const PG8_LAS bf16x8*)(lds + PG8_SB(b, h) + boff + n * 2048 + k * 1024); } while (0)
#define PG8_MMA(ai, bj, At, Bt) do { __builtin_amdgcn_s_setprio(1); _Pragma("unroll") for (int m = 0; m < 4; ++m) _Pragma("unroll") for (int n = 0; n < 2; ++n) _Pragma("unroll") for (int k = 0; k < 2; ++k) \
        acc[ai][bj][m][n] = __builtin_amdgcn_mfma_f32_16x16x32_bf16(Bt[n][k], At[m][k], acc[ai][bj][m][n], 0, 0, 0); __builtin_amdgcn_s_setprio(0); } while (0)
#define PG8_WAIT_V(n) asm volatile("s_waitcnt vmcnt(" #n ")" ::: "memory")
#define PG8_WAIT_L(n) asm volatile("s_waitcnt lgkmcnt(" #n ")" ::: "memory")
#define PG8_BAR __builtin_amdgcn_s_barrier()
#define PG8_SCHED __builtin_amdgcn_sched_barrier(0)
    Unit cur, nxt; int ui = 0;
    if (!S.next(0, cur)) return;
    f32x4 acc[2][2][4][2];
#pragma unroll
    for (int a = 0; a < 2; ++a)
#pragma unroll
        for (int b = 0; b < 2; ++b)
#pragma unroll
            for (int m = 0; m < 4; ++m)
#pragma unroll
                for (int n = 0; n < 2; ++n) acc[a][b][m][n] = (f32x4){0.f, 0.f, 0.f, 0.f};
    bf16x8 At[4][2], B0[2][2], B1[2][2];
    const char* cA = (const char*)g.A + (size_t)cur.pm * tstep; const char* cB = (const char*)g.Bt + (size_t)cur.pn * tstep;
    S.a_ready(cur);
    if constexpr (SP2) {
        PG8_STAGE(PG8_SB(0, 0), cB, voffB); PG8_STAGE(PG8_SB(0, 1), cB + hstep, voffB); PG8_STAGE(PG8_SA(0, 0), cA, voffA); PG8_STAGE(PG8_SA(0, 1), cA + hstep, voffA);
        if (wr == 1) PG8_BAR;
        PG8_WAIT_V(2); PG8_BAR;
        PG8_STAGE(PG8_SB(1, 0), cB + kstep, voffB); PG8_STAGE(PG8_SA(1, 0), cA + kstep, voffA); PG8_STAGE(PG8_SB(1, 1), cB + hstep + kstep, voffB);
        PG8_WAIT_V(6); PG8_BAR;
    } else {
        PG8_STAGE(PG8_SB(0, 0), cB, voffB); PG8_STAGE(PG8_SA(0, 0), cA, voffA); PG8_STAGE(PG8_SB(0, 1), cB + hstep, voffB); PG8_STAGE(PG8_SA(0, 1), cA + hstep, voffA);
        if (wr == 1) PG8_BAR;
        PG8_WAIT_V(4); PG8_BAR;
        PG8_STAGE(PG8_SB(1, 0), cB + kstep, voffB); PG8_STAGE(PG8_SA(1, 0), cA + kstep, voffA); PG8_STAGE(PG8_SB(1, 1), cB + hstep + kstep, voffB);
        PG8_WAIT_V(6); PG8_BAR;
    }
    for (;;) {
        const bool has_next = S.next(ui + 1, nxt);
        const char* nA = has_next ? (const char*)g.A + (size_t)nxt.pm * tstep : cA; const char* nB = has_next ? (const char*)g.Bt + (size_t)nxt.pn * tstep : cB;
        for (int t = 0; t < nt; t += 2) {
            const bool last = (t == nt - 2);
            const char* a1 = cA + (size_t)(t + 1) * kstep;
            const char* a2 = last ? nA : cA + (size_t)(t + 2) * kstep; const char* b2 = last ? nB : cB + (size_t)(t + 2) * kstep;
            const char* a3 = a2 + kstep; const char* b3 = b2 + kstep;
            if (last && has_next) S.a_ready(nxt);
            if constexpr (SP2) {
            PG8_LDB(B0, 0, 0); PG8_LDB(B1, 0, 1); PG8_SCHED; PG8_LDA(At, 0, 0); PG8_STAGE(PG8_SA(1, 1), a1 + hstep, voffA);
            PG8_WAIT_V(8); PG8_WAIT_L(0); PG8_BAR; PG8_MMA(0, 0, At, B0); PG8_MMA(0, 1, At, B1); PG8_BAR; PG8_SCHED;
            PG8_LDA(At, 0, 1); PG8_STAGE(PG8_SB(0, 0), b2, voffB); PG8_STAGE(PG8_SB(0, 1), b2 + hstep, voffB); PG8_STAGE(PG8_SA(0, 0), a2, voffA);
            PG8_WAIT_V(8); PG8_WAIT_L(0); PG8_BAR; PG8_MMA(1, 0, At, B0); PG8_MMA(1, 1, At, B1); PG8_BAR; PG8_SCHED;
            PG8_LDB(B0, 1, 0); PG8_LDB(B1, 1, 1); PG8_SCHED; PG8_LDA(At, 1, 0); PG8_STAGE(PG8_SA(0, 1), a2 + hstep, voffA);
            PG8_WAIT_V(8); PG8_WAIT_L(0); PG8_BAR; PG8_MMA(0, 0, At, B0); PG8_MMA(0, 1, At, B1); PG8_BAR; PG8_SCHED;
            PG8_LDA(At, 1, 1); PG8_STAGE(PG8_SB(1, 0), b3, voffB); PG8_STAGE(PG8_SB(1, 1), b3 + hstep, voffB); PG8_STAGE(PG8_SA(1, 0), a3, voffA);
            PG8_WAIT_V(8); PG8_WAIT_L(0); PG8_BAR; PG8_MMA(1, 0, At, B0); PG8_MMA(1, 1, At, B1); PG8_BAR; PG8_SCHED;
            } else {
            PG8_LDB(B0, 0, 0); PG8_SCHED; PG8_LDA(At, 0, 0); PG8_STAGE(PG8_SA(1, 1), a1 + hstep, voffA);
            PG8_WAIT_L(8); PG8_BAR; PG8_WAIT_L(0); PG8_MMA(0, 0, At, B0); PG8_BAR; PG8_SCHED;
            PG8_LDB(B1, 0, 1); PG8_STAGE(PG8_SB(0, 0), b2, voffB);
            PG8_BAR; PG8_WAIT_L(0); PG8_MMA(0, 1, At, B1); PG8_BAR;
            PG8_LDA(At, 0, 1); PG8_STAGE(PG8_SA(0, 0), a2, voffA);
            PG8_BAR; PG8_WAIT_L(0); PG8_MMA(1, 0, At, B0); PG8_BAR; PG8_SCHED;
            PG8_STAGE(PG8_SB(0, 1), b2 + hstep, voffB);
            PG8_WAIT_V(6); PG8_BAR; PG8_MMA(1, 1, At, B1); PG8_BAR;
            PG8_LDB(B0, 1, 0); PG8_SCHED; PG8_LDA(At, 1, 0); PG8_STAGE(PG8_SA(0, 1), a2 + hstep, voffA);
            PG8_WAIT_L(8); PG8_BAR; PG8_WAIT_L(0); PG8_MMA(0, 0, At, B0); PG8_BAR; PG8_SCHED;
            PG8_LDB(B1, 1, 1); PG8_STAGE(PG8_SB(1, 0), b3, voffB);
            PG8_BAR; PG8_WAIT_L(0); PG8_MMA(0, 1, At, B1); PG8_BAR;
            PG8_LDA(At, 1, 1); PG8_STAGE(PG8_SA(1, 0), a3, voffA);
            PG8_BAR; PG8_WAIT_L(0); PG8_MMA(1, 0, At, B0); PG8_BAR; PG8_SCHED;
            PG8_STAGE(PG8_SB(1, 1), b3 + hstep, voffB);
            PG8_WAIT_V(6); PG8_BAR; PG8_MMA(1, 1, At, B1); PG8_BAR;
            }
        }
        if constexpr (ALIGN_EPI) { if (wr == 0) PG8_BAR; }
        if constexpr (!Epi::AFTER_DRAIN) { E(acc, cur, wr, wc, fr, fq); S.done(cur); }
        if (!has_next) break;
#pragma unroll
        for (int a = 0; a < 2; ++a)
#pragma unroll
            for (int b = 0; b < 2; ++b)
#pragma unroll
                for (int m = 0; m < 4; ++m)
#pragma unroll
                    for (int n = 0; n < 2; ++n) acc[a][b][m][n] = (f32x4){0.f, 0.f, 0.f, 0.f};
        cur = nxt; cA = nA; cB = nB; ++ui;
        if constexpr (ALIGN_EPI) { if (wr == 1) PG8_BAR; }
    }
    PG8_WAIT_V(0);
    if constexpr (!ALIGN_EPI) { if (wr == 0) PG8_BAR; }
    PG8_BAR;
    if constexpr (Epi::AFTER_DRAIN) { E.fused(acc, cur, wr, wc, fr, fq, lds, wid, lane); S.done(cur); }
#undef PG8_SA
#undef PG8_SB
#undef PG8_STAGE
#undef PG8_LDA
#undef PG8_LDB
#undef PG8_MMA
#undef PG8_WAIT_V
#undef PG8_WAIT_L
#undef PG8_BAR
#undef PG8_SCHED
}
}
using pg8::bf16_t; using pg8::f32x4; using pg8::u32x4; using pg8::bf16x8; using pg8::u32x2; using pg8::pk2; using pg8::bflo; using pg8::bfhi; using pg8::sigm; using pg8::NORM_EPS;
#define LAS __attribute__((address_space(3)))
constexpr int NB = 4, T = 8192, M = NB * T, D = 1024, INW = 4352, CC = 512, FF = 2816, GU = 2 * FF, DEPTH = 4, NHEAD = 16;
constexpr size_t MiB = 1u << 20;
constexpr size_t WS_SS = 450 * MiB, SS_BUF = 2 * MiB;
constexpr size_t WS_ROPE = 1 * MiB;
constexpr size_t WS_W = 2 * MiB, W_LAYER = 28 * MiB;
constexpr size_t WO_IN = 0, WO_PW = 8 * MiB + MiB / 2, WO_OUT = WO_PW + 1 * MiB, WO_GU = WO_OUT + 2 * MiB, WO_DN = WO_GU + 11 * MiB;
constexpr size_t WS_XB = 114 * MiB, WS_QO = 178 * MiB, WS_KV = 242 * MiB, WS_A = 258 * MiB, WS_G = 290 * MiB, WS_Y = 418 * MiB, WS_BAR = 455 * MiB, WS_END = 456 * MiB;
constexpr size_t WS_LOB = 354 * MiB;
constexpr size_t WS_ACT = 178 * MiB;
static_assert(WO_DN + (size_t)D * FF * 2 == W_LAYER && WS_W + DEPTH * W_LAYER == WS_XB && WS_ACT + (size_t)M * FF * 2 <= WS_Y, "ws map");
constexpr int LDS_BYTES = 132096;

__device__ __forceinline__ float wave_sum(float v) {
#pragma unroll
    for (int o = 1; o < 64; o <<= 1) v += __shfl_xor(v, o);
    return v;
}

namespace att {
typedef __attribute__((ext_vector_type(16))) float f32x16;
typedef __attribute__((ext_vector_type(4))) short s16x4;
constexpr int KPB = 144, VPB = 520, OFF_V = 256 * KPB;
constexpr float LOG2E = 1.4426950408889634f;
__device__ __forceinline__ int crow(int r, int hi) { return (r & 3) + 8 * (r >> 2) + 4 * hi; }

__device__ __forceinline__ void unit(LAS unsigned char* lds, int b, int kvh, int blk, bf16_t* QO, const bf16_t* KV, const bf16_t* GA, const float* qn, const float* kn, const float* sinks,
                                     const float* rope, int tid, int lane, int wave) {
    const int h = kvh * 8 + wave, q = lane & 31, hi = lane >> 5;
    u32x4 qrN[4]; u32x2 gtN[2][4]; f32x4 rpN[4];
#define AT_LOAD(sub_) do { const int tq_ = blk * 128 + 32 * (sub_) + q; const size_t grow_ = (size_t)(b * T + tq_); const bf16_t* qp_ = QO + grow_ * 1024 + h * 64 + 8 * hi; \
        _Pragma("unroll") for (int d0 = 0; d0 < 4; ++d0) qrN[d0] = *(const u32x4*)(qp_ + 16 * d0); \
        _Pragma("unroll") for (int d0 = 0; d0 < 2; ++d0) _Pragma("unroll") for (int g = 0; g < 4; ++g) gtN[d0][g] = *(const u32x2*)(GA + grow_ * 2048 + h * 64 + 4 * hi + 32 * d0 + 8 * g); \
        _Pragma("unroll") for (int i = 0; i < 4; ++i) rpN[i] = *(const f32x4*)(rope + tq_ * 16 + 4 * i); } while (0)
    AT_LOAD(0);
    {
        const int row = tid >> 1, half = tid & 1, pos = blk * 128 - 128 + row; const bool valid = pos >= 0;
        const bf16_t* src = KV + (size_t)(b * T + pos) * 256 + kvh * 64 + half * 32;
        float x[32]; float ssq = 0.f;
#pragma unroll
        for (int i = 0; i < 4; ++i) { u32x4 r = (u32x4){0u, 0u, 0u, 0u}; if (valid) r = *(const u32x4*)(src + 8 * i);
            x[8 * i + 0] = bflo(r.x); x[8 * i + 1] = bfhi(r.x); x[8 * i + 2] = bflo(r.y); x[8 * i + 3] = bfhi(r.y); x[8 * i + 4] = bflo(r.z); x[8 * i + 5] = bfhi(r.z); x[8 * i + 6] = bflo(r.w); x[8 * i + 7] = bfhi(r.w); }
#pragma unroll
        for (int i = 0; i < 32; ++i) ssq += x[i] * x[i];
        ssq += __shfl_xor(ssq, 1);
        const float rstd = rsqrtf(ssq * (1.0f / 64.0f) + NORM_EPS);
#pragma unroll
        for (int i = 0; i < 8; ++i) { const f32x4 g = *(const f32x4*)(kn + half * 32 + 4 * i); x[4 * i] *= rstd * g[0]; x[4 * i + 1] *= rstd * g[1]; x[4 * i + 2] *= rstd * g[2]; x[4 * i + 3] *= rstd * g[3]; }
        if (half == 0 && valid) { const float* cs = rope + pos * 16;
#pragma unroll
            for (int i = 0; i < 8; ++i) { const float c = cs[i], s = cs[8 + i], x1 = x[i], x2 = x[8 + i]; x[i] = x1 * c - x2 * s; x[8 + i] = x2 * c + x1 * s; } }
#pragma unroll
        for (int i = 0; i < 4; ++i) { u32x4 w; w.x = pk2(x[8 * i], x[8 * i + 1]); w.y = pk2(x[8 * i + 2], x[8 * i + 3]); w.z = pk2(x[8 * i + 4], x[8 * i + 5]); w.w = pk2(x[8 * i + 6], x[8 * i + 7]);
            *(LAS u32x4*)(lds + row * KPB + half * 64 + 16 * i) = w; }
    }
    {
        const int rp = tid >> 2, c = tid & 3, pos0 = blk * 128 - 128 + 2 * rp; const bool valid = pos0 >= 0;
        const bf16_t* src = KV + (size_t)(b * T + pos0) * 256 + 128 + kvh * 64 + 16 * c;
        u32x4 r0[2], r1[2];
#pragma unroll
        for (int i = 0; i < 2; ++i) { r0[i] = (u32x4){0u, 0u, 0u, 0u}; r1[i] = r0[i]; if (valid) { r0[i] = *(const u32x4*)(src + 8 * i); r1[i] = *(const u32x4*)(src + 256 + 8 * i); } }
#pragma unroll
        for (int w = 0; w < 8; ++w) { const unsigned a = r0[w >> 2][w & 3], bb = r1[w >> 2][w & 3]; const int d = 16 * c + 2 * w;
            *(LAS unsigned*)(lds + OFF_V + d * VPB + rp * 4) = (a & 0xffffu) | (bb << 16);
            *(LAS unsigned*)(lds + OFF_V + (d + 1) * VPB + rp * 4) = (a >> 16) | (bb & 0xffff0000u); }
    }
    __syncthreads();
    const float sink2 = sinks[h] * LOG2E;
#pragma unroll 1
    for (int sub = 0; sub < 4; ++sub) {
        const int tq = blk * 128 + 32 * sub + q; const size_t grow = (size_t)(b * T + tq);
        u32x4 qr[4]; u32x2 gt[2][4]; f32x4 rp[4];
#pragma unroll
        for (int i = 0; i < 4; ++i) { qr[i] = qrN[i]; rp[i] = rpN[i]; }
#pragma unroll
        for (int d0 = 0; d0 < 2; ++d0)
#pragma unroll
            for (int g = 0; g < 4; ++g) gt[d0][g] = gtN[d0][g];
        if (sub < 3) AT_LOAD(sub + 1);
        float x[4][8]; float ssq = 0.f;
#pragma unroll
        for (int d0 = 0; d0 < 4; ++d0) { const u32x4 r = qr[d0];
            x[d0][0] = bflo(r.x); x[d0][1] = bfhi(r.x); x[d0][2] = bflo(r.y); x[d0][3] = bfhi(r.y); x[d0][4] = bflo(r.z); x[d0][5] = bfhi(r.z); x[d0][6] = bflo(r.w); x[d0][7] = bfhi(r.w); }
#pragma unroll
        for (int d0 = 0; d0 < 4; ++d0)
#pragma unroll
            for (int i = 0; i < 8; ++i) ssq += x[d0][i] * x[d0][i];
        ssq += __shfl_xor(ssq, 32);
        const float rstd = rsqrtf(ssq * (1.0f / 64.0f) + NORM_EPS) * (0.125f * LOG2E);
#pragma unroll
        for (int d0 = 0; d0 < 4; ++d0) { const f32x4 g0 = *(const f32x4*)(qn + 16 * d0 + 8 * hi), g1 = *(const f32x4*)(qn + 16 * d0 + 8 * hi + 4);
            x[d0][0] *= rstd * g0[0]; x[d0][1] *= rstd * g0[1]; x[d0][2] *= rstd * g0[2]; x[d0][3] *= rstd * g0[3]; x[d0][4] *= rstd * g1[0]; x[d0][5] *= rstd * g1[1]; x[d0][6] *= rstd * g1[2]; x[d0][7] *= rstd * g1[3]; }
#pragma unroll
        for (int i = 0; i < 8; ++i) { const float c = rp[i >> 2][i & 3], s = rp[2 + (i >> 2)][i & 3], me = x[0][i], ot = __shfl_xor(me, 32); x[0][i] = hi == 0 ? me * c - ot * s : me * c + ot * s; }
        bf16x8 qf[4];
#pragma unroll
        for (int d0 = 0; d0 < 4; ++d0) { u32x4 w; w.x = pk2(x[d0][0], x[d0][1]); w.y = pk2(x[d0][2], x[d0][3]); w.z = pk2(x[d0][4], x[d0][5]); w.w = pk2(x[d0][6], x[d0][7]); qf[d0] = __builtin_bit_cast(bf16x8, w); }
        f32x16 p[5];
#pragma unroll
        for (int kt = 0; kt < 5; ++kt) {
#pragma unroll
            for (int r = 0; r < 16; ++r) p[kt][r] = 0.f;
#pragma unroll
            for (int d0 = 0; d0 < 4; ++d0) { const bf16x8 kf = *(const LAS bf16x8*)(lds + (32 * (sub + kt) + q) * KPB + (16 * d0 + 8 * hi) * 2);
                p[kt] = __builtin_amdgcn_mfma_f32_32x32x16_bf16(kf, qf[d0], p[kt], 0, 0, 0); } }
        const bool first = (blk == 0);
        bool lowtri[16];
#pragma unroll
        for (int r = 0; r < 16; ++r) lowtri[r] = crow(r, hi) <= q;
        f32x16 pc;
#pragma unroll
        for (int r = 0; r < 16; ++r) pc[r] = lowtri[r] ? p[4][r] : (first ? -INFINITY : p[0][r]);
        if (first) {
#pragma unroll
            for (int kt = 1; kt < 4; ++kt) if (sub + kt < 4) {
#pragma unroll
                for (int r = 0; r < 16; ++r) p[kt][r] = -INFINITY; } }
        float mx = sink2;
#pragma unroll
        for (int r = 0; r < 16; ++r) mx = fmaxf(fmaxf(mx, pc[r]), fmaxf(fmaxf(p[1][r], p[2][r]), p[3][r]));
        mx = fmaxf(mx, __shfl_xor(mx, 32));
#pragma unroll
        for (int r = 0; r < 16; ++r) { pc[r] = __builtin_amdgcn_exp2f(pc[r] - mx); p[1][r] = __builtin_amdgcn_exp2f(p[1][r] - mx); p[2][r] = __builtin_amdgcn_exp2f(p[2][r] - mx); p[3][r] = __builtin_amdgcn_exp2f(p[3][r] - mx); }
        const f32x16 sv = (pc + p[1]) + (p[2] + p[3]);
        float lsum = ((sv[0] + sv[1]) + (sv[2] + sv[3])) + ((sv[4] + sv[5]) + (sv[6] + sv[7])) + (((sv[8] + sv[9]) + (sv[10] + sv[11])) + ((sv[12] + sv[13]) + (sv[14] + sv[15])));
        lsum += __shfl_xor(lsum, 32); lsum += __builtin_amdgcn_exp2f(sink2 - mx);
        const float inv = 1.0f / lsum;
#pragma unroll
        for (int r = 0; r < 16; ++r) { p[0][r] = lowtri[r] ? 0.f : pc[r]; p[4][r] = lowtri[r] ? pc[r] : 0.f; }
        f32x16 o[2];
#pragma unroll
        for (int r = 0; r < 16; ++r) { o[0][r] = 0.f; o[1][r] = 0.f; }
#pragma unroll
        for (int kt = 0; kt < 5; ++kt)
#pragma unroll
            for (int s = 0; s < 2; ++s) { u32x4 w; w.x = pk2(p[kt][8 * s], p[kt][8 * s + 1]); w.y = pk2(p[kt][8 * s + 2], p[kt][8 * s + 3]); w.z = pk2(p[kt][8 * s + 4], p[kt][8 * s + 5]); w.w = pk2(p[kt][8 * s + 6], p[kt][8 * s + 7]);
                const bf16x8 pf = __builtin_bit_cast(bf16x8, w);
#pragma unroll
                for (int d0 = 0; d0 < 2; ++d0) { const LAS unsigned char* vp = lds + OFF_V + (32 * d0 + q) * VPB + (32 * (sub + kt) + 16 * s + 4 * hi) * 2;
                    const s16x4 lo = *(const LAS s16x4*)vp, hi4 = *(const LAS s16x4*)(vp + 16);
                    const bf16x8 vf = (bf16x8){lo[0], lo[1], lo[2], lo[3], hi4[0], hi4[1], hi4[2], hi4[3]};
                    o[d0] = __builtin_amdgcn_mfma_f32_32x32x16_bf16(vf, pf, o[d0], 0, 0, 0); } }
        bf16_t* op = QO + grow * 1024 + h * 64 + 4 * hi;
#pragma unroll
        for (int d0 = 0; d0 < 2; ++d0)
#pragma unroll
            for (int g = 0; g < 4; ++g) { const u32x2 gg = gt[d0][g]; u32x2 w; w.x = pk2(o[d0][4 * g] * inv * bflo(gg.x), o[d0][4 * g + 1] * inv * bfhi(gg.x)); w.y = pk2(o[d0][4 * g + 2] * inv * bflo(gg.y), o[d0][4 * g + 3] * inv * bfhi(gg.y));
                *(u32x2*)(op + 32 * d0 + 8 * g) = w; }
    }
#undef AT_LOAD
    __syncthreads();
}
}

namespace cv {
constexpr int ROWS = 62, OFF_Y = ROWS * 1024, NU = M / 32;
typedef pg8::f32x2_t f32x2;
__device__ __forceinline__ void phase(LAS unsigned char* lds, int bx, int G, const bf16_t* A, bf16_t* Y, const float* cw, const float* cb, const float* lg, const float* lb, int tid, int lane, int wave) {
    const int cp = tid & 255, tg = tid >> 8;
    f32x2 wv[31];
#pragma unroll
    for (int j = 0; j < 31; ++j) wv[j] = *(const f32x2*)(cw + j * CC + 2 * cp);
    const f32x2 bias = *(const f32x2*)(cb + 2 * cp);
    const f32x4 g0 = *(const f32x4*)(lg + 4 * lane), g1 = *(const f32x4*)(lg + 256 + 4 * lane), b0 = *(const f32x4*)(lb + 4 * lane), b1 = *(const f32x4*)(lb + 256 + 4 * lane);
    u32x4 pre[8];
#define CV_FETCH(un) do { const int t0_ = (un) * 32, p0_ = t0_ & (T - 1); _Pragma("unroll") for (int i = 0; i < 8; ++i) { const int idx = tid + 512 * i, r = idx >> 6, ch = idx & 63; pre[i] = (u32x4){0u, 0u, 0u, 0u}; \
        if (idx < ROWS * 64 && p0_ - 30 + r >= 0) pre[i] = *(const u32x4*)(A + (size_t)(t0_ - 30 + r) * CC + ch * 8); } } while (0)
    int un = bx;
    if (un < NU) CV_FETCH(un);
#pragma unroll 1
    for (; un < NU; un += G) {
        const int t0 = un * 32;
#pragma unroll
        for (int i = 0; i < 8; ++i) { const int idx = tid + 512 * i; if (idx < ROWS * 64) *(LAS u32x4*)(lds + idx * 16) = pre[i]; }
        __syncthreads();
        if (un + G < NU) CV_FETCH(un + G);
#pragma unroll 1
        for (int sb = 0; sb < 2; ++sb) { const int tb = 16 * tg + 8 * sb;
            f32x2 ac[8];
#pragma unroll
            for (int i = 0; i < 8; ++i) ac[i] = bias;
#pragma unroll
            for (int rr = 0; rr < 38; ++rr) { const unsigned v = *(const LAS unsigned*)(lds + (tb + rr) * 1024 + cp * 4); const f32x2 vv = (f32x2){bflo(v), bfhi(v)};
#pragma unroll
                for (int i = 0; i < 8; ++i) { const int j = rr - i; if (j >= 0 && j <= 30) ac[i] = __builtin_elementwise_fma(wv[j], vv, ac[i]); } }
#pragma unroll
            for (int i = 0; i < 8; ++i) *(LAS f32x2*)(lds + OFF_Y + (tb + i) * 2048 + cp * 8) = ac[i]; }
        __syncthreads();
#pragma unroll
        for (int k = 0; k < 4; ++k) { const int tok = 4 * wave + k;
            f32x4 v0 = *(const LAS f32x4*)(lds + OFF_Y + tok * 2048 + lane * 16), v1 = *(const LAS f32x4*)(lds + OFF_Y + tok * 2048 + 1024 + lane * 16);
            const float mean = wave_sum((v0[0] + v0[1]) + (v0[2] + v0[3]) + (v1[0] + v1[1]) + (v1[2] + v1[3])) * (1.0f / 512.0f);
            v0 = v0 - mean; v1 = v1 - mean;
            const float var = wave_sum((v0[0] * v0[0] + v0[1] * v0[1]) + (v0[2] * v0[2] + v0[3] * v0[3]) + (v1[0] * v1[0] + v1[1] * v1[1]) + (v1[2] * v1[2] + v1[3] * v1[3])) * (1.0f / 512.0f);
            const float rstd = rsqrtf(var + NORM_EPS);
            v0 = v0 * rstd * g0 + b0; v1 = v1 * rstd * g1 + b1;
            u32x2 w0, w1; w0.x = pk2(v0[0] * sigm(v0[0]), v0[1] * sigm(v0[1])); w0.y = pk2(v0[2] * sigm(v0[2]), v0[3] * sigm(v0[3]));
            w1.x = pk2(v1[0] * sigm(v1[0]), v1[1] * sigm(v1[1])); w1.y = pk2(v1[2] * sigm(v1[2]), v1[3] * sigm(v1[3]));
            bf16_t* yp = Y + (size_t)(t0 + tok) * CC + 4 * lane; *(u32x2*)yp = w0; *(u32x2*)(yp + 256) = w1; }
        __syncthreads();
    }
#undef CV_FETCH
}
}
__device__ __forceinline__ void transpose_item(const float* W, int K, int N, bf16_t* WT, int k0, int n0s, int n0d, const float* gain, LAS float* scr, int lane) {
    const int r8 = lane >> 3, c4 = (lane & 7) * 4;
    f32x4 v[8]; float gs[8];
#pragma unroll
    for (int i = 0; i < 8; ++i) { v[i] = *(const f32x4*)(W + (size_t)(k0 + 8 * i + r8) * N + n0s + c4); gs[i] = gain ? gain[k0 + 8 * i + r8] : 1.0f; }
#pragma unroll
    for (int i = 0; i < 8; ++i) { LAS float* d = scr + (8 * i + r8) * 33 + c4; d[0] = v[i][0] * gs[i]; d[1] = v[i][1] * gs[i]; d[2] = v[i][2] * gs[i]; d[3] = v[i][3] * gs[i]; }
    asm volatile("s_waitcnt lgkmcnt(0)" ::: "memory");
    const int c = lane & 7;
#pragma unroll
    for (int j = 0; j < 4; ++j) { const int n = (lane >> 3) + 8 * j; const LAS float* s = scr + (8 * c) * 33 + n;
        u32x4 o; o.x = pk2(s[0 * 33], s[1 * 33]); o.y = pk2(s[2 * 33], s[3 * 33]); o.z = pk2(s[4 * 33], s[5 * 33]); o.w = pk2(s[6 * 33], s[7 * 33]);
        *(u32x4*)(WT + (size_t)(n0d + n) * K + k0 + 8 * c) = o; }
    asm volatile("s_waitcnt lgkmcnt(0)" ::: "memory");
}
__device__ __forceinline__ int perm_in(int n0d) { const int pn = n0d >> 8, h = (n0d >> 7) & 1, j = n0d & 127; if (pn >= 5 && pn < 9) return (h ? 1792 : 1280) + 128 * (pn - 5) + j; return n0d; }
__device__ __forceinline__ int perm_gu(int n0d) { const int pn = n0d >> 8, h = (n0d >> 7) & 1, j = n0d & 127; return (h ? FF : 0) + 128 * pn + j; }

struct Args { const float* in[15]; float* out; unsigned char* ws; int ph_lo, ph_hi; };
enum { I_X = 0, I_NMIX, I_WIN, I_QN, I_KN, I_SINK, I_CW, I_CB, I_LG, I_LB, I_WPW, I_WOUT, I_NFFN, I_WGU, I_WDN };

__device__ __forceinline__ void convert_layer(const Args& a, int l, int slot, int nslots, LAS float* scr, int lane) {
    constexpr int I_IN = (D / 64) * (INW / 32), I_PW = (CC / 64) * (D / 32), I_OUT = (D / 64) * (D / 32), I_GU = (D / 64) * (GU / 32), I_DN = (FF / 64) * (D / 32), PER_L = I_IN + I_PW + I_OUT + I_GU + I_DN;
    unsigned char* wb = a.ws + WS_W + (size_t)l * W_LAYER;
    for (int it = slot; it < PER_L; it += nslots) {
        int r = it;
        if (r < I_IN) { const int nblk = INW / 32, kb = r / nblk, nb = r % nblk; transpose_item(a.in[I_WIN] + (size_t)l * D * INW, D, INW, (bf16_t*)(wb + WO_IN), 64 * kb, perm_in(32 * nb), 32 * nb, a.in[I_NMIX] + l * D, scr, lane); continue; } r -= I_IN;
        if (r < I_PW) { const int nblk = D / 32, kb = r / nblk, nb = r % nblk; transpose_item(a.in[I_WPW] + (size_t)l * CC * D, CC, D, (bf16_t*)(wb + WO_PW), 64 * kb, 32 * nb, 32 * nb, nullptr, scr, lane); continue; } r -= I_PW;
        if (r < I_OUT) { const int nblk = D / 32, kb = r / nblk, nb = r % nblk; transpose_item(a.in[I_WOUT] + (size_t)l * D * D, D, D, (bf16_t*)(wb + WO_OUT), 64 * kb, 32 * nb, 32 * nb, nullptr, scr, lane); continue; } r -= I_OUT;
        if (r < I_GU) { const int nblk = GU / 32, kb = r / nblk, nb = r % nblk; transpose_item(a.in[I_WGU] + (size_t)l * D * GU, D, GU, (bf16_t*)(wb + WO_GU), 64 * kb, perm_gu(32 * nb), 32 * nb, a.in[I_NFFN] + l * D, scr, lane); continue; } r -= I_GU;
        { const int nblk = D / 32, kb = r / nblk, nb = r % nblk; transpose_item(a.in[I_WDN] + (size_t)l * FF * D, FF, D, (bf16_t*)(wb + WO_DN), 64 * kb, 32 * nb, 32 * nb, nullptr, scr, lane); }
    }
}
__device__ __forceinline__ void prologue(const Args& a, LAS unsigned char* lds, int tid, int lane, int wave) {
    LAS float* scr = (LAS float*)(lds + wave * 16384);
    const int gw = blockIdx.x * 8 + wave, NGW = gridDim.x * 8;
    const int lw = gridDim.x == 256 ? 1 : DEPTH;
    for (int l = 0; l < lw; ++l) convert_layer(a, l, gw, NGW, scr, lane);
    float* ss = (float*)(a.ws + WS_SS); bf16_t* XB = (bf16_t*)(a.ws + WS_XB);
    bf16_t* LOA = (bf16_t*)a.out;
    for (int m = gw; m < M; m += NGW) { const f32x4* xr = (const f32x4*)(a.in[I_X] + (size_t)m * D) + lane; u32x2* xo = (u32x2*)(XB + (size_t)m * D) + lane; u32x2* lo = (u32x2*)(LOA + (size_t)m * D) + lane; float s = 0.f;
#pragma unroll
        for (int j = 0; j < 4; ++j) { const f32x4 v = xr[64 * j]; s += (v[0] * v[0] + v[1] * v[1]) + (v[2] * v[2] + v[3] * v[3]); u32x2 w; w.x = pk2(v[0], v[1]); w.y = pk2(v[2], v[3]); xo[64 * j] = w;
            u32x2 r; r.x = pk2(v[0] - bflo(w.x), v[1] - bfhi(w.x)); r.y = pk2(v[2] - bflo(w.y), v[3] - bfhi(w.y)); lo[64 * j] = r; }
        s = wave_sum(s); if (lane < 16) ss[(size_t)m * 16 + lane] = lane == 0 ? s : 0.f; }
    float* rope = (float*)(a.ws + WS_ROPE);
    for (int i = blockIdx.x * 512 + tid; i < T * 8; i += gridDim.x * 512) { const int t = i >> 3, f = i & 7;
        double fr = 1.0; for (int k = 0; k < f; ++k) fr *= 0.19392274474868576;
        const float inv_freq = (float)fr; const float ang = (float)t * inv_freq;
        const double x = (double)ang, kq = __builtin_rint(x * 0.6366197723675814);
        const double r = __builtin_fma(-kq, 6.123233995736766e-17, __builtin_fma(-kq, 1.5707963267948966, x)), r2 = r * r;
        const double sp = r * (1.0 + r2 * (-1.0 / 6 + r2 * (1.0 / 120 + r2 * (-1.0 / 5040 + r2 * (1.0 / 362880 + r2 * (-1.0 / 39916800 + r2 * (1.0 / 6227020800.0)))))));
        const double cp = 1.0 + r2 * (-0.5 + r2 * (1.0 / 24 + r2 * (-1.0 / 720 + r2 * (1.0 / 40320 + r2 * (-1.0 / 3628800 + r2 * (1.0 / 479001600 + r2 * (-1.0 / 87178291200.0)))))));
        const int qd = ((int)kq) & 3;
        const double sn = qd == 0 ? sp : qd == 1 ? cp : qd == 2 ? -sp : -cp, cn = qd == 0 ? cp : qd == 1 ? -sp : qd == 2 ? -cp : sp;
        rope[t * 16 + f] = (float)cn; rope[t * 16 + 8 + f] = (float)sn; }
}

#define XB_TMO      128
#define XB_XCNT(j)  (256  + 64 * (j))
#define XB_XSUB(j)  (1280 + 64 * (j))
#define XB_XGEN(j)  (2304 + 64 * (j))
#define XB_TOP      3328
#define XB_TOPGEN   3392
#define XCD_BAR_WORDS 3456
#define XB_SPIN_CAP (1u << 18)

__device__ __forceinline__ unsigned xb_ld(unsigned* p)              { return __hip_atomic_load(p, __ATOMIC_RELAXED, __HIP_MEMORY_SCOPE_AGENT); }
__device__ __forceinline__ unsigned xb_add(unsigned* p, unsigned v) { return __hip_atomic_fetch_add(p, v, __ATOMIC_RELAXED, __HIP_MEMORY_SCOPE_AGENT); }
__device__ __forceinline__ unsigned xb_xcc_id() { return (unsigned)__builtin_amdgcn_s_getreg((3 << 11) | 20) & 0xFu; }
#define XB_SPIN(cond, bar) do { unsigned _sp = 0; while (cond) { __builtin_amdgcn_s_sleep(1); \
    if ((++_sp & 255u) == 0u) { if (xb_ld(&(bar)[XB_TMO])) break; if (_sp > XB_SPIN_CAP) { atomicAdd(&(bar)[XB_TMO], 1u); break; } } } } while (0)

struct XcdBarrier {
    unsigned* bar; unsigned x;
    volatile LAS unsigned* st;
};

__device__ __forceinline__ XcdBarrier xcd_barrier_post(unsigned* bar, volatile LAS unsigned* st) {
    XcdBarrier b; b.bar = bar; b.x = xb_xcc_id(); b.st = st;
    if (threadIdx.x == 0) (void)xb_add(&bar[XB_XCNT(b.x)], 1u);
    return b;
}
__device__ __forceinline__ void xcd_barrier_complete(unsigned* bar, unsigned x, unsigned& nloc, unsigned& nx) {
    const unsigned G = gridDim.x * gridDim.y * gridDim.z;
    unsigned sum, cnt, mine, sp = 0u;
    for (;;) {
        sum = 0u; cnt = 0u; mine = 0u;
#pragma unroll
        for (unsigned j = 0; j < 16; ++j) { const unsigned c = xb_ld(&bar[XB_XCNT(j)]); sum += c; cnt += (c > 0u) ? 1u : 0u; mine = (j == x) ? c : mine; }
        if (sum == G) break;
        __builtin_amdgcn_s_sleep(1);
        if ((++sp & 255u) == 0u) { if (xb_ld(&bar[XB_TMO])) break; if (sp > XB_SPIN_CAP) { atomicAdd(&bar[XB_TMO], 1u); break; } }
    }
    nloc = mine > 0u ? mine : 1u; nx = cnt > 0u ? cnt : 1u;
}

__device__ __forceinline__ void xcd_barrier(const XcdBarrier& b) {
    asm volatile("s_waitcnt vmcnt(0)" ::: "memory");
    __syncthreads();
    if (threadIdx.x == 0) {
        unsigned* bar = b.bar;
        __builtin_amdgcn_s_waitcnt(0);
        unsigned nloc = b.st[0], nx = b.st[1];
        if (nloc == 0u) { xcd_barrier_complete(bar, b.x, nloc, nx); b.st[0] = nloc; b.st[1] = nx; }
        const unsigned old = xb_add(&bar[XB_XSUB(b.x)], 1u);
        const unsigned gen = old / nloc;
        if (old + 1u == (gen + 1u) * nloc) {
            __builtin_amdgcn_fence(__ATOMIC_RELEASE, "agent");
            asm volatile("s_waitcnt vmcnt(0)" ::: "memory");
            const unsigned og = xb_add(&bar[XB_TOP], 1u);
            const unsigned tg = og / nx;
            if (og + 1u == (tg + 1u) * nx) xb_add(&bar[XB_TOPGEN], 1u);
            else XB_SPIN(xb_ld(&bar[XB_TOPGEN]) == tg, bar);
            __builtin_amdgcn_fence(__ATOMIC_ACQUIRE, "agent");
            xb_add(&bar[XB_XGEN(b.x)], 1u);
            asm volatile("s_waitcnt vmcnt(0)" ::: "memory");
        } else {
            XB_SPIN(xb_ld(&bar[XB_XGEN(b.x)]) == gen, bar);
            __builtin_amdgcn_fence(__ATOMIC_ACQUIRE, "agent");
            asm volatile("s_waitcnt vmcnt(0)" ::: "memory");
        }
    }
    __syncthreads();
}

#ifndef PROBE
#define PROBE 0
#endif
#define tsb ((LAS unsigned long long*)(lds + 131072))
#ifndef PROBE_A
#define PROBE_A 2
#endif
#ifndef PROBE_B
#define PROBE_B 3
#endif
#ifndef PROBE_SA
#define PROBE_SA 0.01f
#endif
#ifndef PROBE_SB
#define PROBE_SB 0.01f
#endif
constexpr int N_PHASES = 1 + 6 * DEPTH;
__global__ void __launch_bounds__(512, 2) fwd_kernel(Args a) {
    extern __shared__ __attribute__((aligned(16))) unsigned char lds_raw[];
    LAS unsigned char* lds = (LAS unsigned char*)lds_raw;
    cg::grid_group grid = cg::this_grid();
    volatile LAS unsigned* bst = (volatile LAS unsigned*)(lds + 131072 + 768);
    if (threadIdx.x < 2) bst[threadIdx.x] = 0u;
    __syncthreads();
    const XcdBarrier xbar = xcd_barrier_post((unsigned*)(a.ws + WS_BAR), bst);
    const int G = gridDim.x, bx = blockIdx.x;
    unsigned char* ws = a.ws;
    float* ss = (float*)(ws + WS_SS); const float* rope = (const float*)(ws + WS_ROPE);
    bf16_t* XB = (bf16_t*)(ws + WS_XB); bf16_t* QO = (bf16_t*)(ws + WS_QO); bf16_t* KV = (bf16_t*)(ws + WS_KV); bf16_t* AB = (bf16_t*)(ws + WS_A);
    bf16_t* GB = (bf16_t*)(ws + WS_G); bf16_t* YB = (bf16_t*)(ws + WS_Y); bf16_t* ACT = (bf16_t*)(ws + WS_ACT);
#pragma unroll 1
    for (int ph = a.ph_lo; ph < a.ph_hi; ++ph) {
        if (ph > a.ph_lo) { if (ph == 1) grid.sync(); else xcd_barrier(xbar); }
        int tid_l = threadIdx.x; asm volatile("" : "+v"(tid_l));
#if PROBE
        if (threadIdx.x == 0) tsb[ph] = __builtin_amdgcn_s_memrealtime();
#endif
        const int tid = tid_l, lane = tid & 63, wave = __builtin_amdgcn_readfirstlane(tid >> 6);
        if (ph == 0) { prologue(a, lds, tid, lane, wave); continue; }
        const int l = (ph - 1) / 6, s = (ph - 1) % 6;
        const unsigned char* wb = ws + WS_W + (size_t)l * W_LAYER;
        if (s == 0) {
            pg8::Gemm g{XB, (const bf16_t*)(wb + WO_IN), M, INW, D}; pg8::StaticOrder S; S.init(M, INW, G, bx);
            pg8::EpiIn E{QO, KV, AB, GB, ss};
            pg8::gemm_phase<pg8::EpiIn, pg8::StaticOrder, true, true>(lds, g, S, E);
            if (G == 256 && bx >= 128 && l + 1 < DEPTH) convert_layer(a, l + 1, (bx - 128) * 8 + wave, 128 * 8, (LAS float*)(lds + wave * 16384), lane);
        } else if (s == 1) {
            for (int u = bx; u < NB * 2 * (T / 128); u += G) { const int blk = u & 63, kvh = (u >> 6) & 1, b = u >> 7;
                att::unit(lds, b, kvh, blk, QO, KV, GB, a.in[I_QN] + l * 64, a.in[I_KN] + l * 64, a.in[I_SINK] + l * NHEAD, rope, tid, lane, wave); }
#if PROBE
            if (threadIdx.x == 0) tsb[32 + l] = __builtin_amdgcn_s_memrealtime();
#endif
            cv::phase(lds, bx, G, AB, YB, a.in[I_CW] + (size_t)l * 31 * CC, a.in[I_CB] + l * CC, a.in[I_LG] + l * CC, a.in[I_LB] + l * CC, tid, lane, wave);
        } else if (s == 2) {
            pg8::Gemm g{YB, (const bf16_t*)(wb + WO_PW), M, D, CC}; pg8::StaticOrder S; S.init(M, D, G, bx);
            pg8::EpiMerge E{QO, GB};
            pg8::gemm_phase<pg8::EpiMerge, pg8::StaticOrder, true, true>(lds, g, S, E);
        } else if (s == 3) {
            pg8::Gemm g{QO, (const bf16_t*)(wb + WO_OUT), M, D, D}; pg8::StaticOrder S; S.init(M, D, G, bx);
            pg8::EpiRes E{(const bf16_t*)a.out, (bf16_t*)(ws + WS_LOB), XB, a.out, ss + (size_t)M * 16, 1};
            pg8::gemm_phase<pg8::EpiRes, pg8::StaticOrder, true, true>(lds, g, S, E);
        } else if (s == 4) {
            pg8::Gemm g{XB, (const bf16_t*)(wb + WO_GU), M, GU, D}; pg8::StaticOrder S; S.init(M, GU, G, bx);
            pg8::EpiSwiglu E{ACT, ss + (size_t)M * 16};
            pg8::gemm_phase<pg8::EpiSwiglu, pg8::StaticOrder, true, true>(lds, g, S, E);
        } else {
            pg8::Gemm g{ACT, (const bf16_t*)(wb + WO_DN), M, D, FF}; pg8::StaticOrder S; S.init(M, D, G, bx);
            pg8::EpiRes E{(const bf16_t*)(ws + WS_LOB), (bf16_t*)a.out, XB, a.out, ss, l + 1 < DEPTH ? 1 : 0};
            pg8::gemm_phase<pg8::EpiRes, pg8::StaticOrder, true, true>(lds, g, S, E);
        }
    }
#if PROBE
    if (bx == 0) {
        LAS float* pv = (LAS float*)(lds + 131072 + 512);
        if (threadIdx.x == 0) { tsb[N_PHASES] = __builtin_amdgcn_s_memrealtime();
            unsigned long long sa = 0, sb = 0;
#pragma unroll 1
            for (int l = 0; l < DEPTH; ++l) { const int b = 1 + 6 * l;
                const unsigned long long d1 = tsb[b + 1] - tsb[b], d2 = tsb[32 + l] - tsb[b + 1], d3 = tsb[b + 2] - tsb[32 + l], d4 = tsb[b + 3] - tsb[b + 2], d5 = tsb[b + 4] - tsb[b + 3], d6 = tsb[b + 5] - tsb[b + 4], d7 = tsb[b + 6] - tsb[b + 5];
                sa += PROBE_A == 1 ? d1 : PROBE_A == 2 ? d2 : PROBE_A == 3 ? d3 : PROBE_A == 4 ? d4 : PROBE_A == 5 ? d5 : PROBE_A == 6 ? d6 : PROBE_A == 7 ? d7 : 0;
                sb += PROBE_B == 1 ? d1 : PROBE_B == 2 ? d2 : PROBE_B == 3 ? d3 : PROBE_B == 4 ? d4 : PROBE_B == 5 ? d5 : PROBE_B == 6 ? d6 : PROBE_B == 7 ? d7 : 0; }
            if (PROBE_A == 0) sa = tsb[1] - tsb[0]; if (PROBE_B == 0) sb = tsb[1] - tsb[0];
            pv[0] = (float)sa * 0.01f * PROBE_SA; pv[1] = PROBE_B == 8 ? 20.0f : (float)sb * 0.01f * PROBE_SB; }
        __syncthreads();
        if (threadIdx.x == 0) a.out[0] += pv[0];
        if (PROBE_B >= 0) for (int i = threadIdx.x + 512; i < 65536; i += 512) a.out[(size_t)(i >> 8) * 1024 + (i & 255)] += pv[1] * 0.0625f;
    }
#endif
}

#ifndef MK_PER_PHASE
#define MK_PER_PHASE 0
#endif
extern "C" void kernel_launch(void* const* d_in, const int* in_sizes, int n_in, void* d_out, int out_size, void* d_ws, size_t ws_size, hipStream_t stream) {
    static int grid = 0;
    if (grid == 0) {
        if (n_in != 15 || in_sizes[0] != M * D || out_size != M * D || ws_size < WS_END) { fprintf(stderr, "kernel_launch: unexpected shapes / workspace (n_in %d, ws %zu)\n", n_in, ws_size); grid = -1; return; }
        int dev = 0, cus = 0, per_cu = 0;
        (void)hipGetDevice(&dev); (void)hipDeviceGetAttribute(&cus, hipDeviceAttributeMultiprocessorCount, dev);
        if (hipFuncSetAttribute((const void*)fwd_kernel, hipFuncAttributeMaxDynamicSharedMemorySize, LDS_BYTES) != hipSuccess) { fprintf(stderr, "kernel_launch: hipFuncSetAttribute failed\n"); grid = -1; return; }
        if (hipOccupancyMaxActiveBlocksPerMultiprocessor(&per_cu, (const void*)fwd_kernel, 512, LDS_BYTES) != hipSuccess || per_cu < 1) { fprintf(stderr, "kernel_launch: occupancy query says %d\n", per_cu); per_cu = 1; }
        (void)hipGetLastError();
        grid = cus * per_cu;
    }
    if (grid < 0) return;
    if (hipMemsetAsync((char*)d_ws + WS_BAR, 0, 16384, stream) != hipSuccess) { fprintf(stderr, "kernel_launch: memset of the barrier words failed\n"); return; }
    Args a{};
    for (int i = 0; i < 15; ++i) a.in[i] = (const float*)d_in[i];
    a.out = (float*)d_out; a.ws = (unsigned char*)d_ws;
#if MK_PER_PHASE
    for (int ph = 0; ph < N_PHASES; ++ph) { a.ph_lo = ph; a.ph_hi = ph + 1; hipLaunchKernelGGL(fwd_kernel, dim3(grid), dim3(512), LDS_BYTES, stream, a); }
#else
    a.ph_lo = 0; a.ph_hi = N_PHASES;
    void* args[] = {&a};
    hipError_t e = hipLaunchCooperativeKernel((const void*)fwd_kernel, dim3(grid), dim3(512), args, LDS_BYTES, stream);
    if (e != hipSuccess) fprintf(stderr, "cooperative launch failed: %s (grid %d)\n", hipGetErrorString(e), grid);
#endif
}
```

```cpp
#include <hip/hip_runtime.h>
#include <hip/hip_cooperative_groups.h>
#include <cstdio>
#include <cstdint>
namespace cg = cooperative_groups;
namespace pg8 {
#define PG8_LAS __attribute__((address_space(3)))
typedef unsigned short bf16_t;
typedef short bf16x8 __attribute__((ext_vector_type(8)));
typedef float f32x4 __attribute__((ext_vector_type(4)));
typedef unsigned u32x4 __attribute__((ext_vector_type(4)));
constexpr int BM = 256, BK = 64, HALF = 128, HTB = HALF * BK * 2  , STAGE_BYTES = 8 * HTB, NXCD = 8, WGM = 8;

__host__ __device__ __forceinline__ int lds_byte(int r, int c) { const int st = (r >> 4) * 2 + (c >> 5), rr = r & 15, cc = c & 31, ob = rr * 64 + cc * 2; return st * 1024 + (ob ^ (((ob >> 9) & 1) << 5)); }
__host__ __device__ __forceinline__ void stage_rc(int b, int& R, int& C) { const int st = b / 1024, sb = b % 1024, swz = sb ^ (((sb >> 9) & 1) << 5); R = (st >> 1) * 16 + swz / 64; C = (st & 1) * 32 + (swz % 64) / 2; }
__host__ __device__ __forceinline__ int perm32(int rho) { const int n = rho >> 4, i = rho & 15; return 8 * (i >> 2) + 4 * n + (i & 3); }

struct Unit { int pm, pn; };
struct Gemm { const bf16_t* A; const bf16_t* Bt; int M, N, K; };

struct StaticOrder {
    int nM, nN, nwg, G, c;
    __host__ __device__ void init(int M, int N, int G_, int c_) { nM = M / BM; nN = N / BM; nwg = nM * nN; G = G_; c = c_; }
    __host__ __device__ bool next(int i, Unit& u) const {
        const long L = (long)i * G + c; if (L >= nwg) return false;
        int wgid = (int)L; { const int q = nwg / NXCD, r = nwg % NXCD, xcd = wgid % NXCD, off = wgid / NXCD; wgid = (xcd < r ? xcd * (q + 1) : r * (q + 1) + (xcd - r) * q) + off; }
        const int nig = WGM * nN, gid = wgid / nig, fm = gid * WGM, gsz = (nM - fm) < WGM ? (nM - fm) : WGM;
        u.pm = fm + ((wgid % nig) % gsz); u.pn = (wgid % nig) / gsz; return true;
    }
    __device__ __forceinline__ void a_ready(const Unit&) const {}
    __device__ __forceinline__ void done(const Unit&) const {}
};
typedef float f32x2_t __attribute__((ext_vector_type(2))); typedef __bf16 bf16x2_t __attribute__((ext_vector_type(2)));
typedef unsigned u32x2 __attribute__((ext_vector_type(2)));
__device__ __forceinline__ unsigned pk2(float lo, float hi) { f32x2_t v = {lo, hi}; bf16x2_t b = __builtin_convertvector(v, bf16x2_t); return __builtin_bit_cast(unsigned, b); }
__device__ __forceinline__ float bflo(unsigned u) { return __uint_as_float(u << 16); }
__device__ __forceinline__ float bfhi(unsigned u) { return __uint_as_float(u & 0xffff0000u); }
__device__ __forceinline__ float sigm(float x) { return __builtin_amdgcn_rcpf(1.0f + __builtin_amdgcn_exp2f(x * -1.4426950408889634f)); }
constexpr float NORM_EPS = 1e-6f;
__device__ __forceinline__ float row_rstd(const float* P, int row) { const f32x4* p = (const f32x4*)(P + (size_t)row * 16); const f32x4 a = p[0], b = p[1], c = p[2], d = p[3];
    const float s = ((a[0] + a[1]) + (a[2] + a[3])) + ((b[0] + b[1]) + (b[2] + b[3])) + ((c[0] + c[1]) + (c[2] + c[3])) + ((d[0] + d[1]) + (d[2] + d[3])); return rsqrtf(s * (1.0f / 1024.0f) + NORM_EPS); }

#ifndef ER_DEPTH
#define ER_DEPTH 3
#endif
#ifndef EM_DEPTH
#define EM_DEPTH 6
#endif
__device__ __forceinline__ void wave_rstd(const float* P, int rbase, int lane, float& ra, float& rb) {
    const f32x4* p = (const f32x4*)(P + (size_t)(rbase + lane) * 16); const f32x4* q = p + 4 * HALF;
    const f32x4 a0 = p[0], a1 = p[1], a2 = p[2], a3 = p[3], b0 = q[0], b1 = q[1], b2 = q[2], b3 = q[3];
    const float sa = ((a0[0] + a0[1]) + (a0[2] + a0[3])) + ((a1[0] + a1[1]) + (a1[2] + a1[3])) + ((a2[0] + a2[1]) + (a2[2] + a2[3])) + ((a3[0] + a3[1]) + (a3[2] + a3[3]));
    const float sb = ((b0[0] + b0[1]) + (b0[2] + b0[3])) + ((b1[0] + b1[1]) + (b1[2] + b1[3])) + ((b2[0] + b2[1]) + (b2[2] + b2[3])) + ((b3[0] + b3[1]) + (b3[2] + b3[3]));
    ra = rsqrtf(sa * (1.0f / 1024.0f) + NORM_EPS); rb = rsqrtf(sb * (1.0f / 1024.0f) + NORM_EPS);
}
struct EpiIn {
    static constexpr bool PERM = true, AFTER_DRAIN = false;
    bf16_t *Q, *KV, *A, *G; const float* ss;
    __device__ __forceinline__ void operator()(const f32x4 (&acc)[2][2][4][2], const Unit& u, int wr, int wc, int fr, int fq) const {
        const int row0 = u.pm * BM + wr * 64 + fr, pn = u.pn, cw = wc * 32 + 8 * fq;
        float ra, rb; wave_rstd(ss, u.pm * BM + wr * 64, fr + 16 * fq, ra, rb);
        if (pn >= 5 && pn < 9) {
#pragma unroll
            for (int ai = 0; ai < 2; ++ai)
#pragma unroll
                for (int m = 0; m < 4; ++m) { const int row = row0 + ai * HALF + m * 16; const float rs = __shfl(ai ? rb : ra, 16 * m + fr);
                    const f32x4 u0 = acc[ai][0][m][0] * rs, u1 = acc[ai][0][m][1] * rs, g0 = acc[ai][1][m][0] * rs, g1 = acc[ai][1][m][1] * rs;
                    u32x4 w; w.x = pk2(u0[0] * sigm(g0[0]), u0[1] * sigm(g0[1])); w.y = pk2(u0[2] * sigm(g0[2]), u0[3] * sigm(g0[3]));
                    w.z = pk2(u1[0] * sigm(g1[0]), u1[1] * sigm(g1[1])); w.w = pk2(u1[2] * sigm(g1[2]), u1[3] * sigm(g1[3]));
                    *(u32x4*)(A + (size_t)row * 512 + (pn - 5) * 128 + cw) = w; }
        } else {
            bf16_t* base; int pitch; const bool sg = pn >= 9 && pn < 13;
            if (pn < 4) { base = Q + pn * 256 + cw; pitch = 1024; } else if (pn == 4) { base = KV + cw; pitch = 256; } else { base = G + (pn - 9) * 256 + cw; pitch = 2048; }
#pragma unroll
            for (int ai = 0; ai < 2; ++ai)
#pragma unroll
                for (int m = 0; m < 4; ++m) { const int row = row0 + ai * HALF + m * 16; const float rs = __shfl(ai ? rb : ra, 16 * m + fr);
                    bf16_t* rowp = base + (size_t)row * pitch;
#pragma unroll
                    for (int bj = 0; bj < 2; ++bj) { f32x4 v0 = acc[ai][bj][m][0] * rs, v1 = acc[ai][bj][m][1] * rs;
                        if (sg) { v0 = (f32x4){sigm(v0[0]), sigm(v0[1]), sigm(v0[2]), sigm(v0[3])}; v1 = (f32x4){sigm(v1[0]), sigm(v1[1]), sigm(v1[2]), sigm(v1[3])}; }
                        u32x4 w; w.x = pk2(v0[0], v0[1]); w.y = pk2(v0[2], v0[3]); w.z = pk2(v1[0], v1[1]); w.w = pk2(v1[2], v1[3]);
                        *(u32x4*)(rowp + bj * HALF) = w; } }
        }
    }
};
struct EpiMerge {
    static constexpr bool PERM = true, AFTER_DRAIN = false;
    bf16_t* AO; const bf16_t* G;
    __device__ __forceinline__ void operator()(const f32x4 (&acc)[2][2][4][2], const Unit& u, int wr, int wc, int fr, int fq) const {
        const int row0 = u.pm * BM + wr * 64 + fr, col0 = u.pn * BM + wc * 32 + 8 * fq;
        constexpr int MD = EM_DEPTH; u32x4 pa[MD], pgb[MD];
#define EM_ROW(hg) (row0 + ((hg) >> 3) * HALF + (((hg) >> 1) & 3) * 16)
#define EM_COL(hg) (col0 + ((hg) & 1) * HALF)
#define EM_LOAD(hg, s) do { pa[s] = *(const u32x4*)(AO + (size_t)EM_ROW(hg) * 1024 + EM_COL(hg)); pgb[s] = *(const u32x4*)(G + (size_t)EM_ROW(hg) * 2048 + 1024 + EM_COL(hg)); } while (0)
#pragma unroll
        for (int hg = 0; hg < MD; ++hg) EM_LOAD(hg, hg);
#pragma unroll
        for (int hg = 0; hg < 16; ++hg) { const int ai = hg >> 3, m = (hg >> 1) & 3, bj = hg & 1, s = hg % MD;
            const u32x4 ao = pa[s], gb = pgb[s]; const f32x4 c0 = acc[ai][bj][m][0], c1 = acc[ai][bj][m][1];
            u32x4 w;
            w.x = pk2(bflo(ao.x) + sigm(bflo(gb.x)) * c0[0], bfhi(ao.x) + sigm(bfhi(gb.x)) * c0[1]);
            w.y = pk2(bflo(ao.y) + sigm(bflo(gb.y)) * c0[2], bfhi(ao.y) + sigm(bfhi(gb.y)) * c0[3]);
            w.z = pk2(bflo(ao.z) + sigm(bflo(gb.z)) * c1[0], bfhi(ao.z) + sigm(bfhi(gb.z)) * c1[1]);
            w.w = pk2(bflo(ao.w) + sigm(bflo(gb.w)) * c1[2], bfhi(ao.w) + sigm(bfhi(gb.w)) * c1[3]);
            *(u32x4*)(AO + (size_t)EM_ROW(hg) * 1024 + EM_COL(hg)) = w;
            if (hg + MD < 16) EM_LOAD(hg + MD, s); }
#undef EM_ROW
#undef EM_COL
#undef EM_LOAD
    }
};
struct EpiRes {
    static constexpr bool PERM = true, AFTER_DRAIN = false;
    const bf16_t* lo_in; bf16_t* lo_out; bf16_t* XB; float* fout; float* ssn; int nxt;
    __device__ __forceinline__ void operator()(const f32x4 (&acc)[2][2][4][2], const Unit& u, int wr, int wc, int fr, int fq) const {
        const int row0 = u.pm * BM + wr * 64 + fr, col0 = u.pn * BM + wc * 32 + 8 * fq;
        constexpr int RD = ER_DEPTH; u32x4 ph[RD][2], pl[RD][2];
#define ER_ROW(g) (row0 + ((g) >> 2) * HALF + ((g) & 3) * 16)
#define ER_LOAD(g, s) do { const size_t o_ = (size_t)ER_ROW(g) * 1024 + col0; ph[s][0] = *(const u32x4*)(XB + o_); ph[s][1] = *(const u32x4*)(XB + o_ + HALF); pl[s][0] = *(const u32x4*)(lo_in + o_); pl[s][1] = *(const u32x4*)(lo_in + o_ + HALF); } while (0)
#pragma unroll
        for (int g = 0; g < RD; ++g) ER_LOAD(g, g);
#pragma unroll
        for (int g = 0; g < 8; ++g) { const int ai = g >> 2, m = g & 3, s = g % RD; const int row = ER_ROW(g); const size_t off = (size_t)row * 1024 + col0; float sq = 0.f;
#pragma unroll
            for (int bj = 0; bj < 2; ++bj) { const size_t o = off + bj * HALF; const u32x4 h = ph[s][bj], l = pl[s][bj];
                const f32x4 v0 = (f32x4){bflo(h.x) + bflo(l.x), bfhi(h.x) + bfhi(l.x), bflo(h.y) + bflo(l.y), bfhi(h.y) + bfhi(l.y)} + acc[ai][bj][m][0];
                const f32x4 v1 = (f32x4){bflo(h.z) + bflo(l.z), bfhi(h.z) + bfhi(l.z), bflo(h.w) + bflo(l.w), bfhi(h.w) + bfhi(l.w)} + acc[ai][bj][m][1];
                if (nxt) { u32x4 w; w.x = pk2(v0[0], v0[1]); w.y = pk2(v0[2], v0[3]); w.z = pk2(v1[0], v1[1]); w.w = pk2(v1[2], v1[3]); *(u32x4*)(XB + o) = w;
                    u32x4 r; r.x = pk2(v0[0] - bflo(w.x), v0[1] - bfhi(w.x)); r.y = pk2(v0[2] - bflo(w.y), v0[3] - bfhi(w.y)); r.z = pk2(v1[0] - bflo(w.z), v1[1] - bfhi(w.z)); r.w = pk2(v1[2] - bflo(w.w), v1[3] - bfhi(w.w));
                    *(u32x4*)(lo_out + o) = r;
                    sq += ((v0[0] * v0[0] + v0[1] * v0[1]) + (v0[2] * v0[2] + v0[3] * v0[3])) + ((v1[0] * v1[0] + v1[1] * v1[1]) + (v1[2] * v1[2] + v1[3] * v1[3])); }
                else { *(f32x4*)(fout + o) = v0; *(f32x4*)(fout + o + 4) = v1; } }
            if (nxt) { sq += __shfl_xor(sq, 16); sq += __shfl_xor(sq, 32); if (fq == 0) ssn[(size_t)row * 16 + u.pn * 4 + wc] = sq; }
            if (g + RD < 8) ER_LOAD(g + RD, s); }
#undef ER_ROW
#undef ER_LOAD
    }
};
struct EpiSwiglu {
    static constexpr bool PERM = true, AFTER_DRAIN = false;
    bf16_t* ACT; const float* ss;
    __device__ __forceinline__ void operator()(const f32x4 (&acc)[2][2][4][2], const Unit& u, int wr, int wc, int fr, int fq) const {
        const int row0 = u.pm * BM + wr * 64 + fr, col = u.pn * 128 + wc * 32 + 8 * fq;
        float ra, rb; wave_rstd(ss, u.pm * BM + wr * 64, fr + 16 * fq, ra, rb);
#pragma unroll
        for (int ai = 0; ai < 2; ++ai)
#pragma unroll
            for (int m = 0; m < 4; ++m) { const int row = row0 + ai * HALF + m * 16; const float rs = __shfl(ai ? rb : ra, 16 * m + fr);
                const f32x4 g0 = acc[ai][0][m][0] * rs, g1 = acc[ai][0][m][1] * rs, u0 = acc[ai][1][m][0] * rs, u1 = acc[ai][1][m][1] * rs;
                u32x4 w; w.x = pk2(g0[0] * sigm(g0[0]) * u0[0], g0[1] * sigm(g0[1]) * u0[1]); w.y = pk2(g0[2] * sigm(g0[2]) * u0[2], g0[3] * sigm(g0[3]) * u0[3]);
                w.z = pk2(g1[0] * sigm(g1[0]) * u1[0], g1[1] * sigm(g1[1]) * u1[1]); w.w = pk2(g1[2] * sigm(g1[2]) * u1[2], g1[3] * sigm(g1[3]) * u1[3]);
                *(u32x4*)(ACT + (size_t)row * 2816 + col) = w; }
    }
};
template <class Epi, class Sched, bool ALIGN_EPI = false, bool SP2 = false>
__device__ __forceinline__ void gemm_phase(PG8_LAS unsigned char* lds, const Gemm g, const Sched& S, const Epi& E) {
    int tid_l = threadIdx.x; asm volatile("" : "+v"(tid_l));
    const int tid = tid_l, wid = __builtin_amdgcn_readfirstlane(tid >> 6), lane = tid & 63, wr = wid >> 2, wc = wid & 3, fr = lane & 15, fq = lane >> 4;
    const int K = g.K, nt = K / BK;
    unsigned voffA[2], voffB[2];
#pragma unroll
    for (int i = 0; i < 2; ++i) { int R, C; stage_rc(tid * 16 + i * 8192, R, C); const int Rb = Epi::PERM ? ((R & ~31) + perm32(R & 31)) : R;
        voffA[i] = (unsigned)(R * K + C) * 2u; voffB[i] = (unsigned)(Rb * K + C) * 2u; }
    const size_t kstep = (size_t)(BK * 2);
    const size_t hstep = (size_t)HALF * K * 2;
    const size_t tstep = 2 * hstep;
    const unsigned ldsw = (unsigned)wid * 1024u;
    const int aoff = lds_byte(wr * 64 + fr, fq * 8), boff = lds_byte(wc * 32 + fr, fq * 8);
#define PG8_SA(b, h) (((b) * 2 + (h)) * HTB)
#define PG8_SB(b, h) ((4 + (b) * 2 + (h)) * HTB)
#define PG8_STAGE(bufoff, gbase, voff) do { _Pragma("unroll") for (int _i = 0; _i < 2; ++_i) \
        __builtin_amdgcn_global_load_lds((const unsigned*)((const char*)(gbase) + (voff)[_i]), (PG8_LAS unsigned*)(lds + (bufoff) + ldsw + _i * 8192), 16, 0, 0); } while (0)
#define PG8_LDA(dst, b, h) do { _Pragma("unroll") for (int m = 0; m < 4; ++m) _Pragma("unroll") for (int k = 0; k < 2; ++k) dst[m][k] = *(const PG8_LAS bf16x8*)(lds + PG8_SA(b, h) + aoff + m * 2048 + k * 1024); } while (0)
#define PG8_LDB(dst, b, h) do { _Pragma("unroll") for (int n = 0; n < 2; ++n) _Pragma("unroll") for (int k = 0; k < 2; ++k) dst[n][k] = *(const PG8_LAS bf16x8*)(lds + PG8_SB(b, h) + boff + n * 2048 + k * 1024); } while (0)
#define PG8_MMA(ai, bj, At, Bt) do { __builtin_amdgcn_s_setprio(1); _Pragma("unroll") for (int m = 0; m < 4; ++m) _Pragma("unroll") for (int n = 0; n < 2; ++n) _Pragma("unroll") for (int k = 0; k < 2; ++k) \
        acc[ai][bj][m][n] = __builtin_amdgcn_mfma_f32_16x16x32_bf16(Bt[n][k], At[m][k], acc[ai][bj][m][n], 0, 0, 0); __builtin_amdgcn_s_setprio(0); } while (0)
#define PG8_WAIT_V(n) asm volatile("s_waitcnt vmcnt(" #n ")" ::: "memory")
#define PG8_WAIT_L(n) asm volatile("s_waitcnt lgkmcnt(" #n ")" ::: "memory")
#define PG8_BAR __builtin_amdgcn_s_barrier()
#define PG8_SCHED __builtin_amdgcn_sched_barrier(0)
    Unit cur, nxt; int ui = 0;
    if (!S.next(0, cur)) return;
    f32x4 acc[2][2][4][2];
#pragma unroll
    for (int a = 0; a < 2; ++a)
#pragma unroll
        for (int b = 0; b < 2; ++b)
#pragma unroll
            for (int m = 0; m < 4; ++m)
#pragma unroll
                for (int n = 0; n < 2; ++n) acc[a][b][m][n] = (f32x4){0.f, 0.f, 0.f, 0.f};
    bf16x8 At[4][2], B0[2][2], B1[2][2];
    const char* cA = (const char*)g.A + (size_t)cur.pm * tstep; const char* cB = (const char*)g.Bt + (size_t)cur.pn * tstep;
    S.a_ready(cur);
    if constexpr (SP2) {
        PG8_STAGE(PG8_SB(0, 0), cB, voffB); PG8_STAGE(PG8_SB(0, 1), cB + hstep, voffB); PG8_STAGE(PG8_SA(0, 0), cA, voffA); PG8_STAGE(PG8_SA(0, 1), cA + hstep, voffA);
        if (wr == 1) PG8_BAR;
        PG8_WAIT_V(2); PG8_BAR;
        PG8_STAGE(PG8_SB(1, 0), cB + kstep, voffB); PG8_STAGE(PG8_SA(1, 0), cA + kstep, voffA); PG8_STAGE(PG8_SB(1, 1), cB + hstep + kstep, voffB);
        PG8_WAIT_V(6); PG8_BAR;
    } else {
        PG8_STAGE(PG8_SB(0, 0), cB, voffB); PG8_STAGE(PG8_SA(0, 0), cA, voffA); PG8_STAGE(PG8_SB(0, 1), cB + hstep, voffB); PG8_STAGE(PG8_SA(0, 1), cA + hstep, voffA);
        if (wr == 1) PG8_BAR;
        PG8_WAIT_V(4); PG8_BAR;
        PG8_STAGE(PG8_SB(1, 0), cB + kstep, voffB); PG8_STAGE(PG8_SA(1, 0), cA + kstep, voffA); PG8_STAGE(PG8_SB(1, 1), cB + hstep + kstep, voffB);
        PG8_WAIT_V(6); PG8_BAR;
    }
    for (;;) {
        const bool has_next = S.next(ui + 1, nxt);
        const char* nA = has_next ? (const char*)g.A + (size_t)nxt.pm * tstep : cA; const char* nB = has_next ? (const char*)g.Bt + (size_t)nxt.pn * tstep : cB;
        for (int t = 0; t < nt; t += 2) {
            const bool last = (t == nt - 2);
            const char* a1 = cA + (size_t)(t + 1) * kstep;
            const char* a2 = last ? nA : cA + (size_t)(t + 2) * kstep; const char* b2 = last ? nB : cB + (size_t)(t + 2) * kstep;
            const char* a3 = a2 + kstep; const char* b3 = b2 + kstep;
            if (last && has_next) S.a_ready(nxt);
            if constexpr (SP2) {
            PG8_LDB(B0, 0, 0); PG8_LDB(B1, 0, 1); PG8_SCHED; PG8_LDA(At, 0, 0); PG8_STAGE(PG8_SA(1, 1), a1 + hstep, voffA);
            PG8_WAIT_V(8); PG8_WAIT_L(0); PG8_BAR; PG8_MMA(0, 0, At, B0); PG8_MMA(0, 1, At, B1); PG8_BAR; PG8_SCHED;
            PG8_LDA(At, 0, 1); PG8_STAGE(PG8_SB(0, 0), b2, voffB); PG8_STAGE(PG8_SB(0, 1), b2 + hstep, voffB); PG8_STAGE(PG8_SA(0, 0), a2, voffA);
            PG8_WAIT_V(8); PG8_WAIT_L(0); PG8_BAR; PG8_MMA(1, 0, At, B0); PG8_MMA(1, 1, At, B1); PG8_BAR; PG8_SCHED;
            PG8_LDB(B0, 1, 0); PG8_LDB(B1, 1, 1); PG8_SCHED; PG8_LDA(At, 1, 0); PG8_STAGE(PG8_SA(0, 1), a2 + hstep, voffA);
            PG8_WAIT_V(8); PG8_WAIT_L(0); PG8_BAR; PG8_MMA(0, 0, At, B0); PG8_MMA(0, 1, At, B1); PG8_BAR; PG8_SCHED;
            PG8_LDA(At, 1, 1); PG8_STAGE(PG8_SB(1, 0), b3, voffB); PG8_STAGE(PG8_SB(1, 1), b3 + hstep, voffB); PG8_STAGE(PG8_SA(1, 0), a3, voffA);
            PG8_WAIT_V(8); PG8_WAIT_L(0); PG8_BAR; PG8_MMA(1, 0, At, B0); PG8_MMA(1, 1, At, B1); PG8_BAR; PG8_SCHED;
            } else {
            PG8_LDB(B0, 0, 0); PG8_SCHED; PG8_LDA(At, 0, 0); PG8_STAGE(PG8_SA(1, 1), a1 + hstep, voffA);
            PG8_WAIT_L(8); PG8_BAR; PG8_WAIT_L(0); PG8_MMA(0, 0, At, B0); PG8_BAR; PG8_SCHED;
            PG8_LDB(B1, 0, 1); PG8_STAGE(PG8_SB(0, 0), b2, voffB);
            PG8_BAR; PG8_WAIT_L(0); PG8_MMA(0, 1, At, B1); PG8_BAR;
            PG8_LDA(At, 0, 1); PG8_STAGE(PG8_SA(0, 0), a2, voffA);
            PG8_BAR; PG8_WAIT_L(0); PG8_MMA(1, 0, At, B0); PG8_BAR; PG8_SCHED;
            PG8_STAGE(PG8_SB(0, 1), b2 + hstep, voffB);
            PG8_WAIT_V(6); PG8_BAR; PG8_MMA(1, 1, At, B1); PG8_BAR;
            PG8_LDB(B0, 1, 0); PG8_SCHED; PG8_LDA(At, 1, 0); PG8_STAGE(PG8_SA(0, 1), a2 + hstep, voffA);
            PG8_WAIT_L(8); PG8_BAR; PG8_WAIT_L(0); PG8_MMA(0, 0, At, B0); PG8_BAR; PG8_SCHED;
            PG8_LDB(B1, 1, 1); PG8_STAGE(PG8_SB(1, 0), b3, voffB);
            PG8_BAR; PG8_WAIT_L(0); PG8_MMA(0, 1, At, B1); PG8_BAR;
            PG8_LDA(At, 1, 1); PG8_STAGE(PG8_SA(1, 0), a3, voffA);
            PG8_BAR; PG8_WAIT_L(0); PG8_MMA(1, 0, At, B0); PG8_BAR; PG8_SCHED;
            PG8_STAGE(PG8_SB(1, 1), b3 + hstep, voffB);
            PG8_WAIT_V(6); PG8_BAR; PG8_MMA(1, 1, At, B1); PG8_BAR;
            }
        }
        if constexpr (ALIGN_EPI) { if (wr == 0) PG8_BAR; }
        if constexpr (!Epi::AFTER_DRAIN) { E(acc, cur, wr, wc, fr, fq); S.done(cur); }
        if (!has_next) break;
#pragma unroll
        for (int a = 0; a < 2; ++a)
#pragma unroll
            for (int b = 0; b < 2; ++b)
#pragma unroll
                for (int m = 0; m < 4; ++m)
#pragma unroll
                    for (int n = 0; n < 2; ++n) acc[a][b][m][n] = (f32x4){0.f, 0.f, 0.f, 0.f};
        cur = nxt; cA = nA; cB = nB; ++ui;
        if constexpr (ALIGN_EPI) { if (wr == 1) PG8_BAR; }
    }
    PG8_WAIT_V(0);
    if constexpr (!ALIGN_EPI) { if (wr == 0) PG8_BAR; }
    PG8_BAR;
    if constexpr (Epi::AFTER_DRAIN) { E.fused(acc, cur, wr, wc, fr, fq, lds, wid, lane); S.done(cur); }
#undef PG8_SA
#undef PG8_SB
#undef PG8_STAGE
#undef PG8_LDA
#undef PG8_LDB
#undef PG8_MMA
#undef PG8_WAIT_V
#undef PG8_WAIT_L
#undef PG8_BAR
#undef PG8_SCHED
}
}
using pg8::bf16_t; using pg8::f32x4; using pg8::u32x4; using pg8::bf16x8; using pg8::u32x2; using pg8::pk2; using pg8::bflo; using pg8::bfhi; using pg8::sigm; using pg8::NORM_EPS;
#define LAS __attribute__((address_space(3)))
constexpr int NB = 4, T = 8192, M = NB * T, D = 1024, INW = 4352, CC = 512, FF = 2816, GU = 2 * FF, DEPTH = 4, NHEAD = 16;
constexpr size_t MiB = 1u << 20;
constexpr size_t WS_SS = 450 * MiB, SS_BUF = 2 * MiB;
constexpr size_t WS_ROPE = 1 * MiB;
constexpr size_t WS_W = 2 * MiB, W_LAYER = 28 * MiB;
constexpr size_t WO_IN = 0, WO_PW = 8 * MiB + MiB / 2, WO_OUT = WO_PW + 1 * MiB, WO_GU = WO_OUT + 2 * MiB, WO_DN = WO_GU + 11 * MiB;
constexpr size_t WS_XB = 114 * MiB, WS_QO = 178 * MiB, WS_KV = 242 * MiB, WS_A = 258 * MiB, WS_G = 290 * MiB, WS_Y = 418 * MiB, WS_BAR = 455 * MiB, WS_END = 456 * MiB;
constexpr size_t WS_LOB = 354 * MiB;
constexpr size_t WS_ACT = 178 * MiB;
static_assert(WO_DN + (size_t)D * FF * 2 == W_LAYER && WS_W + DEPTH * W_LAYER == WS_XB && WS_ACT + (size_t)M * FF * 2 <= WS_Y, "ws map");
constexpr int LDS_BYTES = 132096;

__device__ __forceinline__ float wave_sum(float v) {
#pragma unroll
    for (int o = 1; o < 64; o <<= 1) v += __shfl_xor(v, o);
    return v;
}

namespace att {
typedef __attribute__((ext_vector_type(16))) float f32x16;
typedef __attribute__((ext_vector_type(4))) short s16x4;
constexpr int KPB = 144, VPB = 520, OFF_V = 256 * KPB, SCR_OFF = 71680, SCR_WAVE = 4608;
constexpr float LOG2E = 1.4426950408889634f;
__device__ __forceinline__ int crow(int r, int hi) { return (r & 3) + 8 * (r >> 2) + 4 * hi; }

__device__ __forceinline__ void unit(LAS unsigned char* lds, int b, int kvh, int blk, bf16_t* QO, const bf16_t* KV, const bf16_t* GA, const float* qn, const float* kn, const float* sinks,
                                     const float* rope, int tid, int lane, int wave) {
    {
        const int row = tid >> 1, half = tid & 1, pos = blk * 128 - 128 + row; const bool valid = pos >= 0;
        const bf16_t* src = KV + (size_t)(b * T + pos) * 256 + kvh * 64 + half * 32;
        float x[32]; float ssq = 0.f;
#pragma unroll
        for (int i = 0; i < 4; ++i) { u32x4 r = (u32x4){0u, 0u, 0u, 0u}; if (valid) r = *(const u32x4*)(src + 8 * i);
            x[8 * i + 0] = bflo(r.x); x[8 * i + 1] = bfhi(r.x); x[8 * i + 2] = bflo(r.y); x[8 * i + 3] = bfhi(r.y); x[8 * i + 4] = bflo(r.z); x[8 * i + 5] = bfhi(r.z); x[8 * i + 6] = bflo(r.w); x[8 * i + 7] = bfhi(r.w); }
#pragma unroll
        for (int i = 0; i < 32; ++i) ssq += x[i] * x[i];
        ssq += __shfl_xor(ssq, 1);
        const float rstd = rsqrtf(ssq * (1.0f / 64.0f) + NORM_EPS);
#pragma unroll
        for (int i = 0; i < 8; ++i) { const f32x4 g = *(const f32x4*)(kn + half * 32 + 4 * i); x[4 * i] *= rstd * g[0]; x[4 * i + 1] *= rstd * g[1]; x[4 * i + 2] *= rstd * g[2]; x[4 * i + 3] *= rstd * g[3]; }
        if (half == 0 && valid) { const float* cs = rope + pos * 16;
#pragma unroll
            for (int i = 0; i < 8; ++i) { const float c = cs[i], s = cs[8 + i], x1 = x[i], x2 = x[8 + i]; x[i] = x1 * c - x2 * s; x[8 + i] = x2 * c + x1 * s; } }
#pragma unroll
        for (int i = 0; i < 4; ++i) { u32x4 w; w.x = pk2(x[8 * i], x[8 * i + 1]); w.y = pk2(x[8 * i + 2], x[8 * i + 3]); w.z = pk2(x[8 * i + 4], x[8 * i + 5]); w.w = pk2(x[8 * i + 6], x[8 * i + 7]);
            *(LAS u32x4*)(lds + row * KPB + half * 64 + 16 * i) = w; }
    }
    {
        const int rp = tid >> 2, c = tid & 3, pos0 = blk * 128 - 128 + 2 * rp; const bool valid = pos0 >= 0;
        const bf16_t* src = KV + (size_t)(b * T + pos0) * 256 + 128 + kvh * 64 + 16 * c;
        u32x4 r0[2], r1[2];
#pragma unroll
        for (int i = 0; i < 2; ++i) { r0[i] = (u32x4){0u, 0u, 0u, 0u}; r1[i] = r0[i]; if (valid) { r0[i] = *(const u32x4*)(src + 8 * i); r1[i] = *(const u32x4*)(src + 256 + 8 * i); } }
#pragma unroll
        for (int w = 0; w < 8; ++w) { const unsigned a = r0[w >> 2][w & 3], bb = r1[w >> 2][w & 3]; const int d = 16 * c + 2 * w;
            *(LAS unsigned*)(lds + OFF_V + d * VPB + rp * 4) = (a & 0xffffu) | (bb << 16);
            *(LAS unsigned*)(lds + OFF_V + (d + 1) * VPB + rp * 4) = (a >> 16) | (bb & 0xffff0000u); }
    }
    __syncthreads();
    const int h = kvh * 8 + wave, q = lane & 31, hi = lane >> 5;
    const float sink2 = sinks[h] * LOG2E;
#pragma unroll 1
    for (int sub = 0; sub < 4; ++sub) {
        const int tq = blk * 128 + 32 * sub + q; const size_t grow = (size_t)(b * T + tq);
        LAS unsigned char* scr = lds + SCR_OFF + wave * SCR_WAVE;
        const int crow8 = lane >> 3, cch = lane & 7;
        const size_t trow = (size_t)(b * T + blk * 128 + 32 * sub);
        u32x4 gtc[4];
#pragma unroll
        for (int i = 0; i < 4; ++i) { const size_t tr = trow + crow8 + 8 * i; const u32x4 r = *(const u32x4*)(QO + tr * 1024 + h * 64 + cch * 8); gtc[i] = *(const u32x4*)(GA + tr * 2048 + h * 64 + cch * 8);
            *(LAS u32x4*)(scr + (crow8 + 8 * i) * 144 + cch * 16) = r; }
        asm volatile("s_waitcnt lgkmcnt(0)" ::: "memory");
        float x[4][8]; float ssq = 0.f;
#pragma unroll
        for (int d0 = 0; d0 < 4; ++d0) { const u32x4 r = *(const LAS u32x4*)(scr + q * 144 + (16 * d0 + 8 * hi) * 2);
            x[d0][0] = bflo(r.x); x[d0][1] = bfhi(r.x); x[d0][2] = bflo(r.y); x[d0][3] = bfhi(r.y); x[d0][4] = bflo(r.z); x[d0][5] = bfhi(r.z); x[d0][6] = bflo(r.w); x[d0][7] = bfhi(r.w); }
#pragma unroll
        for (int d0 = 0; d0 < 4; ++d0)
#pragma unroll
            for (int i = 0; i < 8; ++i) ssq += x[d0][i] * x[d0][i];
        ssq += __shfl_xor(ssq, 32);
        const float rstd = rsqrtf(ssq * (1.0f / 64.0f) + NORM_EPS) * (0.125f * LOG2E);
#pragma unroll
        for (int d0 = 0; d0 < 4; ++d0) { const f32x4 g0 = *(const f32x4*)(qn + 16 * d0 + 8 * hi), g1 = *(const f32x4*)(qn + 16 * d0 + 8 * hi + 4);
            x[d0][0] *= rstd * g0[0]; x[d0][1] *= rstd * g0[1]; x[d0][2] *= rstd * g0[2]; x[d0][3] *= rstd * g0[3]; x[d0][4] *= rstd * g1[0]; x[d0][5] *= rstd * g1[1]; x[d0][6] *= rstd * g1[2]; x[d0][7] *= rstd * g1[3]; }
        { const float* cs = rope + tq * 16;
#pragma unroll
            for (int i = 0; i < 8; ++i) { const float c = cs[i], s = cs[8 + i], me = x[0][i], ot = __shfl_xor(me, 32); x[0][i] = hi == 0 ? me * c - ot * s : me * c + ot * s; } }
        bf16x8 qf[4];
#pragma unroll
        for (int d0 = 0; d0 < 4; ++d0) { u32x4 w; w.x = pk2(x[d0][0], x[d0][1]); w.y = pk2(x[d0][2], x[d0][3]); w.z = pk2(x[d0][4], x[d0][5]); w.w = pk2(x[d0][6], x[d0][7]); qf[d0] = __builtin_bit_cast(bf16x8, w); }
        f32x16 p[5];
#pragma unroll
        for (int kt = 0; kt < 5; ++kt) {
#pragma unroll
            for (int r = 0; r < 16; ++r) p[kt][r] = 0.f;
#pragma unroll
            for (int d0 = 0; d0 < 4; ++d0) { const bf16x8 kf = *(const LAS bf16x8*)(lds + (32 * (sub + kt) + q) * KPB + (16 * d0 + 8 * hi) * 2);
                p[kt] = __builtin_amdgcn_mfma_f32_32x32x16_bf16(kf, qf[d0], p[kt], 0, 0, 0); } }
        const bool first = (blk == 0);
        float mx = sink2;
#pragma unroll
        for (int kt = 0; kt < 5; ++kt) { const bool dead = first && (sub + kt < 4);
#pragma unroll
            for (int r = 0; r < 16; ++r) { const int j = crow(r, hi); bool ok = true; if (kt == 0) ok = j > q; if (kt == 4) ok = j <= q; if (dead) ok = false;
                const float v = ok ? p[kt][r] : -INFINITY; p[kt][r] = v; mx = fmaxf(mx, v); } }
        mx = fmaxf(mx, __shfl_xor(mx, 32));
        float lsum = 0.f;
#pragma unroll
        for (int kt = 0; kt < 5; ++kt)
#pragma unroll
            for (int r = 0; r < 16; ++r) { const float e = __builtin_amdgcn_exp2f(p[kt][r] - mx); p[kt][r] = e; lsum += e; }
        lsum += __shfl_xor(lsum, 32); lsum += __builtin_amdgcn_exp2f(sink2 - mx);
        const float inv = 1.0f / lsum;
        f32x16 o[2];
#pragma unroll
        for (int r = 0; r < 16; ++r) { o[0][r] = 0.f; o[1][r] = 0.f; }
#pragma unroll
        for (int kt = 0; kt < 5; ++kt)
#pragma unroll
            for (int s = 0; s < 2; ++s) { u32x4 w; w.x = pk2(p[kt][8 * s], p[kt][8 * s + 1]); w.y = pk2(p[kt][8 * s + 2], p[kt][8 * s + 3]); w.z = pk2(p[kt][8 * s + 4], p[kt][8 * s + 5]); w.w = pk2(p[kt][8 * s + 6], p[kt][8 * s + 7]);
                const bf16x8 pf = __builtin_bit_cast(bf16x8, w);
#pragma unroll
                for (int d0 = 0; d0 < 2; ++d0) { const LAS unsigned char* vp = lds + OFF_V + (32 * d0 + q) * VPB + (32 * (sub + kt) + 16 * s + 4 * hi) * 2;
                    const s16x4 lo = *(const LAS s16x4*)vp, hi4 = *(const LAS s16x4*)(vp + 16);
                    const bf16x8 vf = (bf16x8){lo[0], lo[1], lo[2], lo[3], hi4[0], hi4[1], hi4[2], hi4[3]};
                    o[d0] = __builtin_amdgcn_mfma_f32_32x32x16_bf16(vf, pf, o[d0], 0, 0, 0); } }
        asm volatile("s_waitcnt lgkmcnt(0)" ::: "memory");
#pragma unroll
        for (int d0 = 0; d0 < 2; ++d0)
#pragma unroll
            for (int g = 0; g < 4; ++g) { u32x2 w; w.x = pk2(o[d0][4 * g] * inv, o[d0][4 * g + 1] * inv); w.y = pk2(o[d0][4 * g + 2] * inv, o[d0][4 * g + 3] * inv);
                *(LAS u32x2*)(scr + q * 144 + (32 * d0 + 8 * g + 4 * hi) * 2) = w; }
        asm volatile("s_waitcnt lgkmcnt(0)" ::: "memory");
#pragma unroll
        for (int i = 0; i < 4; ++i) { const u32x4 ov = *(const LAS u32x4*)(scr + (crow8 + 8 * i) * 144 + cch * 16); const u32x4 gg = gtc[i]; u32x4 w;
            w.x = pk2(bflo(ov.x) * bflo(gg.x), bfhi(ov.x) * bfhi(gg.x)); w.y = pk2(bflo(ov.y) * bflo(gg.y), bfhi(ov.y) * bfhi(gg.y));
            w.z = pk2(bflo(ov.z) * bflo(gg.z), bfhi(ov.z) * bfhi(gg.z)); w.w = pk2(bflo(ov.w) * bflo(gg.w), bfhi(ov.w) * bfhi(gg.w));
            *(u32x4*)(QO + (trow + crow8 + 8 * i) * 1024 + h * 64 + cch * 8) = w; }
        asm volatile("s_waitcnt lgkmcnt(0)" ::: "memory");
    }
    __syncthreads();
}
}

namespace cv {
constexpr int ROWS = 62, OFF_Y = ROWS * 1024, NU = M / 32;
typedef pg8::f32x2_t f32x2;
__device__ __forceinline__ void phase(LAS unsigned char* lds, int bx, int G, const bf16_t* A, bf16_t* Y, const float* cw, const float* cb, const float* lg, const float* lb, int tid, int lane, int wave) {
    const int cp = tid & 255, tg = tid >> 8;
    f32x2 wv[31];
#pragma unroll
    for (int j = 0; j < 31; ++j) wv[j] = *(const f32x2*)(cw + j * CC + 2 * cp);
    const f32x2 bias = *(const f32x2*)(cb + 2 * cp);
    const f32x4 g0 = *(const f32x4*)(lg + 4 * lane), g1 = *(const f32x4*)(lg + 256 + 4 * lane), b0 = *(const f32x4*)(lb + 4 * lane), b1 = *(const f32x4*)(lb + 256 + 4 * lane);
    u32x4 pre[8];
#define CV_FETCH(un) do { const int t0_ = (un) * 32, p0_ = t0_ & (T - 1); _Pragma("unroll") for (int i = 0; i < 8; ++i) { const int idx = tid + 512 * i, r = idx >> 6, ch = idx & 63; pre[i] = (u32x4){0u, 0u, 0u, 0u}; \
        if (idx < ROWS * 64 && p0_ - 30 + r >= 0) pre[i] = *(const u32x4*)(A + (size_t)(t0_ - 30 + r) * CC + ch * 8); } } while (0)
    int un = bx;
    if (un < NU) CV_FETCH(un);
#pragma unroll 1
    for (; un < NU; un += G) {
        const int t0 = un * 32;
#pragma unroll
        for (int i = 0; i < 8; ++i) { const int idx = tid + 512 * i; if (idx < ROWS * 64) *(LAS u32x4*)(lds + idx * 16) = pre[i]; }
        __syncthreads();
        if (un + G < NU) CV_FETCH(un + G);
#pragma unroll 1
        for (int sb = 0; sb < 2; ++sb) { const int tb = 16 * tg + 8 * sb;
            f32x2 ac[8];
#pragma unroll
            for (int i = 0; i < 8; ++i) ac[i] = bias;
#pragma unroll
            for (int rr = 0; rr < 38; ++rr) { const unsigned v = *(const LAS unsigned*)(lds + (tb + rr) * 1024 + cp * 4); const f32x2 vv = (f32x2){bflo(v), bfhi(v)};
#pragma unroll
                for (int i = 0; i < 8; ++i) { const int j = rr - i; if (j >= 0 && j <= 30) ac[i] = __builtin_elementwise_fma(wv[j], vv, ac[i]); } }
#pragma unroll
            for (int i = 0; i < 8; ++i) *(LAS f32x2*)(lds + OFF_Y + (tb + i) * 2048 + cp * 8) = ac[i]; }
        __syncthreads();
#pragma unroll
        for (int k = 0; k < 4; ++k) { const int tok = 4 * wave + k;
            f32x4 v0 = *(const LAS f32x4*)(lds + OFF_Y + tok * 2048 + lane * 16), v1 = *(const LAS f32x4*)(lds + OFF_Y + tok * 2048 + 1024 + lane * 16);
            const float mean = wave_sum((v0[0] + v0[1]) + (v0[2] + v0[3]) + (v1[0] + v1[1]) + (v1[2] + v1[3])) * (1.0f / 512.0f);
            v0 = v0 - mean; v1 = v1 - mean;
            const float var = wave_sum((v0[0] * v0[0] + v0[1] * v0[1]) + (v0[2] * v0[2] + v0[3] * v0[3]) + (v1[0] * v1[0] + v1[1] * v1[1]) + (v1[2] * v1[2] + v1[3] * v1[3])) * (1.0f / 512.0f);
            const float rstd = rsqrtf(var + NORM_EPS);
            v0 = v0 * rstd * g0 + b0; v1 = v1 * rstd * g1 + b1;
            u32x2 w0, w1; w0.x = pk2(v0[0] * sigm(v0[0]), v0[1] * sigm(v0[1])); w0.y = pk2(v0[2] * sigm(v0[2]), v0[3] * sigm(v0[3]));
            w1.x = pk2(v1[0] * sigm(v1[0]), v1[1] * sigm(v1[1])); w1.y = pk2(v1[2] * sigm(v1[2]), v1[3] * sigm(v1[3]));
            bf16_t* yp = Y + (size_t)(t0 + tok) * CC + 4 * lane; *(u32x2*)yp = w0; *(u32x2*)(yp + 256) = w1; }
        __syncthreads();
    }
#undef CV_FETCH
}
}
__device__ __forceinline__ void transpose_item(const float* W, int K, int N, bf16_t* WT, int k0, int n0s, int n0d, const float* gain, LAS float* scr, int lane) {
    const int r8 = lane >> 3, c4 = (lane & 7) * 4;
    f32x4 v[8]; float gs[8];
#pragma unroll
    for (int i = 0; i < 8; ++i) { v[i] = *(const f32x4*)(W + (size_t)(k0 + 8 * i + r8) * N + n0s + c4); gs[i] = gain ? gain[k0 + 8 * i + r8] : 1.0f; }
#pragma unroll
    for (int i = 0; i < 8; ++i) { LAS float* d = scr + (8 * i + r8) * 33 + c4; d[0] = v[i][0] * gs[i]; d[1] = v[i][1] * gs[i]; d[2] = v[i][2] * gs[i]; d[3] = v[i][3] * gs[i]; }
    asm volatile("s_waitcnt lgkmcnt(0)" ::: "memory");
    const int c = lane & 7;
#pragma unroll
    for (int j = 0; j < 4; ++j) { const int n = (lane >> 3) + 8 * j; const LAS float* s = scr + (8 * c) * 33 + n;
        u32x4 o; o.x = pk2(s[0 * 33], s[1 * 33]); o.y = pk2(s[2 * 33], s[3 * 33]); o.z = pk2(s[4 * 33], s[5 * 33]); o.w = pk2(s[6 * 33], s[7 * 33]);
        *(u32x4*)(WT + (size_t)(n0d + n) * K + k0 + 8 * c) = o; }
    asm volatile("s_waitcnt lgkmcnt(0)" ::: "memory");
}
__device__ __forceinline__ int perm_in(int n0d) { const int pn = n0d >> 8, h = (n0d >> 7) & 1, j = n0d & 127; if (pn >= 5 && pn < 9) return (h ? 1792 : 1280) + 128 * (pn - 5) + j; return n0d; }
__device__ __forceinline__ int perm_gu(int n0d) { const int pn = n0d >> 8, h = (n0d >> 7) & 1, j = n0d & 127; return (h ? FF : 0) + 128 * pn + j; }

struct Args { const float* in[15]; float* out; unsigned char* ws; int ph_lo, ph_hi; };
enum { I_X = 0, I_NMIX, I_WIN, I_QN, I_KN, I_SINK, I_CW, I_CB, I_LG, I_LB, I_WPW, I_WOUT, I_NFFN, I_WGU, I_WDN };

__device__ __forceinline__ void convert_layer(const Args& a, int l, int slot, int nslots, LAS float* scr, int lane) {
    constexpr int I_IN = (D / 64) * (INW / 32), I_PW = (CC / 64) * (D / 32), I_OUT = (D / 64) * (D / 32), I_GU = (D / 64) * (GU / 32), I_DN = (FF / 64) * (D / 32), PER_L = I_IN + I_PW + I_OUT + I_GU + I_DN;
    unsigned char* wb = a.ws + WS_W + (size_t)l * W_LAYER;
    for (int it = slot; it < PER_L; it += nslots) {
        int r = it;
        if (r < I_IN) { const int nblk = INW / 32, kb = r / nblk, nb = r % nblk; transpose_item(a.in[I_WIN] + (size_t)l * D * INW, D, INW, (bf16_t*)(wb + WO_IN), 64 * kb, perm_in(32 * nb), 32 * nb, a.in[I_NMIX] + l * D, scr, lane); continue; } r -= I_IN;
        if (r < I_PW) { const int nblk = D / 32, kb = r / nblk, nb = r % nblk; transpose_item(a.in[I_WPW] + (size_t)l * CC * D, CC, D, (bf16_t*)(wb + WO_PW), 64 * kb, 32 * nb, 32 * nb, nullptr, scr, lane); continue; } r -= I_PW;
        if (r < I_OUT) { const int nblk = D / 32, kb = r / nblk, nb = r % nblk; transpose_item(a.in[I_WOUT] + (size_t)l * D * D, D, D, (bf16_t*)(wb + WO_OUT), 64 * kb, 32 * nb, 32 * nb, nullptr, scr, lane); continue; } r -= I_OUT;
        if (r < I_GU) { const int nblk = GU / 32, kb = r / nblk, nb = r % nblk; transpose_item(a.in[I_WGU] + (size_t)l * D * GU, D, GU, (bf16_t*)(wb + WO_GU), 64 * kb, perm_gu(32 * nb), 32 * nb, a.in[I_NFFN] + l * D, scr, lane); continue; } r -= I_GU;
        { const int nblk = D / 32, kb = r / nblk, nb = r % nblk; transpose_item(a.in[I_WDN] + (size_t)l * FF * D, FF, D, (bf16_t*)(wb + WO_DN), 64 * kb, 32 * nb, 32 * nb, nullptr, scr, lane); }
    }
}
__device__ __forceinline__ void prologue(const Args& a, LAS unsigned char* lds, int tid, int lane, int wave) {
    LAS float* scr = (LAS float*)(lds + wave * 16384);
    const int gw = blockIdx.x * 8 + wave, NGW = gridDim.x * 8;
    const int lw = gridDim.x == 256 ? 1 : DEPTH;
    for (int l = 0; l < lw; ++l) convert_layer(a, l, gw, NGW, scr, lane);
    float* ss = (float*)(a.ws + WS_SS); bf16_t* XB = (bf16_t*)(a.ws + WS_XB);
    bf16_t* LOA = (bf16_t*)a.out;
    for (int m = gw; m < M; m += NGW) { const f32x4* xr = (const f32x4*)(a.in[I_X] + (size_t)m * D) + lane; u32x2* xo = (u32x2*)(XB + (size_t)m * D) + lane; u32x2* lo = (u32x2*)(LOA + (size_t)m * D) + lane; float s = 0.f;
#pragma unroll
        for (int j = 0; j < 4; ++j) { const f32x4 v = xr[64 * j]; s += (v[0] * v[0] + v[1] * v[1]) + (v[2] * v[2] + v[3] * v[3]); u32x2 w; w.x = pk2(v[0], v[1]); w.y = pk2(v[2], v[3]); xo[64 * j] = w;
            u32x2 r; r.x = pk2(v[0] - bflo(w.x), v[1] - bfhi(w.x)); r.y = pk2(v[2] - bflo(w.y), v[3] - bfhi(w.y)); lo[64 * j] = r; }
        s = wave_sum(s); if (lane < 16) ss[(size_t)m * 16 + lane] = lane == 0 ? s : 0.f; }
    float* rope = (float*)(a.ws + WS_ROPE);
    for (int i = blockIdx.x * 512 + tid; i < T * 8; i += gridDim.x * 512) { const int t = i >> 3, f = i & 7;
        double fr = 1.0; for (int k = 0; k < f; ++k) fr *= 0.19392274474868576;
        const float inv_freq = (float)fr; const float ang = (float)t * inv_freq;
        const double x = (double)ang, kq = __builtin_rint(x * 0.6366197723675814);
        const double r = __builtin_fma(-kq, 6.123233995736766e-17, __builtin_fma(-kq, 1.5707963267948966, x)), r2 = r * r;
        const double sp = r * (1.0 + r2 * (-1.0 / 6 + r2 * (1.0 / 120 + r2 * (-1.0 / 5040 + r2 * (1.0 / 362880 + r2 * (-1.0 / 39916800 + r2 * (1.0 / 6227020800.0)))))));
        const double cp = 1.0 + r2 * (-0.5 + r2 * (1.0 / 24 + r2 * (-1.0 / 720 + r2 * (1.0 / 40320 + r2 * (-1.0 / 3628800 + r2 * (1.0 / 479001600 + r2 * (-1.0 / 87178291200.0)))))));
        const int qd = ((int)kq) & 3;
        const double sn = qd == 0 ? sp : qd == 1 ? cp : qd == 2 ? -sp : -cp, cn = qd == 0 ? cp : qd == 1 ? -sp : qd == 2 ? -cp : sp;
        rope[t * 16 + f] = (float)cn; rope[t * 16 + 8 + f] = (float)sn; }
}

#define XB_TMO      128
#define XB_XCNT(j)  (256  + 64 * (j))
#define XB_XSUB(j)  (1280 + 64 * (j))
#define XB_XGEN(j)  (2304 + 64 * (j))
#define XB_TOP      3328
#define XB_TOPGEN   3392
#define XCD_BAR_WORDS 3456
#define XB_SPIN_CAP (1u << 18)

__device__ __forceinline__ unsigned xb_ld(unsigned* p)              { return __hip_atomic_load(p, __ATOMIC_RELAXED, __HIP_MEMORY_SCOPE_AGENT); }
__device__ __forceinline__ unsigned xb_add(unsigned* p, unsigned v) { return __hip_atomic_fetch_add(p, v, __ATOMIC_RELAXED, __HIP_MEMORY_SCOPE_AGENT); }
__device__ __forceinline__ unsigned xb_xcc_id() { return (unsigned)__builtin_amdgcn_s_getreg((3 << 11) | 20) & 0xFu; }
#define XB_SPIN(cond, bar) do { unsigned _sp = 0; while (cond) { __builtin_amdgcn_s_sleep(1); \
    if ((++_sp & 255u) == 0u) { if (xb_ld(&(bar)[XB_TMO])) break; if (_sp > XB_SPIN_CAP) { atomicAdd(&(bar)[XB_TMO], 1u); break; } } } } while (0)

struct XcdBarrier {
    unsigned* bar; unsigned x;
    volatile LAS unsigned* st;
};

__device__ __forceinline__ XcdBarrier xcd_barrier_post(unsigned* bar, volatile LAS unsigned* st) {
    XcdBarrier b; b.bar = bar; b.x = xb_xcc_id(); b.st = st;
    if (threadIdx.x == 0) (void)xb_add(&bar[XB_XCNT(b.x)], 1u);
    return b;
}
__device__ __forceinline__ void xcd_barrier_complete(unsigned* bar, unsigned x, unsigned& nloc, unsigned& nx) {
    const unsigned G = gridDim.x * gridDim.y * gridDim.z;
    unsigned sum, cnt, mine, sp = 0u;
    for (;;) {
        sum = 0u; cnt = 0u; mine = 0u;
#pragma unroll
        for (unsigned j = 0; j < 16; ++j) { const unsigned c = xb_ld(&bar[XB_XCNT(j)]); sum += c; cnt += (c > 0u) ? 1u : 0u; mine = (j == x) ? c : mine; }
        if (sum == G) break;
        __builtin_amdgcn_s_sleep(1);
        if ((++sp & 255u) == 0u) { if (xb_ld(&bar[XB_TMO])) break; if (sp > XB_SPIN_CAP) { atomicAdd(&bar[XB_TMO], 1u); break; } }
    }
    nloc = mine > 0u ? mine : 1u; nx = cnt > 0u ? cnt : 1u;
}

__device__ __forceinline__ void xcd_barrier(const XcdBarrier& b) {
    asm volatile("s_waitcnt vmcnt(0)" ::: "memory");
    __syncthreads();
    if (threadIdx.x == 0) {
        unsigned* bar = b.bar;
        __builtin_amdgcn_s_waitcnt(0);
        unsigned nloc = b.st[0], nx = b.st[1];
        if (nloc == 0u) { xcd_barrier_complete(bar, b.x, nloc, nx); b.st[0] = nloc; b.st[1] = nx; }
        const unsigned old = xb_add(&bar[XB_XSUB(b.x)], 1u);
        const unsigned gen = old / nloc;
        if (old + 1u == (gen + 1u) * nloc) {
            __builtin_amdgcn_fence(__ATOMIC_RELEASE, "agent");
            asm volatile("s_waitcnt vmcnt(0)" ::: "memory");
            const unsigned og = xb_add(&bar[XB_TOP], 1u);
            const unsigned tg = og / nx;
            if (og + 1u == (tg + 1u) * nx) xb_add(&bar[XB_TOPGEN], 1u);
            else XB_SPIN(xb_ld(&bar[XB_TOPGEN]) == tg, bar);
            __builtin_amdgcn_fence(__ATOMIC_ACQUIRE, "agent");
            xb_add(&bar[XB_XGEN(b.x)], 1u);
            asm volatile("s_waitcnt vmcnt(0)" ::: "memory");
        } else {
            XB_SPIN(xb_ld(&bar[XB_XGEN(b.x)]) == gen, bar);
            __builtin_amdgcn_fence(__ATOMIC_ACQUIRE, "agent");
            asm volatile("s_waitcnt vmcnt(0)" ::: "memory");
        }
    }
    __syncthreads();
}

#ifndef PROBE
#define PROBE 0
#endif
#define tsb ((LAS unsigned long long*)(lds + 131072))
#ifndef PROBE_A
#define PROBE_A 2
#endif
#ifndef PROBE_B
#define PROBE_B 3
#endif
#ifndef PROBE_SA
#define PROBE_SA 0.01f
#endif
#ifndef PROBE_SB
#define PROBE_SB 0.01f
#endif
constexpr int N_PHASES = 1 + 6 * DEPTH;
__global__ void __launch_bounds__(512, 2) fwd_kernel(Args a) {
    extern __shared__ __attribute__((aligned(16))) unsigned char lds_raw[];
    LAS unsigned char* lds = (LAS unsigned char*)lds_raw;
    cg::grid_group grid = cg::this_grid();
    volatile LAS unsigned* bst = (volatile LAS unsigned*)(lds + 131072 + 768);
    if (threadIdx.x < 2) bst[threadIdx.x] = 0u;
    __syncthreads();
    const XcdBarrier xbar = xcd_barrier_post((unsigned*)(a.ws + WS_BAR), bst);
    const int G = gridDim.x, bx = blockIdx.x;
    unsigned char* ws = a.ws;
    float* ss = (float*)(ws + WS_SS); const float* rope = (const float*)(ws + WS_ROPE);
    bf16_t* XB = (bf16_t*)(ws + WS_XB); bf16_t* QO = (bf16_t*)(ws + WS_QO); bf16_t* KV = (bf16_t*)(ws + WS_KV); bf16_t* AB = (bf16_t*)(ws + WS_A);
    bf16_t* GB = (bf16_t*)(ws + WS_G); bf16_t* YB = (bf16_t*)(ws + WS_Y); bf16_t* ACT = (bf16_t*)(ws + WS_ACT);
#pragma unroll 1
    for (int ph = a.ph_lo; ph < a.ph_hi; ++ph) {
        if (ph > a.ph_lo) { if (ph == 1) grid.sync(); else xcd_barrier(xbar); }
        int tid_l = threadIdx.x; asm volatile("" : "+v"(tid_l));
#if PROBE
        if (threadIdx.x == 0) tsb[ph] = __builtin_amdgcn_s_memrealtime();
#endif
        const int tid = tid_l, lane = tid & 63, wave = __builtin_amdgcn_readfirstlane(tid >> 6);
        if (ph == 0) { prologue(a, lds, tid, lane, wave); continue; }
        const int l = (ph - 1) / 6, s = (ph - 1) % 6;
        const unsigned char* wb = ws + WS_W + (size_t)l * W_LAYER;
        if (s == 0) {
            pg8::Gemm g{XB, (const bf16_t*)(wb + WO_IN), M, INW, D}; pg8::StaticOrder S; S.init(M, INW, G, bx);
            pg8::EpiIn E{QO, KV, AB, GB, ss};
            pg8::gemm_phase<pg8::EpiIn, pg8::StaticOrder, true, true>(lds, g, S, E);
            if (G == 256 && bx >= 128 && l + 1 < DEPTH) convert_layer(a, l + 1, (bx - 128) * 8 + wave, 128 * 8, (LAS float*)(lds + wave * 16384), lane);
        } else if (s == 1) {
            for (int u = bx; u < NB * 2 * (T / 128); u += G) { const int blk = u & 63, kvh = (u >> 6) & 1, b = u >> 7;
                att::unit(lds, b, kvh, blk, QO, KV, GB, a.in[I_QN] + l * 64, a.in[I_KN] + l * 64, a.in[I_SINK] + l * NHEAD, rope, tid, lane, wave); }
#if PROBE
            if (threadIdx.x == 0) tsb[32 + l] = __builtin_amdgcn_s_memrealtime();
#endif
            cv::phase(lds, bx, G, AB, YB, a.in[I_CW] + (size_t)l * 31 * CC, a.in[I_CB] + l * CC, a.in[I_LG] + l * CC, a.in[I_LB] + l * CC, tid, lane, wave);
        } else if (s == 2) {
            pg8::Gemm g{YB, (const bf16_t*)(wb + WO_PW), M, D, CC}; pg8::StaticOrder S; S.init(M, D, G, bx);
            pg8::EpiMerge E{QO, GB};
            pg8::gemm_phase<pg8::EpiMerge, pg8::StaticOrder, true, true>(lds, g, S, E);
        } else if (s == 3) {
            pg8::Gemm g{QO, (const bf16_t*)(wb + WO_OUT), M, D, D}; pg8::StaticOrder S; S.init(M, D, G, bx);
            pg8::EpiRes E{(const bf16_t*)a.out, (bf16_t*)(ws + WS_LOB), XB, a.out, ss + (size_t)M * 16, 1};
            pg8::gemm_phase<pg8::EpiRes, pg8::StaticOrder, true, true>(lds, g, S, E);
        } else if (s == 4) {
            pg8::Gemm g{XB, (const bf16_t*)(wb + WO_GU), M, GU, D}; pg8::StaticOrder S; S.init(M, GU, G, bx);
            pg8::EpiSwiglu E{ACT, ss + (size_t)M * 16};
            pg8::gemm_phase<pg8::EpiSwiglu, pg8::StaticOrder, true, true>(lds, g, S, E);
        } else {
            pg8::Gemm g{ACT, (const bf16_t*)(wb + WO_DN), M, D, FF}; pg8::StaticOrder S; S.init(M, D, G, bx);
            pg8::EpiRes E{(const bf16_t*)(ws + WS_LOB), (bf16_t*)a.out, XB, a.out, ss, l + 1 < DEPTH ? 1 : 0};
            pg8::gemm_phase<pg8::EpiRes, pg8::StaticOrder, true, true>(lds, g, S, E);
        }
    }
#if PROBE
    if (bx == 0) {
        LAS float* pv = (LAS float*)(lds + 131072 + 512);
        if (threadIdx.x == 0) { tsb[N_PHASES] = __builtin_amdgcn_s_memrealtime();
            unsigned long long sa = 0, sb = 0;
#pragma unroll 1
            for (int l = 0; l < DEPTH; ++l) { const int b = 1 + 6 * l;
                const unsigned long long d1 = tsb[b + 1] - tsb[b], d2 = tsb[32 + l] - tsb[b + 1], d3 = tsb[b + 2] - tsb[32 + l], d4 = tsb[b + 3] - tsb[b + 2], d5 = tsb[b + 4] - tsb[b + 3], d6 = tsb[b + 5] - tsb[b + 4], d7 = tsb[b + 6] - tsb[b + 5];
                sa += PROBE_A == 1 ? d1 : PROBE_A == 2 ? d2 : PROBE_A == 3 ? d3 : PROBE_A == 4 ? d4 : PROBE_A == 5 ? d5 : PROBE_A == 6 ? d6 : PROBE_A == 7 ? d7 : 0;
                sb += PROBE_B == 1 ? d1 : PROBE_B == 2 ? d2 : PROBE_B == 3 ? d3 : PROBE_B == 4 ? d4 : PROBE_B == 5 ? d5 : PROBE_B == 6 ? d6 : PROBE_B == 7 ? d7 : 0; }
            if (PROBE_A == 0) sa = tsb[1] - tsb[0]; if (PROBE_B == 0) sb = tsb[1] - tsb[0];
            pv[0] = (float)sa * 0.01f * PROBE_SA; pv[1] = PROBE_B == 8 ? 20.0f : (float)sb * 0.01f * PROBE_SB; }
        __syncthreads();
        if (threadIdx.x == 0) a.out[0] += pv[0];
        if (PROBE_B >= 0) for (int i = threadIdx.x + 512; i < 65536; i += 512) a.out[(size_t)(i >> 8) * 1024 + (i & 255)] += pv[1] * 0.0625f;
    }
#endif
}

#ifndef MK_PER_PHASE
#define MK_PER_PHASE 0
#endif
extern "C" void kernel_launch(void* const* d_in, const int* in_sizes, int n_in, void* d_out, int out_size, void* d_ws, size_t ws_size, hipStream_t stream) {
    static int grid = 0;
    if (grid == 0) {
        if (n_in != 15 || in_sizes[0] != M * D || out_size != M * D || ws_size < WS_END) { fprintf(stderr, "kernel_launch: unexpected shapes / workspace (n_in %d, ws %zu)\n", n_in, ws_size); grid = -1; return; }
        int dev = 0, cus = 0, per_cu = 0;
        (void)hipGetDevice(&dev); (void)hipDeviceGetAttribute(&cus, hipDeviceAttributeMultiprocessorCount, dev);
        if (hipFuncSetAttribute((const void*)fwd_kernel, hipFuncAttributeMaxDynamicSharedMemorySize, LDS_BYTES) != hipSuccess) { fprintf(stderr, "kernel_launch: hipFuncSetAttribute failed\n"); grid = -1; return; }
        if (hipOccupancyMaxActiveBlocksPerMultiprocessor(&per_cu, (const void*)fwd_kernel, 512, LDS_BYTES) != hipSuccess || per_cu < 1) { fprintf(stderr, "kernel_launch: occupancy query says %d\n", per_cu); per_cu = 1; }
        (void)hipGetLastError();
        grid = cus * per_cu;
    }
    if (grid < 0) return;
    if (hipMemsetAsync((char*)d_ws + WS_BAR, 0, 16384, stream) != hipSuccess) { fprintf(stderr, "kernel_launch: memset of the barrier words failed\n"); return; }
    Args a{};
    for (int i = 0; i < 15; ++i) a.in[i] = (const float*)d_in[i];
    a.out = (float*)d_out; a.ws = (unsigned char*)d_ws;
#if MK_PER_PHASE
    for (int ph = 0; ph < N_PHASES; ++ph) { a.ph_lo = ph; a.ph_hi = ph + 1; hipLaunchKernelGGL(fwd_kernel, dim3(grid), dim3(512), LDS_BYTES, stream, a); }
#else
    a.ph_lo = 0; a.ph_hi = N_PHASES;
    void* args[] = {&a};
    hipError_t e = hipLaunchCooperativeKernel((const void*)fwd_kernel, dim3(grid), dim3(512), args, LDS_BYTES, stream);
    if (e != hipSuccess) fprintf(stderr, "cooperative launch failed: %s (grid %d)\n", hipGetErrorString(e), grid);
#endif
}
```

```cpp
#include <hip/hip_runtime.h>
#include <hip/hip_cooperative_groups.h>
#include <cstdio>
#include <cstdint>
namespace cg = cooperative_groups;
namespace pg8 {
#define PG8_LAS __attribute__((address_space(3)))
typedef unsigned short bf16_t;
typedef short bf16x8 __attribute__((ext_vector_type(8)));
typedef float f32x4 __attribute__((ext_vector_type(4)));
typedef unsigned u32x4 __attribute__((ext_vector_type(4)));
constexpr int BM = 256, BK = 64, HALF = 128, HTB = HALF * BK * 2  , STAGE_BYTES = 8 * HTB, NXCD = 8, WGM = 8;

__host__ __device__ __forceinline__ int lds_byte(int r, int c) { const int st = (r >> 4) * 2 + (c >> 5), rr = r & 15, cc = c & 31, ob = rr * 64 + cc * 2; return st * 1024 + (ob ^ (((ob >> 9) & 1) << 5)); }
__host__ __device__ __forceinline__ void stage_rc(int b, int& R, int& C) { const int st = b / 1024, sb = b % 1024, swz = sb ^ (((sb >> 9) & 1) << 5); R = (st >> 1) * 16 + swz / 64; C = (st & 1) * 32 + (swz % 64) / 2; }
__host__ __device__ __forceinline__ int perm32(int rho) { const int n = rho >> 4, i = rho & 15; return 8 * (i >> 2) + 4 * n + (i & 3); }

struct Unit { int pm, pn; };
struct Gemm { const bf16_t* A; const bf16_t* Bt; int M, N, K; };

struct StaticOrder {
    int nM, nN, nwg, G, c;
    __host__ __device__ void init(int M, int N, int G_, int c_) { nM = M / BM; nN = N / BM; nwg = nM * nN; G = G_; c = c_; }
    __host__ __device__ bool next(int i, Unit& u) const {
        const long L = (long)i * G + c; if (L >= nwg) return false;
        int wgid = (int)L; { const int q = nwg / NXCD, r = nwg % NXCD, xcd = wgid % NXCD, off = wgid / NXCD; wgid = (xcd < r ? xcd * (q + 1) : r * (q + 1) + (xcd - r) * q) + off; }
        const int nig = WGM * nN, gid = wgid / nig, fm = gid * WGM, gsz = (nM - fm) < WGM ? (nM - fm) : WGM;
        u.pm = fm + ((wgid % nig) % gsz); u.pn = (wgid % nig) / gsz; return true;
    }
    __device__ __forceinline__ void a_ready(const Unit&) const {}
    __device__ __forceinline__ void done(const Unit&) const {}
};
typedef float f32x2_t __attribute__((ext_vector_type(2))); typedef __bf16 bf16x2_t __attribute__((ext_vector_type(2)));
typedef unsigned u32x2 __attribute__((ext_vector_type(2)));
__device__ __forceinline__ unsigned pk2(float lo, float hi) { f32x2_t v = {lo, hi}; bf16x2_t b = __builtin_convertvector(v, bf16x2_t); return __builtin_bit_cast(unsigned, b); }
__device__ __forceinline__ float bflo(unsigned u) { return __uint_as_float(u << 16); }
__device__ __forceinline__ float bfhi(unsigned u) { return __uint_as_float(u & 0xffff0000u); }
__device__ __forceinline__ float sigm(float x) { return __builtin_amdgcn_rcpf(1.0f + __builtin_amdgcn_exp2f(x * -1.4426950408889634f)); }
constexpr float NORM_EPS = 1e-6f;
__device__ __forceinline__ float row_rstd(const float* P, int row) { const f32x4* p = (const f32x4*)(P + (size_t)row * 16); const f32x4 a = p[0], b = p[1], c = p[2], d = p[3];
    const float s = ((a[0] + a[1]) + (a[2] + a[3])) + ((b[0] + b[1]) + (b[2] + b[3])) + ((c[0] + c[1]) + (c[2] + c[3])) + ((d[0] + d[1]) + (d[2] + d[3])); return rsqrtf(s * (1.0f / 1024.0f) + NORM_EPS); }

#ifndef ER_DEPTH
#define ER_DEPTH 3
#endif
#ifndef EM_DEPTH
#define EM_DEPTH 6
#endif
__device__ __forceinline__ void wave_rstd(const float* P, int rbase, int lane, float& ra, float& rb) {
    const f32x4* p = (const f32x4*)(P + (size_t)(rbase + lane) * 16); const f32x4* q = p + 4 * HALF;
    const f32x4 a0 = p[0], a1 = p[1], a2 = p[2], a3 = p[3], b0 = q[0], b1 = q[1], b2 = q[2], b3 = q[3];
    const float sa = ((a0[0] + a0[1]) + (a0[2] + a0[3])) + ((a1[0] + a1[1]) + (a1[2] + a1[3])) + ((a2[0] + a2[1]) + (a2[2] + a2[3])) + ((a3[0] + a3[1]) + (a3[2] + a3[3]));
    const float sb = ((b0[0] + b0[1]) + (b0[2] + b0[3])) + ((b1[0] + b1[1]) + (b1[2] + b1[3])) + ((b2[0] + b2[1]) + (b2[2] + b2[3])) + ((b3[0] + b3[1]) + (b3[2] + b3[3]));
    ra = rsqrtf(sa * (1.0f / 1024.0f) + NORM_EPS); rb = rsqrtf(sb * (1.0f / 1024.0f) + NORM_EPS);
}
struct EpiIn {
    static constexpr bool PERM = true, AFTER_DRAIN = false;
    bf16_t *Q, *KV, *A, *G; const float* ss;
    __device__ __forceinline__ void operator()(const f32x4 (&acc)[2][2][4][2], const Unit& u, int wr, int wc, int fr, int fq) const {
        const int row0 = u.pm * BM + wr * 64 + fr, pn = u.pn, cw = wc * 32 + 8 * fq;
        float ra, rb; wave_rstd(ss, u.pm * BM + wr * 64, fr + 16 * fq, ra, rb);
        if (pn >= 5 && pn < 9) {
#pragma unroll
            for (int ai = 0; ai < 2; ++ai)
#pragma unroll
                for (int m = 0; m < 4; ++m) { const int row = row0 + ai * HALF + m * 16; const float rs = __shfl(ai ? rb : ra, 16 * m + fr);
                    const f32x4 u0 = acc[ai][0][m][0] * rs, u1 = acc[ai][0][m][1] * rs, g0 = acc[ai][1][m][0] * rs, g1 = acc[ai][1][m][1] * rs;
                    u32x4 w; w.x = pk2(u0[0] * sigm(g0[0]), u0[1] * sigm(g0[1])); w.y = pk2(u0[2] * sigm(g0[2]), u0[3] * sigm(g0[3]));
                    w.z = pk2(u1[0] * sigm(g1[0]), u1[1] * sigm(g1[1])); w.w = pk2(u1[2] * sigm(g1[2]), u1[3] * sigm(g1[3]));
                    *(u32x4*)(A + (size_t)row * 512 + (pn - 5) * 128 + cw) = w; }
        } else {
            bf16_t* base; int pitch; const bool sg = pn >= 9 && pn < 13;
            if (pn < 4) { base = Q + pn * 256 + cw; pitch = 1024; } else if (pn == 4) { base = KV + cw; pitch = 256; } else { base = G + (pn - 9) * 256 + cw; pitch = 2048; }
#pragma unroll
            for (int ai = 0; ai < 2; ++ai)
#pragma unroll
                for (int m = 0; m < 4; ++m) { const int row = row0 + ai * HALF + m * 16; const float rs = __shfl(ai ? rb : ra, 16 * m + fr);
                    bf16_t* rowp = base + (size_t)row * pitch;
#pragma unroll
                    for (int bj = 0; bj < 2; ++bj) { f32x4 v0 = acc[ai][bj][m][0] * rs, v1 = acc[ai][bj][m][1] * rs;
                        if (sg) { v0 = (f32x4){sigm(v0[0]), sigm(v0[1]), sigm(v0[2]), sigm(v0[3])}; v1 = (f32x4){sigm(v1[0]), sigm(v1[1]), sigm(v1[2]), sigm(v1[3])}; }
                        u32x4 w; w.x = pk2(v0[0], v0[1]); w.y = pk2(v0[2], v0[3]); w.z = pk2(v1[0], v1[1]); w.w = pk2(v1[2], v1[3]);
                        *(u32x4*)(rowp + bj * HALF) = w; } }
        }
    }
};
struct EpiMerge {
    static constexpr bool PERM = true, AFTER_DRAIN = false;
    bf16_t* AO; const bf16_t* G;
    __device__ __forceinline__ void operator()(const f32x4 (&acc)[2][2][4][2], const Unit& u, int wr, int wc, int fr, int fq) const {
        const int row0 = u.pm * BM + wr * 64 + fr, col0 = u.pn * BM + wc * 32 + 8 * fq;
        constexpr int MD = EM_DEPTH; u32x4 pa[MD], pgb[MD];
#define EM_ROW(hg) (row0 + ((hg) >> 3) * HALF + (((hg) >> 1) & 3) * 16)
#define EM_COL(hg) (col0 + ((hg) & 1) * HALF)
#define EM_LOAD(hg, s) do { pa[s] = *(const u32x4*)(AO + (size_t)EM_ROW(hg) * 1024 + EM_COL(hg)); pgb[s] = *(const u32x4*)(G + (size_t)EM_ROW(hg) * 2048 + 1024 + EM_COL(hg)); } while (0)
#pragma unroll
        for (int hg = 0; hg < MD; ++hg) EM_LOAD(hg, hg);
#pragma unroll
        for (int hg = 0; hg < 16; ++hg) { const int ai = hg >> 3, m = (hg >> 1) & 3, bj = hg & 1, s = hg % MD;
            const u32x4 ao = pa[s], gb = pgb[s]; const f32x4 c0 = acc[ai][bj][m][0], c1 = acc[ai][bj][m][1];
            u32x4 w;
            w.x = pk2(bflo(ao.x) + sigm(bflo(gb.x)) * c0[0], bfhi(ao.x) + sigm(bfhi(gb.x)) * c0[1]);
            w.y = pk2(bflo(ao.y) + sigm(bflo(gb.y)) * c0[2], bfhi(ao.y) + sigm(bfhi(gb.y)) * c0[3]);
            w.z = pk2(bflo(ao.z) + sigm(bflo(gb.z)) * c1[0], bfhi(ao.z) + sigm(bfhi(gb.z)) * c1[1]);
            w.w = pk2(bflo(ao.w) + sigm(bflo(gb.w)) * c1[2], bfhi(ao.w) + sigm(bfhi(gb.w)) * c1[3]);
            *(u32x4*)(AO + (size_t)EM_ROW(hg) * 1024 + EM_COL(hg)) = w;
            if (hg + MD < 16) EM_LOAD(hg + MD, s); }
#undef EM_ROW
#undef EM_COL
#undef EM_LOAD
    }
};
struct EpiRes {
    static constexpr bool PERM = true, AFTER_DRAIN = false;
    const bf16_t* lo_in; bf16_t* lo_out; bf16_t* XB; float* fout; float* ssn; int nxt;
    __device__ __forceinline__ void operator()(const f32x4 (&acc)[2][2][4][2], const Unit& u, int wr, int wc, int fr, int fq) const {
        const int row0 = u.pm * BM + wr * 64 + fr, col0 = u.pn * BM + wc * 32 + 8 * fq;
        constexpr int RD = ER_DEPTH; u32x4 ph[RD][2], pl[RD][2];
#define ER_ROW(g) (row0 + ((g) >> 2) * HALF + ((g) & 3) * 16)
#define ER_LOAD(g, s) do { const size_t o_ = (size_t)ER_ROW(g) * 1024 + col0; ph[s][0] = *(const u32x4*)(XB + o_); ph[s][1] = *(const u32x4*)(XB + o_ + HALF); pl[s][0] = *(const u32x4*)(lo_in + o_); pl[s][1] = *(const u32x4*)(lo_in + o_ + HALF); } while (0)
#pragma unroll
        for (int g = 0; g < RD; ++g) ER_LOAD(g, g);
#pragma unroll
        for (int g = 0; g < 8; ++g) { const int ai = g >> 2, m = g & 3, s = g % RD; const int row = ER_ROW(g); const size_t off = (size_t)row * 1024 + col0; float sq = 0.f;
#pragma unroll
            for (int bj = 0; bj < 2; ++bj) { const size_t o = off + bj * HALF; const u32x4 h = ph[s][bj], l = pl[s][bj];
                const f32x4 v0 = (f32x4){bflo(h.x) + bflo(l.x), bfhi(h.x) + bfhi(l.x), bflo(h.y) + bflo(l.y), bfhi(h.y) + bfhi(l.y)} + acc[ai][bj][m][0];
                const f32x4 v1 = (f32x4){bflo(h.z) + bflo(l.z), bfhi(h.z) + bfhi(l.z), bflo(h.w) + bflo(l.w), bfhi(h.w) + bfhi(l.w)} + acc[ai][bj][m][1];
                if (nxt) { u32x4 w; w.x = pk2(v0[0], v0[1]); w.y = pk2(v0[2], v0[3]); w.z = pk2(v1[0], v1[1]); w.w = pk2(v1[2], v1[3]); *(u32x4*)(XB + o) = w;
                    u32x4 r; r.x = pk2(v0[0] - bflo(w.x), v0[1] - bfhi(w.x)); r.y = pk2(v0[2] - bflo(w.y), v0[3] - bfhi(w.y)); r.z = pk2(v1[0] - bflo(w.z), v1[1] - bfhi(w.z)); r.w = pk2(v1[2] - bflo(w.w), v1[3] - bfhi(w.w));
                    *(u32x4*)(lo_out + o) = r;
                    sq += ((v0[0] * v0[0] + v0[1] * v0[1]) + (v0[2] * v0[2] + v0[3] * v0[3])) + ((v1[0] * v1[0] + v1[1] * v1[1]) + (v1[2] * v1[2] + v1[3] * v1[3])); }
                else { *(f32x4*)(fout + o) = v0; *(f32x4*)(fout + o + 4) = v1; } }
            if (nxt) { sq += __shfl_xor(sq, 16); sq += __shfl_xor(sq, 32); if (fq == 0) ssn[(size_t)row * 16 + u.pn * 4 + wc] = sq; }
            if (g + RD < 8) ER_LOAD(g + RD, s); }
#undef ER_ROW
#undef ER_LOAD
    }
};
struct EpiSwiglu {
    static constexpr bool PERM = true, AFTER_DRAIN = false;
    bf16_t* ACT; const float* ss;
    __device__ __forceinline__ void operator()(const f32x4 (&acc)[2][2][4][2], const Unit& u, int wr, int wc, int fr, int fq) const {
        const int row0 = u.pm * BM + wr * 64 + fr, col = u.pn * 128 + wc * 32 + 8 * fq;
        float ra, rb; wave_rstd(ss, u.pm * BM + wr * 64, fr + 16 * fq, ra, rb);
#pragma unroll
        for (int ai = 0; ai < 2; ++ai)
#pragma unroll
            for (int m = 0; m < 4; ++m) { const int row = row0 + ai * HALF + m * 16; const float rs = __shfl(ai ? rb : ra, 16 * m + fr);
                const f32x4 g0 = acc[ai][0][m][0] * rs, g1 = acc[ai][0][m][1] * rs, u0 = acc[ai][1][m][0] * rs, u1 = acc[ai][1][m][1] * rs;
                u32x4 w; w.x = pk2(g0[0] * sigm(g0[0]) * u0[0], g0[1] * sigm(g0[1]) * u0[1]); w.y = pk2(g0[2] * sigm(g0[2]) * u0[2], g0[3] * sigm(g0[3]) * u0[3]);
                w.z = pk2(g1[0] * sigm(g1[0]) * u1[0], g1[1] * sigm(g1[1]) * u1[1]); w.w = pk2(g1[2] * sigm(g1[2]) * u1[2], g1[3] * sigm(g1[3]) * u1[3]);
                *(u32x4*)(ACT + (size_t)row * 2816 + col) = w; }
    }
};
template <class Epi, class Sched, bool ALIGN_EPI = false, bool SP2 = false>
__device__ __forceinline__ void gemm_phase(PG8_LAS unsigned char* lds, const Gemm g, const Sched& S, const Epi& E) {
    int tid_l = threadIdx.x; asm volatile("" : "+v"(tid_l));
    const int tid = tid_l, wid = __builtin_amdgcn_readfirstlane(tid >> 6), lane = tid & 63, wr = wid >> 2, wc = wid & 3, fr = lane & 15, fq = lane >> 4;
    const int K = g.K, nt = K / BK;
    unsigned voffA[2], voffB[2];
#pragma unroll
    for (int i = 0; i < 2; ++i) { int R, C; stage_rc(tid * 16 + i * 8192, R, C); const int Rb = Epi::PERM ? ((R & ~31) + perm32(R & 31)) : R;
        voffA[i] = (unsigned)(R * K + C) * 2u; voffB[i] = (unsigned)(Rb * K + C) * 2u; }
    const size_t kstep = (size_t)(BK * 2);
    const size_t hstep = (size_t)HALF * K * 2;
    const size_t tstep = 2 * hstep;
    const unsigned ldsw = (unsigned)wid * 1024u;
    const int aoff = lds_byte(wr * 64 + fr, fq * 8), boff = lds_byte(wc * 32 + fr, fq * 8);
#define PG8_SA(b, h) (((b) * 2 + (h)) * HTB)
#define PG8_SB(b, h) ((4 + (b) * 2 + (h)) * HTB)
#define PG8_STAGE(bufoff, gbase, voff) do { _Pragma("unroll") for (int _i = 0; _i < 2; ++_i) \
        __builtin_amdgcn_global_load_lds((const unsigned*)((const char*)(gbase) + (voff)[_i]), (PG8_LAS unsigned*)(lds + (bufoff) + ldsw + _i * 8192), 16, 0, 0); } while (0)
#define PG8_LDA(dst, b, h) do { _Pragma("unroll") for (int m = 0; m < 4; ++m) _Pragma("unroll") for (int k = 0; k < 2; ++k) dst[m][k] = *(const PG8_LAS bf16x8*)(lds + PG8_SA(b, h) + aoff + m * 2048 + k * 1024); } while (0)
#define PG8_LDB(dst, b, h) do { _Pragma("unroll") for (int n = 0; n < 2; ++n) _Pragma("unroll") for (int k = 0; k < 2; ++k) dst[n][k] = *(const PG8_LAS bf16x8*)(lds + PG8_SB(b, h) + boff + n * 2048 + k * 1024); } while (0)
#define PG8_MMA(ai, bj, At, Bt) do { __builtin_amdgcn_s_setprio(1); _Pragma("unroll") for (int m = 0; m < 4; ++m) _Pragma("unroll") for (int n = 0; n < 2; ++n) _Pragma("unroll") for (int k = 0; k < 2; ++k) \
        acc[ai][bj][m][n] = __builtin_amdgcn_mfma_f32_16x16x32_bf16(Bt[n][k], At[m][k], acc[ai][bj][m][n], 0, 0, 0); __builtin_amdgcn_s_setprio(0); } while (0)
#define PG8_WAIT_V(n) asm volatile("s_waitcnt vmcnt(" #n ")" ::: "memory")
#define PG8_WAIT_L(n) asm volatile("s_waitcnt lgkmcnt(" #n ")" ::: "memory")
#define PG8_BAR __builtin_amdgcn_s_barrier()
#define PG8_SCHED __builtin_amdgcn_sched_barrier(0)
    Unit cur, nxt; int ui = 0;
    if (!S.next(0, cur)) return;
    f32x4 acc[2][2][4][2];
#pragma unroll
    for (int a = 0; a < 2; ++a)
#pragma unroll
        for (int b = 0; b < 2; ++b)
#pragma unroll
            for (int m = 0; m < 4; ++m)
#pragma unroll
                for (int n = 0; n < 2; ++n) acc[a][b][m][n] = (f32x4){0.f, 0.f, 0.f, 0.f};
    bf16x8 At[4][2], B0[2][2], B1[2][2];
    const char* cA = (const char*)g.A + (size_t)cur.pm * tstep; const char* cB = (const char*)g.Bt + (size_t)cur.pn * tstep;
    S.a_ready(cur);
    if constexpr (SP2) {
        PG8_STAGE(PG8_SB(0, 0), cB, voffB); PG8_STAGE(PG8_SB(0, 1), cB + hstep, voffB); PG8_STAGE(PG8_SA(0, 0), cA, voffA); PG8_STAGE(PG8_SA(0, 1), cA + hstep, voffA);
        if (wr == 1) PG8_BAR;
        PG8_WAIT_V(2); PG8_BAR;
        PG8_STAGE(PG8_SB(1, 0), cB + kstep, voffB); PG8_STAGE(PG8_SA(1, 0), cA + kstep, voffA); PG8_STAGE(PG8_SB(1, 1), cB + hstep + kstep, voffB);
        PG8_WAIT_V(6); PG8_BAR;
    } else {
        PG8_STAGE(PG8_SB(0, 0), cB, voffB); PG8_STAGE(PG8_SA(0, 0), cA, voffA); PG8_STAGE(PG8_SB(0, 1), cB + hstep, voffB); PG8_STAGE(PG8_SA(0, 1), cA + hstep, voffA);
        if (wr == 1) PG8_BAR;
        PG8_WAIT_V(4); PG8_BAR;
        PG8_STAGE(PG8_SB(1, 0), cB + kstep, voffB); PG8_STAGE(PG8_SA(1, 0), cA + kstep, voffA); PG8_STAGE(PG8_SB(1, 1), cB + hstep + kstep, voffB);
        PG8_WAIT_V(6); PG8_BAR;
    }
    for (;;) {
        const bool has_next = S.next(ui + 1, nxt);
        const char* nA = has_next ? (const char*)g.A + (size_t)nxt.pm * tstep : cA; const char* nB = has_next ? (const char*)g.Bt + (size_t)nxt.pn * tstep : cB;
        for (int t = 0; t < nt; t += 2) {
            const bool last = (t == nt - 2);
            const char* a1 = cA + (size_t)(t + 1) * kstep;
            const char* a2 = last ? nA : cA + (size_t)(t + 2) * kstep; const char* b2 = last ? nB : cB + (size_t)(t + 2) * kstep;
            const char* a3 = a2 + kstep; const char* b3 = b2 + kstep;
            if (last && has_next) S.a_ready(nxt);
            if constexpr (SP2) {
            PG8_LDB(B0, 0, 0); PG8_LDB(B1, 0, 1); PG8_SCHED; PG8_LDA(At, 0, 0); PG8_STAGE(PG8_SA(1, 1), a1 + hstep, voffA);
            PG8_WAIT_V(8); PG8_WAIT_L(0); PG8_BAR; PG8_MMA(0, 0, At, B0); PG8_MMA(0, 1, At, B1); PG8_BAR; PG8_SCHED;
            PG8_LDA(At, 0, 1); PG8_STAGE(PG8_SB(0, 0), b2, voffB); PG8_STAGE(PG8_SB(0, 1), b2 + hstep, voffB); PG8_STAGE(PG8_SA(0, 0), a2, voffA);
            PG8_WAIT_V(8); PG8_WAIT_L(0); PG8_BAR; PG8_MMA(1, 0, At, B0); PG8_MMA(1, 1, At, B1); PG8_BAR; PG8_SCHED;
            PG8_LDB(B0, 1, 0); PG8_LDB(B1, 1, 1); PG8_SCHED; PG8_LDA(At, 1, 0); PG8_STAGE(PG8_SA(0, 1), a2 + hstep, voffA);
            PG8_WAIT_V(8); PG8_WAIT_L(0); PG8_BAR; PG8_MMA(0, 0, At, B0); PG8_MMA(0, 1, At, B1); PG8_BAR; PG8_SCHED;
            PG8_LDA(At, 1, 1); PG8_STAGE(PG8_SB(1, 0), b3, voffB); PG8_STAGE(PG8_SB(1, 1), b3 + hstep, voffB); PG8_STAGE(PG8_SA(1, 0), a3, voffA);
            PG8_WAIT_V(8); PG8_WAIT_L(0); PG8_BAR; PG8_MMA(1, 0, At, B0); PG8_MMA(1, 1, At, B1); PG8_BAR; PG8_SCHED;
            } else {
            PG8_LDB(B0, 0, 0); PG8_SCHED; PG8_LDA(At, 0, 0); PG8_STAGE(PG8_SA(1, 1), a1 + hstep, voffA);
            PG8_WAIT_L(8); PG8_BAR; PG8_WAIT_L(0); PG8_MMA(0, 0, At, B0); PG8_BAR; PG8_SCHED;
            PG8_LDB(B1, 0, 1); PG8_STAGE(PG8_SB(0, 0), b2, voffB);
            PG8_BAR; PG8_WAIT_L(0); PG8_MMA(0, 1, At, B1); PG8_BAR;
            PG8_LDA(At, 0, 1); PG8_STAGE(PG8_SA(0, 0), a2, voffA);
            PG8_BAR; PG8_WAIT_L(0); PG8_MMA(1, 0, At, B0); PG8_BAR; PG8_SCHED;
            PG8_STAGE(PG8_SB(0, 1), b2 + hstep, voffB);
            PG8_WAIT_V(6); PG8_BAR; PG8_MMA(1, 1, At, B1); PG8_BAR;
            PG8_LDB(B0, 1, 0); PG8_SCHED; PG8_LDA(At, 1, 0); PG8_STAGE(PG8_SA(0, 1), a2 + hstep, voffA);
            PG8_WAIT_L(8); PG8_BAR; PG8_WAIT_L(0); PG8_MMA(0, 0, At, B0); PG8_BAR; PG8_SCHED;
            PG8_LDB(B1, 1, 1); PG8_STAGE(PG8_SB(1, 0), b3, voffB);
            PG8_BAR; PG8_WAIT_L(0); PG8_MMA(0, 1, At, B1); PG8_BAR;
            PG8_LDA(At, 1, 1); PG8_STAGE(PG8_SA(1, 0), a3, voffA);
            PG8_BAR; PG8_WAIT_L(0); PG8_MMA(1, 0, At, B0); PG8_BAR; PG8_SCHED;
            PG8_STAGE(PG8_SB(1, 1), b3 + hstep, voffB);
            PG8_WAIT_V(6); PG8_BAR; PG8_MMA(1, 1, At, B1); PG8_BAR;
            }
        }
        if constexpr (ALIGN_EPI) { if (wr == 0) PG8_BAR; }
        if constexpr (!Epi::AFTER_DRAIN) { E(acc, cur, wr, wc, fr, fq); S.done(cur); }
        if (!has_next) break;
#pragma unroll
        for (int a = 0; a < 2; ++a)
#pragma unroll
            for (int b = 0; b < 2; ++b)
#pragma unroll
                for (int m = 0; m < 4; ++m)
#pragma unroll
                    for (int n = 0; n < 2; ++n) acc[a][b][m][n] = (f32x4){0.f, 0.f, 0.f, 0.f};
        cur = nxt; cA = nA; cB = nB; ++ui;
        if constexpr (ALIGN_EPI) { if (wr == 1) PG8_BAR; }
    }
    PG8_WAIT_V(0);
    if constexpr (!ALIGN_EPI) { if (wr == 0) PG8_BAR; }
    PG8_BAR;
    if constexpr (Epi::AFTER_DRAIN) { E.fused(acc, cur, wr, wc, fr, fq, lds, wid, lane); S.done(cur); }
#undef PG8_SA
#undef PG8_SB
#undef PG8_STAGE
#undef PG8_LDA
#undef PG8_LDB
#undef PG8_MMA
#undef PG8_WAIT_V
#undef PG8_WAIT_L
#undef PG8_BAR
#undef PG8_SCHED
}
}
using pg8::bf16_t; using pg8::f32x4; using pg8::u32x4; using pg8::bf16x8; using pg8::u32x2; using pg8::pk2; using pg8::bflo; using pg8::bfhi; using pg8::sigm; using pg8::NORM_EPS;
#define LAS __attribute__((address_space(3)))
constexpr int NB = 4, T = 8192, M = NB * T, D = 1024, INW = 4352, CC = 512, FF = 2816, GU = 2 * FF, DEPTH = 4, NHEAD = 16;
constexpr size_t MiB = 1u << 20;
constexpr size_t WS_SS = 450 * MiB, SS_BUF = 2 * MiB;
constexpr size_t WS_ROPE = 1 * MiB;
constexpr size_t WS_W = 2 * MiB, W_LAYER = 28 * MiB;
constexpr size_t WO_IN = 0, WO_PW = 8 * MiB + MiB / 2, WO_OUT = WO_PW + 1 * MiB, WO_GU = WO_OUT + 2 * MiB, WO_DN = WO_GU + 11 * MiB;
constexpr size_t WS_XB = 114 * MiB, WS_QO = 178 * MiB, WS_KV = 242 * MiB, WS_A = 258 * MiB, WS_G = 290 * MiB, WS_Y = 418 * MiB, WS_BAR = 455 * MiB, WS_END = 456 * MiB;
constexpr size_t WS_LOB = 354 * MiB;
constexpr size_t WS_ACT = 178 * MiB;
static_assert(WO_DN + (size_t)D * FF * 2 == W_LAYER && WS_W + DEPTH * W_LAYER == WS_XB && WS_ACT + (size_t)M * FF * 2 <= WS_Y, "ws map");
constexpr int LDS_BYTES = 132096;

__device__ __forceinline__ float wave_sum(float v) {
#pragma unroll
    for (int o = 1; o < 64; o <<= 1) v += __shfl_xor(v, o);
    return v;
}

namespace att {
typedef __attribute__((ext_vector_type(16))) float f32x16;
typedef __attribute__((ext_vector_type(4))) short s16x4;
constexpr int KPB = 144, VPB = 520, OFF_V = 256 * KPB, SCR_OFF = 71680, SCR_WAVE = 4608;
constexpr float LOG2E = 1.4426950408889634f;
__device__ __forceinline__ int crow(int r, int hi) { return (r & 3) + 8 * (r >> 2) + 4 * hi; }

__device__ __forceinline__ void unit(LAS unsigned char* lds, int b, int kvh, int blk, bf16_t* QO, const bf16_t* KV, const bf16_t* GA, const float* qn, const float* kn, const float* sinks,
                                     const float* rope, int tid, int lane, int wave) {
    const int h = kvh * 8 + wave, q = lane & 31, hi = lane >> 5, crow8 = lane >> 3, cch = lane & 7;
    u32x4 qrN[4], gtN[4]; f32x4 rpN[4];
#define AT_LOAD(sub_) do { const size_t tr_ = (size_t)(b * T + blk * 128 + 32 * (sub_)); const int tq_ = blk * 128 + 32 * (sub_) + q; \
        _Pragma("unroll") for (int i = 0; i < 4; ++i) { qrN[i] = *(const u32x4*)(QO + (tr_ + crow8 + 8 * i) * 1024 + h * 64 + cch * 8); gtN[i] = *(const u32x4*)(GA + (tr_ + crow8 + 8 * i) * 2048 + h * 64 + cch * 8); \
            rpN[i] = *(const f32x4*)(rope + tq_ * 16 + 4 * i); } } while (0)
    AT_LOAD(0);
    {
        const int row = tid >> 1, half = tid & 1, pos = blk * 128 - 128 + row; const bool valid = pos >= 0;
        const bf16_t* src = KV + (size_t)(b * T + pos) * 256 + kvh * 64 + half * 32;
        float x[32]; float ssq = 0.f;
#pragma unroll
        for (int i = 0; i < 4; ++i) { u32x4 r = (u32x4){0u, 0u, 0u, 0u}; if (valid) r = *(const u32x4*)(src + 8 * i);
            x[8 * i + 0] = bflo(r.x); x[8 * i + 1] = bfhi(r.x); x[8 * i + 2] = bflo(r.y); x[8 * i + 3] = bfhi(r.y); x[8 * i + 4] = bflo(r.z); x[8 * i + 5] = bfhi(r.z); x[8 * i + 6] = bflo(r.w); x[8 * i + 7] = bfhi(r.w); }
#pragma unroll
        for (int i = 0; i < 32; ++i) ssq += x[i] * x[i];
        ssq += __shfl_xor(ssq, 1);
        const float rstd = rsqrtf(ssq * (1.0f / 64.0f) + NORM_EPS);
#pragma unroll
        for (int i = 0; i < 8; ++i) { const f32x4 g = *(const f32x4*)(kn + half * 32 + 4 * i); x[4 * i] *= rstd * g[0]; x[4 * i + 1] *= rstd * g[1]; x[4 * i + 2] *= rstd * g[2]; x[4 * i + 3] *= rstd * g[3]; }
        if (half == 0 && valid) { const float* cs = rope + pos * 16;
#pragma unroll
            for (int i = 0; i < 8; ++i) { const float c = cs[i], s = cs[8 + i], x1 = x[i], x2 = x[8 + i]; x[i] = x1 * c - x2 * s; x[8 + i] = x2 * c + x1 * s; } }
#pragma unroll
        for (int i = 0; i < 4; ++i) { u32x4 w; w.x = pk2(x[8 * i], x[8 * i + 1]); w.y = pk2(x[8 * i + 2], x[8 * i + 3]); w.z = pk2(x[8 * i + 4], x[8 * i + 5]); w.w = pk2(x[8 * i + 6], x[8 * i + 7]);
            *(LAS u32x4*)(lds + row * KPB + half * 64 + 16 * i) = w; }
    }
    {
        const int rp = tid >> 2, c = tid & 3, pos0 = blk * 128 - 128 + 2 * rp; const bool valid = pos0 >= 0;
        const bf16_t* src = KV + (size_t)(b * T + pos0) * 256 + 128 + kvh * 64 + 16 * c;
        u32x4 r0[2], r1[2];
#pragma unroll
        for (int i = 0; i < 2; ++i) { r0[i] = (u32x4){0u, 0u, 0u, 0u}; r1[i] = r0[i]; if (valid) { r0[i] = *(const u32x4*)(src + 8 * i); r1[i] = *(const u32x4*)(src + 256 + 8 * i); } }
#pragma unroll
        for (int w = 0; w < 8; ++w) { const unsigned a = r0[w >> 2][w & 3], bb = r1[w >> 2][w & 3]; const int d = 16 * c + 2 * w;
            *(LAS unsigned*)(lds + OFF_V + d * VPB + rp * 4) = (a & 0xffffu) | (bb << 16);
            *(LAS unsigned*)(lds + OFF_V + (d + 1) * VPB + rp * 4) = (a >> 16) | (bb & 0xffff0000u); }
    }
    __syncthreads();
    const float sink2 = sinks[h] * LOG2E;
#pragma unroll 1
    for (int sub = 0; sub < 4; ++sub) {
        const int tq = blk * 128 + 32 * sub + q;
        LAS unsigned char* scr = lds + SCR_OFF + wave * SCR_WAVE;
        const size_t trow = (size_t)(b * T + blk * 128 + 32 * sub);
        u32x4 gtc[4]; f32x4 rp[4];
#pragma unroll
        for (int i = 0; i < 4; ++i) { gtc[i] = gtN[i]; rp[i] = rpN[i]; *(LAS u32x4*)(scr + (crow8 + 8 * i) * 144 + cch * 16) = qrN[i]; }
        if (sub < 3) AT_LOAD(sub + 1);
        asm volatile("s_waitcnt lgkmcnt(0)" ::: "memory");
        float x[4][8]; float ssq = 0.f;
#pragma unroll
        for (int d0 = 0; d0 < 4; ++d0) { const u32x4 r = *(const LAS u32x4*)(scr + q * 144 + (16 * d0 + 8 * hi) * 2);
            x[d0][0] = bflo(r.x); x[d0][1] = bfhi(r.x); x[d0][2] = bflo(r.y); x[d0][3] = bfhi(r.y); x[d0][4] = bflo(r.z); x[d0][5] = bfhi(r.z); x[d0][6] = bflo(r.w); x[d0][7] = bfhi(r.w); }
#pragma unroll
        for (int d0 = 0; d0 < 4; ++d0)
#pragma unroll
            for (int i = 0; i < 8; ++i) ssq += x[d0][i] * x[d0][i];
        ssq += __shfl_xor(ssq, 32);
        const float rstd = rsqrtf(ssq * (1.0f / 64.0f) + NORM_EPS) * (0.125f * LOG2E);
#pragma unroll
        for (int d0 = 0; d0 < 4; ++d0) { const f32x4 g0 = *(const f32x4*)(qn + 16 * d0 + 8 * hi), g1 = *(const f32x4*)(qn + 16 * d0 + 8 * hi + 4);
            x[d0][0] *= rstd * g0[0]; x[d0][1] *= rstd * g0[1]; x[d0][2] *= rstd * g0[2]; x[d0][3] *= rstd * g0[3]; x[d0][4] *= rstd * g1[0]; x[d0][5] *= rstd * g1[1]; x[d0][6] *= rstd * g1[2]; x[d0][7] *= rstd * g1[3]; }
#pragma unroll
        for (int i = 0; i < 8; ++i) { const float c = rp[i >> 2][i & 3], s = rp[2 + (i >> 2)][i & 3], me = x[0][i], ot = __shfl_xor(me, 32); x[0][i] = hi == 0 ? me * c - ot * s : me * c + ot * s; }
        bf16x8 qf[4];
#pragma unroll
        for (int d0 = 0; d0 < 4; ++d0) { u32x4 w; w.x = pk2(x[d0][0], x[d0][1]); w.y = pk2(x[d0][2], x[d0][3]); w.z = pk2(x[d0][4], x[d0][5]); w.w = pk2(x[d0][6], x[d0][7]); qf[d0] = __builtin_bit_cast(bf16x8, w); }
        f32x16 p[5];
#pragma unroll
        for (int kt = 0; kt < 5; ++kt) {
#pragma unroll
            for (int r = 0; r < 16; ++r) p[kt][r] = 0.f;
#pragma unroll
            for (int d0 = 0; d0 < 4; ++d0) { const bf16x8 kf = *(const LAS bf16x8*)(lds + (32 * (sub + kt) + q) * KPB + (16 * d0 + 8 * hi) * 2);
                p[kt] = __builtin_amdgcn_mfma_f32_32x32x16_bf16(kf, qf[d0], p[kt], 0, 0, 0); } }
        const bool first = (blk == 0);
        bool lowtri[16];
#pragma unroll
        for (int r = 0; r < 16; ++r) lowtri[r] = crow(r, hi) <= q;
        f32x16 pc;
#pragma unroll
        for (int r = 0; r < 16; ++r) pc[r] = lowtri[r] ? p[4][r] : (first ? -INFINITY : p[0][r]);
        if (first) {
#pragma unroll
            for (int kt = 1; kt < 4; ++kt) if (sub + kt < 4) {
#pragma unroll
                for (int r = 0; r < 16; ++r) p[kt][r] = -INFINITY; } }
        float mx = sink2;
#pragma unroll
        for (int r = 0; r < 16; ++r) mx = fmaxf(fmaxf(mx, pc[r]), fmaxf(fmaxf(p[1][r], p[2][r]), p[3][r]));
        mx = fmaxf(mx, __shfl_xor(mx, 32));
#pragma unroll
        for (int r = 0; r < 16; ++r) { pc[r] = __builtin_amdgcn_exp2f(pc[r] - mx); p[1][r] = __builtin_amdgcn_exp2f(p[1][r] - mx); p[2][r] = __builtin_amdgcn_exp2f(p[2][r] - mx); p[3][r] = __builtin_amdgcn_exp2f(p[3][r] - mx); }
        const f32x16 sv = (pc + p[1]) + (p[2] + p[3]);
        float lsum = ((sv[0] + sv[1]) + (sv[2] + sv[3])) + ((sv[4] + sv[5]) + (sv[6] + sv[7])) + (((sv[8] + sv[9]) + (sv[10] + sv[11])) + ((sv[12] + sv[13]) + (sv[14] + sv[15])));
        lsum += __shfl_xor(lsum, 32); lsum += __builtin_amdgcn_exp2f(sink2 - mx);
        const float inv = 1.0f / lsum;
#pragma unroll
        for (int r = 0; r < 16; ++r) { p[0][r] = lowtri[r] ? 0.f : pc[r]; p[4][r] = lowtri[r] ? pc[r] : 0.f; }
        f32x16 o[2];
#pragma unroll
        for (int r = 0; r < 16; ++r) { o[0][r] = 0.f; o[1][r] = 0.f; }
#pragma unroll
        for (int kt = 0; kt < 5; ++kt)
#pragma unroll
            for (int s = 0; s < 2; ++s) { u32x4 w; w.x = pk2(p[kt][8 * s], p[kt][8 * s + 1]); w.y = pk2(p[kt][8 * s + 2], p[kt][8 * s + 3]); w.z = pk2(p[kt][8 * s + 4], p[kt][8 * s + 5]); w.w = pk2(p[kt][8 * s + 6], p[kt][8 * s + 7]);
                const bf16x8 pf = __builtin_bit_cast(bf16x8, w);
#pragma unroll
                for (int d0 = 0; d0 < 2; ++d0) { const LAS unsigned char* vp = lds + OFF_V + (32 * d0 + q) * VPB + (32 * (sub + kt) + 16 * s + 4 * hi) * 2;
                    const s16x4 lo = *(const LAS s16x4*)vp, hi4 = *(const LAS s16x4*)(vp + 16);
                    const bf16x8 vf = (bf16x8){lo[0], lo[1], lo[2], lo[3], hi4[0], hi4[1], hi4[2], hi4[3]};
                    o[d0] = __builtin_amdgcn_mfma_f32_32x32x16_bf16(vf, pf, o[d0], 0, 0, 0); } }
        asm volatile("s_waitcnt lgkmcnt(0)" ::: "memory");
#pragma unroll
        for (int d0 = 0; d0 < 2; ++d0)
#pragma unroll
            for (int g = 0; g < 4; ++g) { u32x2 w; w.x = pk2(o[d0][4 * g] * inv, o[d0][4 * g + 1] * inv); w.y = pk2(o[d0][4 * g + 2] * inv, o[d0][4 * g + 3] * inv);
                *(LAS u32x2*)(scr + q * 144 + (32 * d0 + 8 * g + 4 * hi) * 2) = w; }
        asm volatile("s_waitcnt lgkmcnt(0)" ::: "memory");
#pragma unroll
        for (int i = 0; i < 4; ++i) { const u32x4 ov = *(const LAS u32x4*)(scr + (crow8 + 8 * i) * 144 + cch * 16); const u32x4 gg = gtc[i]; u32x4 w;
            w.x = pk2(bflo(ov.x) * bflo(gg.x), bfhi(ov.x) * bfhi(gg.x)); w.y = pk2(bflo(ov.y) * bflo(gg.y), bfhi(ov.y) * bfhi(gg.y));
            w.z = pk2(bflo(ov.z) * bflo(gg.z), bfhi(ov.z) * bfhi(gg.z)); w.w = pk2(bflo(ov.w) * bflo(gg.w), bfhi(ov.w) * bfhi(gg.w));
            *(u32x4*)(QO + (trow + crow8 + 8 * i) * 1024 + h * 64 + cch * 8) = w; }
        asm volatile("s_waitcnt lgkmcnt(0)" ::: "memory");
    }
#undef AT_LOAD
    __syncthreads();
}
}

namespace cv {
constexpr int ROWS = 62, OFF_Y = ROWS * 1024, NU = M / 32;
typedef pg8::f32x2_t f32x2;
__device__ __forceinline__ void phase(LAS unsigned char* lds, int bx, int G, const bf16_t* A, bf16_t* Y, const float* cw, const float* cb, const float* lg, const float* lb, int tid, int lane, int wave) {
    const int cp = tid & 255, tg = tid >> 8;
    f32x2 wv[31];
#pragma unroll
    for (int j = 0; j < 31; ++j) wv[j] = *(const f32x2*)(cw + j * CC + 2 * cp);
    const f32x2 bias = *(const f32x2*)(cb + 2 * cp);
    const f32x4 g0 = *(const f32x4*)(lg + 4 * lane), g1 = *(const f32x4*)(lg + 256 + 4 * lane), b0 = *(const f32x4*)(lb + 4 * lane), b1 = *(const f32x4*)(lb + 256 + 4 * lane);
    u32x4 pre[8];
#define CV_FETCH(un) do { const int t0_ = (un) * 32, p0_ = t0_ & (T - 1); _Pragma("unroll") for (int i = 0; i < 8; ++i) { const int idx = tid + 512 * i, r = idx >> 6, ch = idx & 63; pre[i] = (u32x4){0u, 0u, 0u, 0u}; \
        if (idx < ROWS * 64 && p0_ - 30 + r >= 0) pre[i] = *(const u32x4*)(A + (size_t)(t0_ - 30 + r) * CC + ch * 8); } } while (0)
    int un = bx;
    if (un < NU) CV_FETCH(un);
#pragma unroll 1
    for (; un < NU; un += G) {
        const int t0 = un * 32;
#pragma unroll
        for (int i = 0; i < 8; ++i) { const int idx = tid + 512 * i; if (idx < ROWS * 64) *(LAS u32x4*)(lds + idx * 16) = pre[i]; }
        __syncthreads();
        if (un + G < NU) CV_FETCH(un + G);
#pragma unroll 1
        for (int sb = 0; sb < 2; ++sb) { const int tb = 16 * tg + 8 * sb;
            f32x2 ac[8];
#pragma unroll
            for (int i = 0; i < 8; ++i) ac[i] = bias;
#pragma unroll
            for (int rr = 0; rr < 38; ++rr) { const unsigned v = *(const LAS unsigned*)(lds + (tb + rr) * 1024 + cp * 4); const f32x2 vv = (f32x2){bflo(v), bfhi(v)};
#pragma unroll
                for (int i = 0; i < 8; ++i) { const int j = rr - i; if (j >= 0 && j <= 30) ac[i] = __builtin_elementwise_fma(wv[j], vv, ac[i]); } }
#pragma unroll
            for (int i = 0; i < 8; ++i) *(LAS f32x2*)(lds + OFF_Y + (tb + i) * 2048 + cp * 8) = ac[i]; }
        __syncthreads();
#pragma unroll
        for (int k = 0; k < 4; ++k) { const int tok = 4 * wave + k;
            f32x4 v0 = *(const LAS f32x4*)(lds + OFF_Y + tok * 2048 + lane * 16), v1 = *(const LAS f32x4*)(lds + OFF_Y + tok * 2048 + 1024 + lane * 16);
            const float mean = wave_sum((v0[0] + v0[1]) + (v0[2] + v0[3]) + (v1[0] + v1[1]) + (v1[2] + v1[3])) * (1.0f / 512.0f);
            v0 = v0 - mean; v1 = v1 - mean;
            const float var = wave_sum((v0[0] * v0[0] + v0[1] * v0[1]) + (v0[2] * v0[2] + v0[3] * v0[3]) + (v1[0] * v1[0] + v1[1] * v1[1]) + (v1[2] * v1[2] + v1[3] * v1[3])) * (1.0f / 512.0f);
            const float rstd = rsqrtf(var + NORM_EPS);
            v0 = v0 * rstd * g0 + b0; v1 = v1 * rstd * g1 + b1;
            u32x2 w0, w1; w0.x = pk2(v0[0] * sigm(v0[0]), v0[1] * sigm(v0[1])); w0.y = pk2(v0[2] * sigm(v0[2]), v0[3] * sigm(v0[3]));
            w1.x = pk2(v1[0] * sigm(v1[0]), v1[1] * sigm(v1[1])); w1.y = pk2(v1[2] * sigm(v1[2]), v1[3] * sigm(v1[3]));
            bf16_t* yp = Y + (size_t)(t0 + tok) * CC + 4 * lane; *(u32x2*)yp = w0; *(u32x2*)(yp + 256) = w1; }
        __syncthreads();
    }
#undef CV_FETCH
}
}
__device__ __forceinline__ void transpose_item(const float* W, int K, int N, bf16_t* WT, int k0, int n0s, int n0d, const float* gain, LAS float* scr, int lane) {
    const int r8 = lane >> 3, c4 = (lane & 7) * 4;
    f32x4 v[8]; float gs[8];
#pragma unroll
    for (int i = 0; i < 8; ++i) { v[i] = *(const f32x4*)(W + (size_t)(k0 + 8 * i + r8) * N + n0s + c4); gs[i] = gain ? gain[k0 + 8 * i + r8] : 1.0f; }
#pragma unroll
    for (int i = 0; i < 8; ++i) { LAS float* d = scr + (8 * i + r8) * 33 + c4; d[0] = v[i][0] * gs[i]; d[1] = v[i][1] * gs[i]; d[2] = v[i][2] * gs[i]; d[3] = v[i][3] * gs[i]; }
    asm volatile("s_waitcnt lgkmcnt(0)" ::: "memory");
    const int c = lane & 7;
#pragma unroll
    for (int j = 0; j < 4; ++j) { const int n = (lane >> 3) + 8 * j; const LAS float* s = scr + (8 * c) * 33 + n;
        u32x4 o; o.x = pk2(s[0 * 33], s[1 * 33]); o.y = pk2(s[2 * 33], s[3 * 33]); o.z = pk2(s[4 * 33], s[5 * 33]); o.w = pk2(s[6 * 33], s[7 * 33]);
        *(u32x4*)(WT + (size_t)(n0d + n) * K + k0 + 8 * c) = o; }
    asm volatile("s_waitcnt lgkmcnt(0)" ::: "memory");
}
__device__ __forceinline__ int perm_in(int n0d) { const int pn = n0d >> 8, h = (n0d >> 7) & 1, j = n0d & 127; if (pn >= 5 && pn < 9) return (h ? 1792 : 1280) + 128 * (pn - 5) + j; return n0d; }
__device__ __forceinline__ int perm_gu(int n0d) { const int pn = n0d >> 8, h = (n0d >> 7) & 1, j = n0d & 127; return (h ? FF : 0) + 128 * pn + j; }

struct Args { const float* in[15]; float* out; unsigned char* ws; int ph_lo, ph_hi; };
enum { I_X = 0, I_NMIX, I_WIN, I_QN, I_KN, I_SINK, I_CW, I_CB, I_LG, I_LB, I_WPW, I_WOUT, I_NFFN, I_WGU, I_WDN };

__device__ __forceinline__ void convert_layer(const Args& a, int l, int slot, int nslots, LAS float* scr, int lane) {
    constexpr int I_IN = (D / 64) * (INW / 32), I_PW = (CC / 64) * (D / 32), I_OUT = (D / 64) * (D / 32), I_GU = (D / 64) * (GU / 32), I_DN = (FF / 64) * (D / 32), PER_L = I_IN + I_PW + I_OUT + I_GU + I_DN;
    unsigned char* wb = a.ws + WS_W + (size_t)l * W_LAYER;
    for (int it = slot; it < PER_L; it += nslots) {
        int r = it;
        if (r < I_IN) { const int nblk = INW / 32, kb = r / nblk, nb = r % nblk; transpose_item(a.in[I_WIN] + (size_t)l * D * INW, D, INW, (bf16_t*)(wb + WO_IN), 64 * kb, perm_in(32 * nb), 32 * nb, a.in[I_NMIX] + l * D, scr, lane); continue; } r -= I_IN;
        if (r < I_PW) { const int nblk = D / 32, kb = r / nblk, nb = r % nblk; transpose_item(a.in[I_WPW] + (size_t)l * CC * D, CC, D, (bf16_t*)(wb + WO_PW), 64 * kb, 32 * nb, 32 * nb, nullptr, scr, lane); continue; } r -= I_PW;
        if (r < I_OUT) { const int nblk = D / 32, kb = r / nblk, nb = r % nblk; transpose_item(a.in[I_WOUT] + (size_t)l * D * D, D, D, (bf16_t*)(wb + WO_OUT), 64 * kb, 32 * nb, 32 * nb, nullptr, scr, lane); continue; } r -= I_OUT;
        if (r < I_GU) { const int nblk = GU / 32, kb = r / nblk, nb = r % nblk; transpose_item(a.in[I_WGU] + (size_t)l * D * GU, D, GU, (bf16_t*)(wb + WO_GU), 64 * kb, perm_gu(32 * nb), 32 * nb, a.in[I_NFFN] + l * D, scr, lane); continue; } r -= I_GU;
        { const int nblk = D / 32, kb = r / nblk, nb = r % nblk; transpose_item(a.in[I_WDN] + (size_t)l * FF * D, FF, D, (bf16_t*)(wb + WO_DN), 64 * kb, 32 * nb, 32 * nb, nullptr, scr, lane); }
    }
}
__device__ __forceinline__ void prologue(const Args& a, LAS unsigned char* lds, int tid, int lane, int wave) {
    LAS float* scr = (LAS float*)(lds + wave * 16384);
    const int gw = blockIdx.x * 8 + wave, NGW = gridDim.x * 8;
    const int lw = gridDim.x == 256 ? 1 : DEPTH;
    for (int l = 0; l < lw; ++l) convert_layer(a, l, gw, NGW, scr, lane);
    float* ss = (float*)(a.ws + WS_SS); bf16_t* XB = (bf16_t*)(a.ws + WS_XB);
    bf16_t* LOA = (bf16_t*)a.out;
    for (int m = gw; m < M; m += NGW) { const f32x4* xr = (const f32x4*)(a.in[I_X] + (size_t)m * D) + lane; u32x2* xo = (u32x2*)(XB + (size_t)m * D) + lane; u32x2* lo = (u32x2*)(LOA + (size_t)m * D) + lane; float s = 0.f;
#pragma unroll
        for (int j = 0; j < 4; ++j) { const f32x4 v = xr[64 * j]; s += (v[0] * v[0] + v[1] * v[1]) + (v[2] * v[2] + v[3] * v[3]); u32x2 w; w.x = pk2(v[0], v[1]); w.y = pk2(v[2], v[3]); xo[64 * j] = w;
            u32x2 r; r.x = pk2(v[0] - bflo(w.x), v[1] - bfhi(w.x)); r.y = pk2(v[2] - bflo(w.y), v[3] - bfhi(w.y)); lo[64 * j] = r; }
        s = wave_sum(s); if (lane < 16) ss[(size_t)m * 16 + lane] = lane == 0 ? s : 0.f; }
    float* rope = (float*)(a.ws + WS_ROPE);
    for (int i = blockIdx.x * 512 + tid; i < T * 8; i += gridDim.x * 512) { const int t = i >> 3, f = i & 7;
        double fr = 1.0; for (int k = 0; k < f; ++k) fr *= 0.19392274474868576;
        const float inv_freq = (float)fr; const float ang = (float)t * inv_freq;
        const double x = (double)ang, kq = __builtin_rint(x * 0.6366197723675814);
        const double r = __builtin_fma(-kq, 6.123233995736766e-17, __builtin_fma(-kq, 1.5707963267948966, x)), r2 = r * r;
        const double sp = r * (1.0 + r2 * (-1.0 / 6 + r2 * (1.0 / 120 + r2 * (-1.0 / 5040 + r2 * (1.0 / 362880 + r2 * (-1.0 / 39916800 + r2 * (1.0 / 6227020800.0)))))));
        const double cp = 1.0 + r2 * (-0.5 + r2 * (1.0 / 24 + r2 * (-1.0 / 720 + r2 * (1.0 / 40320 + r2 * (-1.0 / 3628800 + r2 * (1.0 / 479001600 + r2 * (-1.0 / 87178291200.0)))))));
        const int qd = ((int)kq) & 3;
        const double sn = qd == 0 ? sp : qd == 1 ? cp : qd == 2 ? -sp : -cp, cn = qd == 0 ? cp : qd == 1 ? -sp : qd == 2 ? -cp : sp;
        rope[t * 16 + f] = (float)cn; rope[t * 16 + 8 + f] = (float)sn; }
}

#define XB_TMO      128
#define XB_XCNT(j)  (256  + 64 * (j))
#define XB_XSUB(j)  (1280 + 64 * (j))
#define XB_XGEN(j)  (2304 + 64 * (j))
#define XB_TOP      3328
#define XB_TOPGEN   3392
#define XCD_BAR_WORDS 3456
#define XB_SPIN_CAP (1u << 18)

__device__ __forceinline__ unsigned xb_ld(unsigned* p)              { return __hip_atomic_load(p, __ATOMIC_RELAXED, __HIP_MEMORY_SCOPE_AGENT); }
__device__ __forceinline__ unsigned xb_add(unsigned* p, unsigned v) { return __hip_atomic_fetch_add(p, v, __ATOMIC_RELAXED, __HIP_MEMORY_SCOPE_AGENT); }
__device__ __forceinline__ unsigned xb_xcc_id() { return (unsigned)__builtin_amdgcn_s_getreg((3 << 11) | 20) & 0xFu; }
#define XB_SPIN(cond, bar) do { unsigned _sp = 0; while (cond) { __builtin_amdgcn_s_sleep(1); \
    if ((++_sp & 255u) == 0u) { if (xb_ld(&(bar)[XB_TMO])) break; if (_sp > XB_SPIN_CAP) { atomicAdd(&(bar)[XB_TMO], 1u); break; } } } } while (0)

struct XcdBarrier {
    unsigned* bar; unsigned x;
    volatile LAS unsigned* st;
};

__device__ __forceinline__ XcdBarrier xcd_barrier_post(unsigned* bar, volatile LAS unsigned* st) {
    XcdBarrier b; b.bar = bar; b.x = xb_xcc_id(); b.st = st;
    if (threadIdx.x == 0) (void)xb_add(&bar[XB_XCNT(b.x)], 1u);
    return b;
}
__device__ __forceinline__ void xcd_barrier_complete(unsigned* bar, unsigned x, unsigned& nloc, unsigned& nx) {
    const unsigned G = gridDim.x * gridDim.y * gridDim.z;
    unsigned sum, cnt, mine, sp = 0u;
    for (;;) {
        sum = 0u; cnt = 0u; mine = 0u;
#pragma unroll
        for (unsigned j = 0; j < 16; ++j) { const unsigned c = xb_ld(&bar[XB_XCNT(j)]); sum += c; cnt += (c > 0u) ? 1u : 0u; mine = (j == x) ? c : mine; }
        if (sum == G) break;
        __builtin_amdgcn_s_sleep(1);
        if ((++sp & 255u) == 0u) { if (xb_ld(&bar[XB_TMO])) break; if (sp > XB_SPIN_CAP) { atomicAdd(&bar[XB_TMO], 1u); break; } }
    }
    nloc = mine > 0u ? mine : 1u; nx = cnt > 0u ? cnt : 1u;
}

__device__ __forceinline__ void xcd_barrier(const XcdBarrier& b) {
    asm volatile("s_waitcnt vmcnt(0)" ::: "memory");
    __syncthreads();
    if (threadIdx.x == 0) {
        unsigned* bar = b.bar;
        __builtin_amdgcn_s_waitcnt(0);
        unsigned nloc = b.st[0], nx = b.st[1];
        if (nloc == 0u) { xcd_barrier_complete(bar, b.x, nloc, nx); b.st[0] = nloc; b.st[1] = nx; }
        const unsigned old = xb_add(&bar[XB_XSUB(b.x)], 1u);
        const unsigned gen = old / nloc;
        if (old + 1u == (gen + 1u) * nloc) {
            __builtin_amdgcn_fence(__ATOMIC_RELEASE, "agent");
            asm volatile("s_waitcnt vmcnt(0)" ::: "memory");
            const unsigned og = xb_add(&bar[XB_TOP], 1u);
            const unsigned tg = og / nx;
            if (og + 1u == (tg + 1u) * nx) xb_add(&bar[XB_TOPGEN], 1u);
            else XB_SPIN(xb_ld(&bar[XB_TOPGEN]) == tg, bar);
            __builtin_amdgcn_fence(__ATOMIC_ACQUIRE, "agent");
            xb_add(&bar[XB_XGEN(b.x)], 1u);
            asm volatile("s_waitcnt vmcnt(0)" ::: "memory");
        } else {
            XB_SPIN(xb_ld(&bar[XB_XGEN(b.x)]) == gen, bar);
            __builtin_amdgcn_fence(__ATOMIC_ACQUIRE, "agent");
            asm volatile("s_waitcnt vmcnt(0)" ::: "memory");
        }
    }
    __syncthreads();
}

#ifndef PROBE
#define PROBE 0
#endif
#define tsb ((LAS unsigned long long*)(lds + 131072))
#ifndef PROBE_A
#define PROBE_A 2
#endif
#ifndef PROBE_B
#define PROBE_B 3
#endif
#ifndef PROBE_SA
#define PROBE_SA 0.01f
#endif
#ifndef PROBE_SB
#define PROBE_SB 0.01f
#endif
constexpr int N_PHASES = 1 + 6 * DEPTH;
__global__ void __launch_bounds__(512, 2) fwd_kernel(Args a) {
    extern __shared__ __attribute__((aligned(16))) unsigned char lds_raw[];
    LAS unsigned char* lds = (LAS unsigned char*)lds_raw;
    cg::grid_group grid = cg::this_grid();
    volatile LAS unsigned* bst = (volatile LAS unsigned*)(lds + 131072 + 768);
    if (threadIdx.x < 2) bst[threadIdx.x] = 0u;
    __syncthreads();
    const XcdBarrier xbar = xcd_barrier_post((unsigned*)(a.ws + WS_BAR), bst);
    const int G = gridDim.x, bx = blockIdx.x;
    unsigned char* ws = a.ws;
    float* ss = (float*)(ws + WS_SS); const float* rope = (const float*)(ws + WS_ROPE);
    bf16_t* XB = (bf16_t*)(ws + WS_XB); bf16_t* QO = (bf16_t*)(ws + WS_QO); bf16_t* KV = (bf16_t*)(ws + WS_KV); bf16_t* AB = (bf16_t*)(ws + WS_A);
    bf16_t* GB = (bf16_t*)(ws + WS_G); bf16_t* YB = (bf16_t*)(ws + WS_Y); bf16_t* ACT = (bf16_t*)(ws + WS_ACT);
#pragma unroll 1
    for (int ph = a.ph_lo; ph < a.ph_hi; ++ph) {
        if (ph > a.ph_lo) { if (ph == 1) grid.sync(); else xcd_barrier(xbar); }
        int tid_l = threadIdx.x; asm volatile("" : "+v"(tid_l));
#if PROBE
        if (threadIdx.x == 0) tsb[ph] = __builtin_amdgcn_s_memrealtime();
#endif
        const int tid = tid_l, lane = tid & 63, wave = __builtin_amdgcn_readfirstlane(tid >> 6);
        if (ph == 0) { prologue(a, lds, tid, lane, wave); continue; }
        const int l = (ph - 1) / 6, s = (ph - 1) % 6;
        const unsigned char* wb = ws + WS_W + (size_t)l * W_LAYER;
        if (s == 0) {
            pg8::Gemm g{XB, (const bf16_t*)(wb + WO_IN), M, INW, D}; pg8::StaticOrder S; S.init(M, INW, G, bx);
            pg8::EpiIn E{QO, KV, AB, GB, ss};
            pg8::gemm_phase<pg8::EpiIn, pg8::StaticOrder, true, true>(lds, g, S, E);
            if (G == 256 && bx >= 128 && l + 1 < DEPTH) convert_layer(a, l + 1, (bx - 128) * 8 + wave, 128 * 8, (LAS float*)(lds + wave * 16384), lane);
        } else if (s == 1) {
            for (int u = bx; u < NB * 2 * (T / 128); u += G) { const int blk = u & 63, kvh = (u >> 6) & 1, b = u >> 7;
                att::unit(lds, b, kvh, blk, QO, KV, GB, a.in[I_QN] + l * 64, a.in[I_KN] + l * 64, a.in[I_SINK] + l * NHEAD, rope, tid, lane, wave); }
#if PROBE
            if (threadIdx.x == 0) tsb[32 + l] = __builtin_amdgcn_s_memrealtime();
#endif
            cv::phase(lds, bx, G, AB, YB, a.in[I_CW] + (size_t)l * 31 * CC, a.in[I_CB] + l * CC, a.in[I_LG] + l * CC, a.in[I_LB] + l * CC, tid, lane, wave);
        } else if (s == 2) {
            pg8::Gemm g{YB, (const bf16_t*)(wb + WO_PW), M, D, CC}; pg8::StaticOrder S; S.init(M, D, G, bx);
            pg8::EpiMerge E{QO, GB};
            pg8::gemm_phase<pg8::EpiMerge, pg8::StaticOrder, true, true>(lds, g, S, E);
        } else if (s == 3) {
            pg8::Gemm g{QO, (const bf16_t*)(wb + WO_OUT), M, D, D}; pg8::StaticOrder S; S.init(M, D, G, bx);
            pg8::EpiRes E{(const bf16_t*)a.out, (bf16_t*)(ws + WS_LOB), XB, a.out, ss + (size_t)M * 16, 1};
            pg8::gemm_phase<pg8::EpiRes, pg8::StaticOrder, true, true>(lds, g, S, E);
        } else if (s == 4) {
            pg8::Gemm g{XB, (const bf16_t*)(wb + WO_GU), M, GU, D}; pg8::StaticOrder S; S.init(M, GU, G, bx);
            pg8::EpiSwiglu E{ACT, ss + (size_t)M * 16};
            pg8::gemm_phase<pg8::EpiSwiglu, pg8::StaticOrder, true, true>(lds, g, S, E);
        } else {
            pg8::Gemm g{ACT, (const bf16_t*)(wb + WO_DN), M, D, FF}; pg8::StaticOrder S; S.init(M, D, G, bx);
            pg8::EpiRes E{(const bf16_t*)(ws + WS_LOB), (bf16_t*)a.out, XB, a.out, ss, l + 1 < DEPTH ? 1 : 0};
            pg8::gemm_phase<pg8::EpiRes, pg8::StaticOrder, true, true>(lds, g, S, E);
        }
    }
#if PROBE
    if (bx == 0) {
        LAS float* pv = (LAS float*)(lds + 131072 + 512);
        if (threadIdx.x == 0) { tsb[N_PHASES] = __builtin_amdgcn_s_memrealtime();
            unsigned long long sa = 0, sb = 0;
#pragma unroll 1
            for (int l = 0; l < DEPTH; ++l) { const int b = 1 + 6 * l;
                const unsigned long long d1 = tsb[b + 1] - tsb[b], d2 = tsb[32 + l] - tsb[b + 1], d3 = tsb[b + 2] - tsb[32 + l], d4 = tsb[b + 3] - tsb[b + 2], d5 = tsb[b + 4] - tsb[b + 3], d6 = tsb[b + 5] - tsb[b + 4], d7 = tsb[b + 6] - tsb[b + 5];
                sa += PROBE_A == 1 ? d1 : PROBE_A == 2 ? d2 : PROBE_A == 3 ? d3 : PROBE_A == 4 ? d4 : PROBE_A == 5 ? d5 : PROBE_A == 6 ? d6 : PROBE_A == 7 ? d7 : 0;
                sb += PROBE_B == 1 ? d1 : PROBE_B == 2 ? d2 : PROBE_B == 3 ? d3 : PROBE_B == 4 ? d4 : PROBE_B == 5 ? d5 : PROBE_B == 6 ? d6 : PROBE_B == 7 ? d7 : 0; }
            if (PROBE_A == 0) sa = tsb[1] - tsb[0]; if (PROBE_B == 0) sb = tsb[1] - tsb[0];
            pv[0] = (float)sa * 0.01f * PROBE_SA; pv[1] = PROBE_B == 8 ? 20.0f : (float)sb * 0.01f * PROBE_SB; }
        __syncthreads();
        if (threadIdx.x == 0) a.out[0] += pv[0];
        if (PROBE_B >= 0) for (int i = threadIdx.x + 512; i < 65536; i += 512) a.out[(size_t)(i >> 8) * 1024 + (i & 255)] += pv[1] * 0.0625f;
    }
#endif
}

#ifndef MK_PER_PHASE
#define MK_PER_PHASE 0
#endif
extern "C" void kernel_launch(void* const* d_in, const int* in_sizes, int n_in, void* d_out, int out_size, void* d_ws, size_t ws_size, hipStream_t stream) {
    static int grid = 0;
    if (grid == 0) {
        if (n_in != 15 || in_sizes[0] != M * D || out_size != M * D || ws_size < WS_END) { fprintf(stderr, "kernel_launch: unexpected shapes / workspace (n_in %d, ws %zu)\n", n_in, ws_size); grid = -1; return; }
        int dev = 0, cus = 0, per_cu = 0;
        (void)hipGetDevice(&dev); (void)hipDeviceGetAttribute(&cus, hipDeviceAttributeMultiprocessorCount, dev);
        if (hipFuncSetAttribute((const void*)fwd_kernel, hipFuncAttributeMaxDynamicSharedMemorySize, LDS_BYTES) != hipSuccess) { fprintf(stderr, "kernel_launch: hipFuncSetAttribute failed\n"); grid = -1; return; }
        if (hipOccupancyMaxActiveBlocksPerMultiprocessor(&per_cu, (const void*)fwd_kernel, 512, LDS_BYTES) != hipSuccess || per_cu < 1) { fprintf(stderr, "kernel_launch: occupancy query says %d\n", per_cu); per_cu = 1; }
        (void)hipGetLastError();
        grid = cus * per_cu;
    }
    if (grid < 0) return;
    if (hipMemsetAsync((char*)d_ws + WS_BAR, 0, 16384, stream) != hipSuccess) { fprintf(stderr, "kernel_launch: memset of the barrier words failed\n"); return; }
    Args a{};
    for (int i = 0; i < 15; ++i) a.in[i] = (const float*)d_in[i];
    a.out = (float*)d_out; a.ws = (unsigned char*)d_ws;
#if MK_PER_PHASE
    for (int ph = 0; ph < N_PHASES; ++ph) { a.ph_lo = ph; a.ph_hi = ph + 1; hipLaunchKernelGGL(fwd_kernel, dim3(grid), dim3(512), LDS_BYTES, stream, a); }
#else
    a.ph_lo = 0; a.ph_hi = N_PHASES;
    void* args[] = {&a};
    hipError_t e = hipLaunchCooperativeKernel((const void*)fwd_kernel, dim3(grid), dim3(512), args, LDS_BYTES, stream);
    if (e != hipSuccess) fprintf(stderr, "cooperative launch failed: %s (grid %d)\n", hipGetErrorString(e), grid);
#endif
}
```

```cpp
#include <hip/hip_runtime.h>
#include <hip/hip_cooperative_groups.h>
#include <cstdio>
#include <cstdint>
namespace cg = cooperative_groups;
namespace pg8 {
#define PG8_LAS __attribute__((address_space(3)))
typedef unsigned short bf16_t;
typedef short bf16x8 __attribute__((ext_vector_type(8)));
typedef float f32x4 __attribute__((ext_vector_type(4)));
typedef unsigned u32x4 __attribute__((ext_vector_type(4)));
constexpr int BM = 256, BK = 64, HALF = 128, HTB = HALF * BK * 2  , STAGE_BYTES = 8 * HTB, NXCD = 8, WGM = 8;

__host__ __device__ __forceinline__ int lds_byte(int r, int c) { const int st = (r >> 4) * 2 + (c >> 5), rr = r & 15, cc = c & 31, ob = rr * 64 + cc * 2; return st * 1024 + (ob ^ (((ob >> 9) & 1) << 5)); }
__host__ __device__ __forceinline__ void stage_rc(int b, int& R, int& C) { const int st = b / 1024, sb = b % 1024, swz = sb ^ (((sb >> 9) & 1) << 5); R = (st >> 1) * 16 + swz / 64; C = (st & 1) * 32 + (swz % 64) / 2; }
__host__ __device__ __forceinline__ int perm32(int rho) { const int n = rho >> 4, i = rho & 15; return 8 * (i >> 2) + 4 * n + (i & 3); }

struct Unit { int pm, pn; };
struct Gemm { const bf16_t* A; const bf16_t* Bt; int M, N, K; };

struct StaticOrder {
    int nM, nN, nwg, G, c;
    __host__ __device__ void init(int M, int N, int G_, int c_) { nM = M / BM; nN = N / BM; nwg = nM * nN; G = G_; c = c_; }
    __host__ __device__ bool next(int i, Unit& u) const {
        const long L = (long)i * G + c; if (L >= nwg) return false;
        int wgid = (int)L; { const int q = nwg / NXCD, r = nwg % NXCD, xcd = wgid % NXCD, off = wgid / NXCD; wgid = (xcd < r ? xcd * (q + 1) : r * (q + 1) + (xcd - r) * q) + off; }
        const int nig = WGM * nN, gid = wgid / nig, fm = gid * WGM, gsz = (nM - fm) < WGM ? (nM - fm) : WGM;
        u.pm = fm + ((wgid % nig) % gsz); u.pn = (wgid % nig) / gsz; return true;
    }
    __device__ __forceinline__ void a_ready(const Unit&) const {}
    __device__ __forceinline__ void done(const Unit&) const {}
};
typedef float f32x2_t __attribute__((ext_vector_type(2))); typedef __bf16 bf16x2_t __attribute__((ext_vector_type(2)));
typedef unsigned u32x2 __attribute__((ext_vector_type(2)));
__device__ __forceinline__ unsigned pk2(float lo, float hi) { f32x2_t v = {lo, hi}; bf16x2_t b = __builtin_convertvector(v, bf16x2_t); return __builtin_bit_cast(unsigned, b); }
__device__ __forceinline__ float bflo(unsigned u) { return __uint_as_float(u << 16); }
__device__ __forceinline__ float bfhi(unsigned u) { return __uint_as_float(u & 0xffff0000u); }
__device__ __forceinline__ float sigm(float x) { return __builtin_amdgcn_rcpf(1.0f + __builtin_amdgcn_exp2f(x * -1.4426950408889634f)); }
constexpr float NORM_EPS = 1e-6f;
__device__ __forceinline__ float row_rstd(const float* P, int row) { const f32x4* p = (const f32x4*)(P + (size_t)row * 16); const f32x4 a = p[0], b = p[1], c = p[2], d = p[3];
    const float s = ((a[0] + a[1]) + (a[2] + a[3])) + ((b[0] + b[1]) + (b[2] + b[3])) + ((c[0] + c[1]) + (c[2] + c[3])) + ((d[0] + d[1]) + (d[2] + d[3])); return rsqrtf(s * (1.0f / 1024.0f) + NORM_EPS); }

#ifndef ER_DEPTH
#define ER_DEPTH 4
#endif
#ifndef EM_DEPTH
#define EM_DEPTH 6
#endif
__device__ __forceinline__ void wave_rstd(const float* P, int rbase, int lane, float& ra, float& rb) {
    const f32x4* p = (const f32x4*)(P + (size_t)(rbase + lane) * 16); const f32x4* q = p + 4 * HALF;
    const f32x4 a0 = p[0], a1 = p[1], a2 = p[2], a3 = p[3], b0 = q[0], b1 = q[1], b2 = q[2], b3 = q[3];
    const float sa = ((a0[0] + a0[1]) + (a0[2] + a0[3])) + ((a1[0] + a1[1]) + (a1[2] + a1[3])) + ((a2[0] + a2[1]) + (a2[2] + a2[3])) + ((a3[0] + a3[1]) + (a3[2] + a3[3]));
    const float sb = ((b0[0] + b0[1]) + (b0[2] + b0[3])) + ((b1[0] + b1[1]) + (b1[2] + b1[3])) + ((b2[0] + b2[1]) + (b2[2] + b2[3])) + ((b3[0] + b3[1]) + (b3[2] + b3[3]));
    ra = rsqrtf(sa * (1.0f / 1024.0f) + NORM_EPS); rb = rsqrtf(sb * (1.0f / 1024.0f) + NORM_EPS);
}
struct EpiIn {
    static constexpr bool PERM = true, AFTER_DRAIN = false;
    bf16_t *Q, *KV, *A, *G; const float* ss;
    __device__ __forceinline__ void operator()(const f32x4 (&acc)[2][2][4][2], const Unit& u, int wr, int wc, int fr, int fq) const {
        const int row0 = u.pm * BM + wr * 64 + fr, pn = u.pn, cw = wc * 32 + 8 * fq;
        float ra, rb; wave_rstd(ss, u.pm * BM + wr * 64, fr + 16 * fq, ra, rb);
        if (pn >= 5 && pn < 9) {
#pragma unroll
            for (int ai = 0; ai < 2; ++ai)
#pragma unroll
                for (int m = 0; m < 4; ++m) { const int row = row0 + ai * HALF + m * 16; const float rs = __shfl(ai ? rb : ra, 16 * m + fr);
                    const f32x4 u0 = acc[ai][0][m][0] * rs, u1 = acc[ai][0][m][1] * rs, g0 = acc[ai][1][m][0] * rs, g1 = acc[ai][1][m][1] * rs;
                    u32x4 w; w.x = pk2(u0[0] * sigm(g0[0]), u0[1] * sigm(g0[1])); w.y = pk2(u0[2] * sigm(g0[2]), u0[3] * sigm(g0[3]));
                    w.z = pk2(u1[0] * sigm(g1[0]), u1[1] * sigm(g1[1])); w.w = pk2(u1[2] * sigm(g1[2]), u1[3] * sigm(g1[3]));
                    *(u32x4*)(A + (size_t)row * 512 + (pn - 5) * 128 + cw) = w; }
        } else {
            bf16_t* base; int pitch; const bool sg = pn >= 9 && pn < 13;
            if (pn < 4) { base = Q + pn * 256 + cw; pitch = 1024; } else if (pn == 4) { base = KV + cw; pitch = 256; } else { base = G + (pn - 9) * 256 + cw; pitch = 2048; }
#pragma unroll
            for (int ai = 0; ai < 2; ++ai)
#pragma unroll
                for (int m = 0; m < 4; ++m) { const int row = row0 + ai * HALF + m * 16; const float rs = __shfl(ai ? rb : ra, 16 * m + fr);
                    bf16_t* rowp = base + (size_t)row * pitch;
#pragma unroll
                    for (int bj = 0; bj < 2; ++bj) { f32x4 v0 = acc[ai][bj][m][0] * rs, v1 = acc[ai][bj][m][1] * rs;
                        if (sg) { v0 = (f32x4){sigm(v0[0]), sigm(v0[1]), sigm(v0[2]), sigm(v0[3])}; v1 = (f32x4){sigm(v1[0]), sigm(v1[1]), sigm(v1[2]), sigm(v1[3])}; }
                        u32x4 w; w.x = pk2(v0[0], v0[1]); w.y = pk2(v0[2], v0[3]); w.z = pk2(v1[0], v1[1]); w.w = pk2(v1[2], v1[3]);
                        *(u32x4*)(rowp + bj * HALF) = w; } }
        }
    }
};
struct EpiMerge {
    static constexpr bool PERM = true, AFTER_DRAIN = false;
    bf16_t* AO; const bf16_t* G;
    __device__ __forceinline__ void operator()(const f32x4 (&acc)[2][2][4][2], const Unit& u, int wr, int wc, int fr, int fq) const {
        const int row0 = u.pm * BM + wr * 64 + fr, col0 = u.pn * BM + wc * 32 + 8 * fq;
        constexpr int MD = EM_DEPTH; u32x4 pa[MD], pgb[MD];
#define EM_ROW(hg) (row0 + ((hg) >> 3) * HALF + (((hg) >> 1) & 3) * 16)
#define EM_COL(hg) (col0 + ((hg) & 1) * HALF)
#define EM_LOAD(hg, s) do { pa[s] = *(const u32x4*)(AO + (size_t)EM_ROW(hg) * 1024 + EM_COL(hg)); pgb[s] = *(const u32x4*)(G + (size_t)EM_ROW(hg) * 2048 + 1024 + EM_COL(hg)); } while (0)
#pragma unroll
        for (int hg = 0; hg < MD; ++hg) EM_LOAD(hg, hg);
#pragma unroll
        for (int hg = 0; hg < 16; ++hg) { const int ai = hg >> 3, m = (hg >> 1) & 3, bj = hg & 1, s = hg % MD;
            const u32x4 ao = pa[s], gb = pgb[s]; const f32x4 c0 = acc[ai][bj][m][0], c1 = acc[ai][bj][m][1];
            u32x4 w;
            w.x = pk2(bflo(ao.x) + sigm(bflo(gb.x)) * c0[0], bfhi(ao.x) + sigm(bfhi(gb.x)) * c0[1]);
            w.y = pk2(bflo(ao.y) + sigm(bflo(gb.y)) * c0[2], bfhi(ao.y) + sigm(bfhi(gb.y)) * c0[3]);
            w.z = pk2(bflo(ao.z) + sigm(bflo(gb.z)) * c1[0], bfhi(ao.z) + sigm(bfhi(gb.z)) * c1[1]);
            w.w = pk2(bflo(ao.w) + sigm(bflo(gb.w)) * c1[2], bfhi(ao.w) + sigm(bfhi(gb.w)) * c1[3]);
            *(u32x4*)(AO + (size_t)EM_ROW(hg) * 1024 + EM_COL(hg)) = w;
            if (hg + MD < 16) EM_LOAD(hg + MD, s); }
#undef EM_ROW
#undef EM_COL
#undef EM_LOAD
    }
};
__device__ __forceinline__ float lo8_dec(unsigned hbits16, unsigned qbyte) {
    unsigned E = (hbits16 >> 7) & 0xffu; E = E < 16u ? 16u : E;
    return __uint_as_float(hbits16 << 16) + (float)(int)(signed char)qbyte * __uint_as_float((E - 15u) << 23);
}
__device__ __forceinline__ unsigned lo8_enc(float v, unsigned hbits16) {
    unsigned E = (hbits16 >> 7) & 0xffu; E = E < 16u ? 16u : E;
    const float q = (v - __uint_as_float(hbits16 << 16)) * __uint_as_float((269u - E) << 23);
    int i = (int)__builtin_rintf(q); i = i < -128 ? -128 : (i > 127 ? 127 : i);
    return (unsigned)i & 0xffu;
}
struct EpiRes {
    static constexpr bool PERM = true, AFTER_DRAIN = false;
    const unsigned char* lo_in; unsigned char* lo_out; bf16_t* XB; float* fout; float* ssn; int nxt;
    __device__ __forceinline__ void operator()(const f32x4 (&acc)[2][2][4][2], const Unit& u, int wr, int wc, int fr, int fq) const {
        const int row0 = u.pm * BM + wr * 64 + fr, col0 = u.pn * BM + wc * 32 + 8 * fq;
        constexpr int RD = ER_DEPTH; u32x4 ph[RD][2]; u32x2 pl[RD][2];
#define ER_ROW(g) (row0 + ((g) >> 2) * HALF + ((g) & 3) * 16)
#define ER_LOAD(g, s) do { const size_t o_ = (size_t)ER_ROW(g) * 1024 + col0; ph[s][0] = *(const u32x4*)(XB + o_); ph[s][1] = *(const u32x4*)(XB + o_ + HALF); pl[s][0] = *(const u32x2*)(lo_in + o_); pl[s][1] = *(const u32x2*)(lo_in + o_ + HALF); } while (0)
#pragma unroll
        for (int g = 0; g < RD; ++g) ER_LOAD(g, g);
#pragma unroll
        for (int g = 0; g < 8; ++g) { const int ai = g >> 2, m = g & 3, s = g % RD; const int row = ER_ROW(g); const size_t off = (size_t)row * 1024 + col0; float sq = 0.f;
#pragma unroll
            for (int bj = 0; bj < 2; ++bj) { const size_t o = off + bj * HALF; const u32x4 h = ph[s][bj]; const u32x2 l = pl[s][bj];
                const f32x4 v0 = (f32x4){lo8_dec(h.x & 0xffffu, l.x), lo8_dec(h.x >> 16, l.x >> 8), lo8_dec(h.y & 0xffffu, l.x >> 16), lo8_dec(h.y >> 16, l.x >> 24)} + acc[ai][bj][m][0];
                const f32x4 v1 = (f32x4){lo8_dec(h.z & 0xffffu, l.y), lo8_dec(h.z >> 16, l.y >> 8), lo8_dec(h.w & 0xffffu, l.y >> 16), lo8_dec(h.w >> 16, l.y >> 24)} + acc[ai][bj][m][1];
                if (nxt) { u32x4 w; w.x = pk2(v0[0], v0[1]); w.y = pk2(v0[2], v0[3]); w.z = pk2(v1[0], v1[1]); w.w = pk2(v1[2], v1[3]); *(u32x4*)(XB + o) = w;
                    u32x2 r; r.x = lo8_enc(v0[0], w.x & 0xffffu) | (lo8_enc(v0[1], w.x >> 16) << 8) | (lo8_enc(v0[2], w.y & 0xffffu) << 16) | (lo8_enc(v0[3], w.y >> 16) << 24);
                    r.y = lo8_enc(v1[0], w.z & 0xffffu) | (lo8_enc(v1[1], w.z >> 16) << 8) | (lo8_enc(v1[2], w.w & 0xffffu) << 16) | (lo8_enc(v1[3], w.w >> 16) << 24);
                    *(u32x2*)(lo_out + o) = r;
                    sq += ((v0[0] * v0[0] + v0[1] * v0[1]) + (v0[2] * v0[2] + v0[3] * v0[3])) + ((v1[0] * v1[0] + v1[1] * v1[1]) + (v1[2] * v1[2] + v1[3] * v1[3])); }
                else { *(f32x4*)(fout + o) = v0; *(f32x4*)(fout + o + 4) = v1; } }
            if (nxt) { sq += __shfl_xor(sq, 16); sq += __shfl_xor(sq, 32); if (fq == 0) ssn[(size_t)row * 16 + u.pn * 4 + wc] = sq; }
            if (g + RD < 8) ER_LOAD(g + RD, s); }
#undef ER_ROW
#undef ER_LOAD
    }
};
struct EpiSwiglu {
    static constexpr bool PERM = true, AFTER_DRAIN = false;
    bf16_t* ACT; const float* ss;
    __device__ __forceinline__ void operator()(const f32x4 (&acc)[2][2][4][2], const Unit& u, int wr, int wc, int fr, int fq) const {
        const int row0 = u.pm * BM + wr * 64 + fr, col = u.pn * 128 + wc * 32 + 8 * fq;
        float ra, rb; wave_rstd(ss, u.pm * BM + wr * 64, fr + 16 * fq, ra, rb);
#pragma unroll
        for (int ai = 0; ai < 2; ++ai)
#pragma unroll
            for (int m = 0; m < 4; ++m) { const int row = row0 + ai * HALF + m * 16; const float rs = __shfl(ai ? rb : ra, 16 * m + fr);
                const f32x4 g0 = acc[ai][0][m][0] * rs, g1 = acc[ai][0][m][1] * rs, u0 = acc[ai][1][m][0] * rs, u1 = acc[ai][1][m][1] * rs;
                u32x4 w; w.x = pk2(g0[0] * sigm(g0[0]) * u0[0], g0[1] * sigm(g0[1]) * u0[1]); w.y = pk2(g0[2] * sigm(g0[2]) * u0[2], g0[3] * sigm(g0[3]) * u0[3]);
                w.z = pk2(g1[0] * sigm(g1[0]) * u1[0], g1[1] * sigm(g1[1]) * u1[1]); w.w = pk2(g1[2] * sigm(g1[2]) * u1[2], g1[3] * sigm(g1[3]) * u1[3]);
                *(u32x4*)(ACT + (size_t)row * 2816 + col) = w; }
    }
};
template <class Epi, class Sched, bool ALIGN_EPI = false, bool SP2 = false>
__device__ __forceinline__ void gemm_phase(PG8_LAS unsigned char* lds, const Gemm g, const Sched& S, const Epi& E) {
    int tid_l = threadIdx.x; asm volatile("" : "+v"(tid_l));
    const int tid = tid_l, wid = __builtin_amdgcn_readfirstlane(tid >> 6), lane = tid & 63, wr = wid >> 2, wc = wid & 3, fr = lane & 15, fq = lane >> 4;
    const int K = g.K, nt = K / BK;
    unsigned voffA[2], voffB[2];
#pragma unroll
    for (int i = 0; i < 2; ++i) { int R, C; stage_rc(tid * 16 + i * 8192, R, C); const int Rb = Epi::PERM ? ((R & ~31) + perm32(R & 31)) : R;
        voffA[i] = (unsigned)(R * K + C) * 2u; voffB[i] = (unsigned)(Rb * K + C) * 2u; }
    const size_t kstep = (size_t)(BK * 2);
    const size_t hstep = (size_t)HALF * K * 2;
    const size_t tstep = 2 * hstep;
    const unsigned ldsw = (unsigned)wid * 1024u;
    const int aoff = lds_byte(wr * 64 + fr, fq * 8), boff = lds_byte(wc * 32 + fr, fq * 8);
#define PG8_SA(b, h) (((b) * 2 + (h)) * HTB)
#define PG8_SB(b, h) ((4 + (b) * 2 + (h)) * HTB)
#define PG8_STAGE(bufoff, gbase, voff) do { _Pragma("unroll") for (int _i = 0; _i < 2; ++_i) \
        __builtin_amdgcn_global_load_lds((const unsigned*)((const char*)(gbase) + (voff)[_i]), (PG8_LAS unsigned*)(lds + (bufoff) + ldsw + _i * 8192), 16, 0, 0); } while (0)
#define PG8_LDA(dst, b, h) do { _Pragma("unroll") for (int m = 0; m < 4; ++m) _Pragma("unroll") for (int k = 0; k < 2; ++k) dst[m][k] = *(const PG8_LAS bf16x8*)(lds + PG8_SA(b, h) + aoff + m * 2048 + k * 1024); } while (0)
#define PG8_LDB(dst, b, h) do { _Pragma("unroll") for (int n = 0; n < 2; ++n) _Pragma("unroll") for (int k = 0; k < 2; ++k) dst[n][k] = *(const PG8_LAS bf16x8*)(lds + PG8_SB(b, h) + boff + n * 2048 + k * 1024); } while (0)
#define PG8_MMA(ai, bj, At, Bt) do { __builtin_amdgcn_s_setprio(1); _Pragma("unroll") for (int m = 0; m < 4; ++m) _Pragma("unroll") for (int n = 0; n < 2; ++n) _Pragma("unroll") for (int k = 0; k < 2; ++k) \
        acc[ai][bj][m][n] = __builtin_amdgcn_mfma_f32_16x16x32_bf16(Bt[n][k], At[m][k], acc[ai][bj][m][n], 0, 0, 0); __builtin_amdgcn_s_setprio(0); } while (0)
#define PG8_WAIT_V(n) asm volatile("s_waitcnt vmcnt(" #n ")" ::: "memory")
#define PG8_WAIT_L(n) asm volatile("s_waitcnt lgkmcnt(" #n ")" ::: "memory")
#define PG8_BAR __builtin_amdgcn_s_barrier()
#define PG8_SCHED __builtin_amdgcn_sched_barrier(0)
    Unit cur, nxt; int ui = 0;
    if (!S.next(0, cur)) return;
    f32x4 acc[2][2][4][2];
#pragma unroll
    for (int a = 0; a < 2; ++a)
#pragma unroll
        for (int b = 0; b < 2; ++b)
#pragma unroll
            for (int m = 0; m < 4; ++m)
#pragma unroll
                for (int n = 0; n < 2; ++n) acc[a][b][m][n] = (f32x4){0.f, 0.f, 0.f, 0.f};
    bf16x8 At[4][2], B0[2][2], B1[2][2];
    const char* cA = (const char*)g.A + (size_t)cur.pm * tstep; const char* cB = (const char*)g.Bt + (size_t)cur.pn * tstep;
    S.a_ready(cur);
    if constexpr (SP2) {
        PG8_STAGE(PG8_SB(0, 0), cB, voffB); PG8_STAGE(PG8_SB(0, 1), cB + hstep, voffB); PG8_STAGE(PG8_SA(0, 0), cA, voffA); PG8_STAGE(PG8_SA(0, 1), cA + hstep, voffA);
        if (wr == 1) PG8_BAR;
        PG8_WAIT_V(2); PG8_BAR;
        PG8_STAGE(PG8_SB(1, 0), cB + kstep, voffB); PG8_STAGE(PG8_SA(1, 0), cA + kstep, voffA); PG8_STAGE(PG8_SB(1, 1), cB + hstep + kstep, voffB);
        PG8_WAIT_V(6); PG8_BAR;
    } else {
        PG8_STAGE(PG8_SB(0, 0), cB, voffB); PG8_STAGE(PG8_SA(0, 0), cA, voffA); PG8_STAGE(PG8_SB(0, 1), cB + hstep, voffB); PG8_STAGE(PG8_SA(0, 1), cA + hstep, voffA);
        if (wr == 1) PG8_BAR;
        PG8_WAIT_V(4); PG8_BAR;
        PG8_STAGE(PG8_SB(1, 0), cB + kstep, voffB); PG8_STAGE(PG8_SA(1, 0), cA + kstep, voffA); PG8_STAGE(PG8_SB(1, 1), cB + hstep + kstep, voffB);
        PG8_WAIT_V(6); PG8_BAR;
    }
    for (;;) {
        const bool has_next = S.next(ui + 1, nxt);
        const char* nA = has_next ? (const char*)g.A + (size_t)nxt.pm * tstep : cA; const char* nB = has_next ? (const char*)g.Bt + (size_t)nxt.pn * tstep : cB;
        for (int t = 0; t < nt; t += 2) {
            const bool last = (t == nt - 2);
            const char* a1 = cA + (size_t)(t + 1) * kstep;
            const char* a2 = last ? nA : cA + (size_t)(t + 2) * kstep; const char* b2 = last ? nB : cB + (size_t)(t + 2) * kstep;
            const char* a3 = a2 + kstep; const char* b3 = b2 + kstep;
            if (last && has_next) S.a_ready(nxt);
            if constexpr (SP2) {
            PG8_LDB(B0, 0, 0); PG8_LDB(B1, 0, 1); PG8_SCHED; PG8_LDA(At, 0, 0); PG8_STAGE(PG8_SA(1, 1), a1 + hstep, voffA);
            PG8_WAIT_V(8); PG8_WAIT_L(0); PG8_BAR; PG8_MMA(0, 0, At, B0); PG8_MMA(0, 1, At, B1); PG8_BAR; PG8_SCHED;
            PG8_LDA(At, 0, 1); PG8_STAGE(PG8_SB(0, 0), b2, voffB); PG8_STAGE(PG8_SB(0, 1), b2 + hstep, voffB); PG8_STAGE(PG8_SA(0, 0), a2, voffA);
            PG8_WAIT_V(8); PG8_WAIT_L(0); PG8_BAR; PG8_MMA(1, 0, At, B0); PG8_MMA(1, 1, At, B1); PG8_BAR; PG8_SCHED;
            PG8_LDB(B0, 1, 0); PG8_LDB(B1, 1, 1); PG8_SCHED; PG8_LDA(At, 1, 0); PG8_STAGE(PG8_SA(0, 1), a2 + hstep, voffA);
            PG8_WAIT_V(8); PG8_WAIT_L(0); PG8_BAR; PG8_MMA(0, 0, At, B0); PG8_MMA(0, 1, At, B1); PG8_BAR; PG8_SCHED;
            PG8_LDA(At, 1, 1); PG8_STAGE(PG8_SB(1, 0), b3, voffB); PG8_STAGE(PG8_SB(1, 1), b3 + hstep, voffB); PG8_STAGE(PG8_SA(1, 0), a3, voffA);
            PG8_WAIT_V(8); PG8_WAIT_L(0); PG8_BAR; PG8_MMA(1, 0, At, B0); PG8_MMA(1, 1, At, B1); PG8_BAR; PG8_SCHED;
            } else {
            PG8_LDB(B0, 0, 0); PG8_SCHED; PG8_LDA(At, 0, 0); PG8_STAGE(PG8_SA(1, 1), a1 + hstep, voffA);
            PG8_WAIT_L(8); PG8_BAR; PG8_WAIT_L(0); PG8_MMA(0, 0, At, B0); PG8_BAR; PG8_SCHED;
            PG8_LDB(B1, 0, 1); PG8_STAGE(PG8_SB(0, 0), b2, voffB);
            PG8_BAR; PG8_WAIT_L(0); PG8_MMA(0, 1, At, B1); PG8_BAR;
            PG8_LDA(At, 0, 1); PG8_STAGE(PG8_SA(0, 0), a2, voffA);
            PG8_BAR; PG8_WAIT_L(0); PG8_MMA(1, 0, At, B0); PG8_BAR; PG8_SCHED;
            PG8_STAGE(PG8_SB(0, 1), b2 + hstep, voffB);
            PG8_WAIT_V(6); PG8_BAR; PG8_MMA(1, 1, At, B1); PG8_BAR;
            PG8_LDB(B0, 1, 0); PG8_SCHED; PG8_LDA(At, 1, 0); PG8_STAGE(PG8_SA(0, 1), a2 + hstep, voffA);
            PG8_WAIT_L(8); PG8_BAR; PG8_WAIT_L(0); PG8_MMA(0, 0, At, B0); PG8_BAR; PG8_SCHED;
            PG8_LDB(B1, 1, 1); PG8_STAGE(PG8_SB(1, 0), b3, voffB);
            PG8_BAR; PG8_WAIT_L(0); PG8_MMA(0, 1, At, B1); PG8_BAR;
            PG8_LDA(At, 1, 1); PG8_STAGE(PG8_SA(1, 0), a3, voffA);
            PG8_BAR; PG8_WAIT_L(0); PG8_MMA(1, 0, At, B0); PG8_BAR; PG8_SCHED;
            PG8_STAGE(PG8_SB(1, 1), b3 + hstep, voffB);
            PG8_WAIT_V(6); PG8_BAR; PG8_MMA(1, 1, At, B1); PG8_BAR;
            }
        }
        if constexpr (ALIGN_EPI) { if (wr == 0) PG8_BAR; }
        if constexpr (!Epi::AFTER_DRAIN) { E(acc, cur, wr, wc, fr, fq); S.done(cur); }
        if (!has_next) break;
#pragma unroll
        for (int a = 0; a < 2; ++a)
#pragma unroll
            for (int b = 0; b < 2; ++b)
#pragma unroll
                for (int m = 0; m < 4; ++m)
#pragma unroll
                    for (int n = 0; n < 2; ++n) acc[a][b][m][n] = (f32x4){0.f, 0.f, 0.f, 0.f};
        cur = nxt; cA = nA; cB = nB; ++ui;
        if constexpr (ALIGN_EPI) { if (wr == 1) PG8_BAR; }
    }
    PG8_WAIT_V(0);
    if constexpr (!ALIGN_EPI) { if (wr == 0) PG8_BAR; }
    PG8_BAR;
    if constexpr (Epi::AFTER_DRAIN) { E.fused(acc, cur, wr, wc, fr, fq, lds, wid, lane); S.done(cur); }
#undef PG8_SA
#undef PG8_SB
#undef PG8_STAGE
#undef PG8_LDA
#undef PG8_LDB
#undef PG8_MMA
#undef PG8_WAIT_V
#undef PG8_WAIT_L
#undef PG8_BAR
#undef PG8_SCHED
}
}
using pg8::bf16_t; using pg8::f32x4; using pg8::u32x4; using pg8::bf16x8; using pg8::u32x2; using pg8::pk2; using pg8::bflo; using pg8::bfhi; using pg8::sigm; using pg8::NORM_EPS;
#define LAS __attribute__((address_space(3)))
constexpr int NB = 4, T = 8192, M = NB * T, D = 1024, INW = 4352, CC = 512, FF = 2816, GU = 2 * FF, DEPTH = 4, NHEAD = 16;
constexpr size_t MiB = 1u << 20;
constexpr size_t WS_SS = 450 * MiB, SS_BUF = 2 * MiB;
constexpr size_t WS_ROPE = 1 * MiB;
constexpr size_t WS_W = 2 * MiB, W_LAYER = 28 * MiB;
constexpr size_t WO_IN = 0, WO_PW = 8 * MiB + MiB / 2, WO_OUT = WO_PW + 1 * MiB, WO_GU = WO_OUT + 2 * MiB, WO_DN = WO_GU + 11 * MiB;
constexpr size_t WS_XB = 114 * MiB, WS_QO = 178 * MiB, WS_KV = 242 * MiB, WS_A = 258 * MiB, WS_G = 290 * MiB, WS_Y = 418 * MiB, WS_BAR = 455 * MiB, WS_END = 456 * MiB;
constexpr size_t WS_LOB = 354 * MiB;
constexpr size_t WS_ACT = 178 * MiB;
static_assert(WO_DN + (size_t)D * FF * 2 == W_LAYER && WS_W + DEPTH * W_LAYER == WS_XB && WS_ACT + (size_t)M * FF * 2 <= WS_Y, "ws map");
constexpr int LDS_BYTES = 132096;

__device__ __forceinline__ float wave_sum(float v) {
#pragma unroll
    for (int o = 1; o < 64; o <<= 1) v += __shfl_xor(v, o);
    return v;
}

namespace att {
typedef __attribute__((ext_vector_type(16))) float f32x16;
typedef __attribute__((ext_vector_type(4))) short s16x4;
constexpr int KPB = 144, VPB = 520, OFF_V = 256 * KPB, SCR_OFF = 71680, SCR_WAVE = 4608;
constexpr float LOG2E = 1.4426950408889634f;
__device__ __forceinline__ int crow(int r, int hi) { return (r & 3) + 8 * (r >> 2) + 4 * hi; }

__device__ __forceinline__ void unit(LAS unsigned char* lds, int b, int kvh, int blk, bf16_t* QO, const bf16_t* KV, const bf16_t* GA, const float* qn, const float* kn, const float* sinks,
                                     const float* rope, int tid, int lane, int wave) {
    const int h = kvh * 8 + wave, q = lane & 31, hi = lane >> 5, crow8 = lane >> 3, cch = lane & 7;
    u32x4 qrN[4], gtN[4]; f32x4 rpN[4];
#define AT_LOAD(sub_) do { const size_t tr_ = (size_t)(b * T + blk * 128 + 32 * (sub_)); const int tq_ = blk * 128 + 32 * (sub_) + q; \
        _Pragma("unroll") for (int i = 0; i < 4; ++i) { qrN[i] = *(const u32x4*)(QO + (tr_ + crow8 + 8 * i) * 1024 + h * 64 + cch * 8); gtN[i] = *(const u32x4*)(GA + (tr_ + crow8 + 8 * i) * 2048 + h * 64 + cch * 8); \
            rpN[i] = *(const f32x4*)(rope + tq_ * 16 + 4 * i); } } while (0)
    AT_LOAD(0);
    {
        const int row = tid >> 1, half = tid & 1, pos = blk * 128 - 128 + row; const bool valid = pos >= 0;
        const bf16_t* src = KV + (size_t)(b * T + pos) * 256 + kvh * 64 + half * 32;
        float x[32]; float ssq = 0.f;
#pragma unroll
        for (int i = 0; i < 4; ++i) { u32x4 r = (u32x4){0u, 0u, 0u, 0u}; if (valid) r = *(const u32x4*)(src + 8 * i);
            x[8 * i + 0] = bflo(r.x); x[8 * i + 1] = bfhi(r.x); x[8 * i + 2] = bflo(r.y); x[8 * i + 3] = bfhi(r.y); x[8 * i + 4] = bflo(r.z); x[8 * i + 5] = bfhi(r.z); x[8 * i + 6] = bflo(r.w); x[8 * i + 7] = bfhi(r.w); }
#pragma unroll
        for (int i = 0; i < 32; ++i) ssq += x[i] * x[i];
        ssq += __shfl_xor(ssq, 1);
        const float rstd = rsqrtf(ssq * (1.0f / 64.0f) + NORM_EPS);
#pragma unroll
        for (int i = 0; i < 8; ++i) { const f32x4 g = *(const f32x4*)(kn + half * 32 + 4 * i); x[4 * i] *= rstd * g[0]; x[4 * i + 1] *= rstd * g[1]; x[4 * i + 2] *= rstd * g[2]; x[4 * i + 3] *= rstd * g[3]; }
        if (half == 0 && valid) { const float* cs = rope + pos * 16;
#pragma unroll
            for (int i = 0; i < 8; ++i) { const float c = cs[i], s = cs[8 + i], x1 = x[i], x2 = x[8 + i]; x[i] = x1 * c - x2 * s; x[8 + i] = x2 * c + x1 * s; } }
#pragma unroll
        for (int i = 0; i < 4; ++i) { u32x4 w; w.x = pk2(x[8 * i], x[8 * i + 1]); w.y = pk2(x[8 * i + 2], x[8 * i + 3]); w.z = pk2(x[8 * i + 4], x[8 * i + 5]); w.w = pk2(x[8 * i + 6], x[8 * i + 7]);
            *(LAS u32x4*)(lds + row * KPB + half * 64 + 16 * i) = w; }
    }
    {
        const int rp = tid >> 2, c = tid & 3, pos0 = blk * 128 - 128 + 2 * rp; const bool valid = pos0 >= 0;
        const bf16_t* src = KV + (size_t)(b * T + pos0) * 256 + 128 + kvh * 64 + 16 * c;
        u32x4 r0[2], r1[2];
#pragma unroll
        for (int i = 0; i < 2; ++i) { r0[i] = (u32x4){0u, 0u, 0u, 0u}; r1[i] = r0[i]; if (valid) { r0[i] = *(const u32x4*)(src + 8 * i); r1[i] = *(const u32x4*)(src + 256 + 8 * i); } }
#pragma unroll
        for (int w = 0; w < 8; ++w) { const unsigned a = r0[w >> 2][w & 3], bb = r1[w >> 2][w & 3]; const int d = 16 * c + 2 * w;
            *(LAS unsigned*)(lds + OFF_V + d * VPB + rp * 4) = (a & 0xffffu) | (bb << 16);
            *(LAS unsigned*)(lds + OFF_V + (d + 1) * VPB + rp * 4) = (a >> 16) | (bb & 0xffff0000u); }
    }
    __syncthreads();
    const float sink2 = sinks[h] * LOG2E;
#pragma unroll 1
    for (int sub = 0; sub < 4; ++sub) {
        const int tq = blk * 128 + 32 * sub + q;
        LAS unsigned char* scr = lds + SCR_OFF + wave * SCR_WAVE;
        const size_t trow = (size_t)(b * T + blk * 128 + 32 * sub);
        u32x4 gtc[4]; f32x4 rp[4];
#pragma unroll
        for (int i = 0; i < 4; ++i) { gtc[i] = gtN[i]; rp[i] = rpN[i]; *(LAS u32x4*)(scr + (crow8 + 8 * i) * 144 + cch * 16) = qrN[i]; }
        if (sub < 3) AT_LOAD(sub + 1);
        asm volatile("s_waitcnt lgkmcnt(0)" ::: "memory");
        float x[4][8]; float ssq = 0.f;
#pragma unroll
        for (int d0 = 0; d0 < 4; ++d0) { const u32x4 r = *(const LAS u32x4*)(scr + q * 144 + (16 * d0 + 8 * hi) * 2);
            x[d0][0] = bflo(r.x); x[d0][1] = bfhi(r.x); x[d0][2] = bflo(r.y); x[d0][3] = bfhi(r.y); x[d0][4] = bflo(r.z); x[d0][5] = bfhi(r.z); x[d0][6] = bflo(r.w); x[d0][7] = bfhi(r.w); }
#pragma unroll
        for (int d0 = 0; d0 < 4; ++d0)
#pragma unroll
            for (int i = 0; i < 8; ++i) ssq += x[d0][i] * x[d0][i];
        ssq += __shfl_xor(ssq, 32);
        const float rstd = rsqrtf(ssq * (1.0f / 64.0f) + NORM_EPS) * (0.125f * LOG2E);
#pragma unroll
        for (int d0 = 0; d0 < 4; ++d0) { const f32x4 g0 = *(const f32x4*)(qn + 16 * d0 + 8 * hi), g1 = *(const f32x4*)(qn + 16 * d0 + 8 * hi + 4);
            x[d0][0] *= rstd * g0[0]; x[d0][1] *= rstd * g0[1]; x[d0][2] *= rstd * g0[2]; x[d0][3] *= rstd * g0[3]; x[d0][4] *= rstd * g1[0]; x[d0][5] *= rstd * g1[1]; x[d0][6] *= rstd * g1[2]; x[d0][7] *= rstd * g1[3]; }
#pragma unroll
        for (int i = 0; i < 8; ++i) { const float c = rp[i >> 2][i & 3], s = rp[2 + (i >> 2)][i & 3], me = x[0][i], ot = __shfl_xor(me, 32); x[0][i] = hi == 0 ? me * c - ot * s : me * c + ot * s; }
        bf16x8 qf[4];
#pragma unroll
        for (int d0 = 0; d0 < 4; ++d0) { u32x4 w; w.x = pk2(x[d0][0], x[d0][1]); w.y = pk2(x[d0][2], x[d0][3]); w.z = pk2(x[d0][4], x[d0][5]); w.w = pk2(x[d0][6], x[d0][7]); qf[d0] = __builtin_bit_cast(bf16x8, w); }
        f32x16 p[5];
#pragma unroll
        for (int kt = 0; kt < 5; ++kt) {
#pragma unroll
            for (int r = 0; r < 16; ++r) p[kt][r] = 0.f;
#pragma unroll
            for (int d0 = 0; d0 < 4; ++d0) { const bf16x8 kf = *(const LAS bf16x8*)(lds + (32 * (sub + kt) + q) * KPB + (16 * d0 + 8 * hi) * 2);
                p[kt] = __builtin_amdgcn_mfma_f32_32x32x16_bf16(kf, qf[d0], p[kt], 0, 0, 0); } }
        const bool first = (blk == 0);
        bool lowtri[16];
#pragma unroll
        for (int r = 0; r < 16; ++r) lowtri[r] = crow(r, hi) <= q;
        f32x16 pc;
#pragma unroll
        for (int r = 0; r < 16; ++r) pc[r] = lowtri[r] ? p[4][r] : (first ? -INFINITY : p[0][r]);
        if (first) {
#pragma unroll
            for (int kt = 1; kt < 4; ++kt) if (sub + kt < 4) {
#pragma unroll
                for (int r = 0; r < 16; ++r) p[kt][r] = -INFINITY; } }
        float mx = sink2;
#pragma unroll
        for (int r = 0; r < 16; ++r) mx = fmaxf(fmaxf(mx, pc[r]), fmaxf(fmaxf(p[1][r], p[2][r]), p[3][r]));
        mx = fmaxf(mx, __shfl_xor(mx, 32));
#pragma unroll
        for (int r = 0; r < 16; ++r) { pc[r] = __builtin_amdgcn_exp2f(pc[r] - mx); p[1][r] = __builtin_amdgcn_exp2f(p[1][r] - mx); p[2][r] = __builtin_amdgcn_exp2f(p[2][r] - mx); p[3][r] = __builtin_amdgcn_exp2f(p[3][r] - mx); }
        const f32x16 sv = (pc + p[1]) + (p[2] + p[3]);
        float lsum = ((sv[0] + sv[1]) + (sv[2] + sv[3])) + ((sv[4] + sv[5]) + (sv[6] + sv[7])) + (((sv[8] + sv[9]) + (sv[10] + sv[11])) + ((sv[12] + sv[13]) + (sv[14] + sv[15])));
        lsum += __shfl_xor(lsum, 32); lsum += __builtin_amdgcn_exp2f(sink2 - mx);
        const float inv = 1.0f / lsum;
#pragma unroll
        for (int r = 0; r < 16; ++r) { p[0][r] = lowtri[r] ? 0.f : pc[r]; p[4][r] = lowtri[r] ? pc[r] : 0.f; }
        f32x16 o[2];
#pragma unroll
        for (int r = 0; r < 16; ++r) { o[0][r] = 0.f; o[1][r] = 0.f; }
#pragma unroll
        for (int kt = 0; kt < 5; ++kt)
#pragma unroll
            for (int s = 0; s < 2; ++s) { u32x4 w; w.x = pk2(p[kt][8 * s], p[kt][8 * s + 1]); w.y = pk2(p[kt][8 * s + 2], p[kt][8 * s + 3]); w.z = pk2(p[kt][8 * s + 4], p[kt][8 * s + 5]); w.w = pk2(p[kt][8 * s + 6], p[kt][8 * s + 7]);
                const bf16x8 pf = __builtin_bit_cast(bf16x8, w);
#pragma unroll
                for (int d0 = 0; d0 < 2; ++d0) { const LAS unsigned char* vp = lds + OFF_V + (32 * d0 + q) * VPB + (32 * (sub + kt) + 16 * s + 4 * hi) * 2;
                    const s16x4 lo = *(const LAS s16x4*)vp, hi4 = *(const LAS s16x4*)(vp + 16);
                    const bf16x8 vf = (bf16x8){lo[0], lo[1], lo[2], lo[3], hi4[0], hi4[1], hi4[2], hi4[3]};
                    o[d0] = __builtin_amdgcn_mfma_f32_32x32x16_bf16(vf, pf, o[d0], 0, 0, 0); } }
        asm volatile("s_waitcnt lgkmcnt(0)" ::: "memory");
#pragma unroll
        for (int d0 = 0; d0 < 2; ++d0)
#pragma unroll
            for (int g = 0; g < 4; ++g) { u32x2 w; w.x = pk2(o[d0][4 * g] * inv, o[d0][4 * g + 1] * inv); w.y = pk2(o[d0][4 * g + 2] * inv, o[d0][4 * g + 3] * inv);
                *(LAS u32x2*)(scr + q * 144 + (32 * d0 + 8 * g + 4 * hi) * 2) = w; }
        asm volatile("s_waitcnt lgkmcnt(0)" ::: "memory");
#pragma unroll
        for (int i = 0; i < 4; ++i) { const u32x4 ov = *(const LAS u32x4*)(scr + (crow8 + 8 * i) * 144 + cch * 16); const u32x4 gg = gtc[i]; u32x4 w;
            w.x = pk2(bflo(ov.x) * bflo(gg.x), bfhi(ov.x) * bfhi(gg.x)); w.y = pk2(bflo(ov.y) * bflo(gg.y), bfhi(ov.y) * bfhi(gg.y));
            w.z = pk2(bflo(ov.z) * bflo(gg.z), bfhi(ov.z) * bfhi(gg.z)); w.w = pk2(bflo(ov.w) * bflo(gg.w), bfhi(ov.w) * bfhi(gg.w));
            *(u32x4*)(QO + (trow + crow8 + 8 * i) * 1024 + h * 64 + cch * 8) = w; }
        asm volatile("s_waitcnt lgkmcnt(0)" ::: "memory");
    }
#undef AT_LOAD
    __syncthreads();
}
}

namespace cv {
constexpr int ROWS = 62, OFF_Y = ROWS * 1024, NU = M / 32;
typedef pg8::f32x2_t f32x2;
__device__ __forceinline__ void phase(LAS unsigned char* lds, int bx, int G, const bf16_t* A, bf16_t* Y, const float* cw, const float* cb, const float* lg, const float* lb, int tid, int lane, int wave) {
    const int cp = tid & 255, tg = tid >> 8;
    f32x2 wv[31];
#pragma unroll
    for (int j = 0; j < 31; ++j) wv[j] = *(const f32x2*)(cw + j * CC + 2 * cp);
    const f32x2 bias = *(const f32x2*)(cb + 2 * cp);
    const f32x4 g0 = *(const f32x4*)(lg + 4 * lane), g1 = *(const f32x4*)(lg + 256 + 4 * lane), b0 = *(const f32x4*)(lb + 4 * lane), b1 = *(const f32x4*)(lb + 256 + 4 * lane);
    u32x4 pre[8];
#define CV_FETCH(un) do { const int t0_ = (un) * 32, p0_ = t0_ & (T - 1); _Pragma("unroll") for (int i = 0; i < 8; ++i) { const int idx = tid + 512 * i, r = idx >> 6, ch = idx & 63; pre[i] = (u32x4){0u, 0u, 0u, 0u}; \
        if (idx < ROWS * 64 && p0_ - 30 + r >= 0) pre[i] = *(const u32x4*)(A + (size_t)(t0_ - 30 + r) * CC + ch * 8); } } while (0)
    int un = bx;
    if (un < NU) CV_FETCH(un);
#pragma unroll 1
    for (; un < NU; un += G) {
        const int t0 = un * 32;
#pragma unroll
        for (int i = 0; i < 8; ++i) { const int idx = tid + 512 * i; if (idx < ROWS * 64) *(LAS u32x4*)(lds + idx * 16) = pre[i]; }
        __syncthreads();
        if (un + G < NU) CV_FETCH(un + G);
#pragma unroll 1
        for (int sb = 0; sb < 2; ++sb) { const int tb = 16 * tg + 8 * sb;
            f32x2 ac[8];
#pragma unroll
            for (int i = 0; i < 8; ++i) ac[i] = bias;
#pragma unroll
            for (int rr = 0; rr < 38; ++rr) { const unsigned v = *(const LAS unsigned*)(lds + (tb + rr) * 1024 + cp * 4); const f32x2 vv = (f32x2){bflo(v), bfhi(v)};
#pragma unroll
                for (int i = 0; i < 8; ++i) { const int j = rr - i; if (j >= 0 && j <= 30) ac[i] = __builtin_elementwise_fma(wv[j], vv, ac[i]); } }
#pragma unroll
            for (int i = 0; i < 8; ++i) *(LAS f32x2*)(lds + OFF_Y + (tb + i) * 2048 + cp * 8) = ac[i]; }
        __syncthreads();
#pragma unroll
        for (int k = 0; k < 4; ++k) { const int tok = 4 * wave + k;
            f32x4 v0 = *(const LAS f32x4*)(lds + OFF_Y + tok * 2048 + lane * 16), v1 = *(const LAS f32x4*)(lds + OFF_Y + tok * 2048 + 1024 + lane * 16);
            const float mean = wave_sum((v0[0] + v0[1]) + (v0[2] + v0[3]) + (v1[0] + v1[1]) + (v1[2] + v1[3])) * (1.0f / 512.0f);
            v0 = v0 - mean; v1 = v1 - mean;
            const float var = wave_sum((v0[0] * v0[0] + v0[1] * v0[1]) + (v0[2] * v0[2] + v0[3] * v0[3]) + (v1[0] * v1[0] + v1[1] * v1[1]) + (v1[2] * v1[2] + v1[3] * v1[3])) * (1.0f / 512.0f);
            const float rstd = rsqrtf(var + NORM_EPS);
            v0 = v0 * rstd * g0 + b0; v1 = v1 * rstd * g1 + b1;
            u32x2 w0, w1; w0.x = pk2(v0[0] * sigm(v0[0]), v0[1] * sigm(v0[1])); w0.y = pk2(v0[2] * sigm(v0[2]), v0[3] * sigm(v0[3]));
            w1.x = pk2(v1[0] * sigm(v1[0]), v1[1] * sigm(v1[1])); w1.y = pk2(v1[2] * sigm(v1[2]), v1[3] * sigm(v1[3]));
            bf16_t* yp = Y + (size_t)(t0 + tok) * CC + 4 * lane; *(u32x2*)yp = w0; *(u32x2*)(yp + 256) = w1; }
        __syncthreads();
    }
#undef CV_FETCH
}
}
__device__ __forceinline__ void transpose_item(const float* W, int K, int N, bf16_t* WT, int k0, int n0s, int n0d, const float* gain, LAS float* scr, int lane) {
    const int r8 = lane >> 3, c4 = (lane & 7) * 4;
    f32x4 v[8]; float gs[8];
#pragma unroll
    for (int i = 0; i < 8; ++i) { v[i] = *(const f32x4*)(W + (size_t)(k0 + 8 * i + r8) * N + n0s + c4); gs[i] = gain ? gain[k0 + 8 * i + r8] : 1.0f; }
#pragma unroll
    for (int i = 0; i < 8; ++i) { LAS float* d = scr + (8 * i + r8) * 33 + c4; d[0] = v[i][0] * gs[i]; d[1] = v[i][1] * gs[i]; d[2] = v[i][2] * gs[i]; d[3] = v[i][3] * gs[i]; }
    asm volatile("s_waitcnt lgkmcnt(0)" ::: "memory");
    const int c = lane & 7;
#pragma unroll
    for (int j = 0; j < 4; ++j) { const int n = (lane >> 3) + 8 * j; const LAS float* s = scr + (8 * c) * 33 + n;
        u32x4 o; o.x = pk2(s[0 * 33], s[1 * 33]); o.y = pk2(s[2 * 33], s[3 * 33]); o.z = pk2(s[4 * 33], s[5 * 33]); o.w = pk2(s[6 * 33], s[7 * 33]);
        *(u32x4*)(WT + (size_t)(n0d + n) * K + k0 + 8 * c) = o; }
    asm volatile("s_waitcnt lgkmcnt(0)" ::: "memory");
}
__device__ __forceinline__ int perm_in(int n0d) { const int pn = n0d >> 8, h = (n0d >> 7) & 1, j = n0d & 127; if (pn >= 5 && pn < 9) return (h ? 1792 : 1280) + 128 * (pn - 5) + j; return n0d; }
__device__ __forceinline__ int perm_gu(int n0d) { const int pn = n0d >> 8, h = (n0d >> 7) & 1, j = n0d & 127; return (h ? FF : 0) + 128 * pn + j; }

struct Args { const float* in[15]; float* out; unsigned char* ws; int ph_lo, ph_hi; };
enum { I_X = 0, I_NMIX, I_WIN, I_QN, I_KN, I_SINK, I_CW, I_CB, I_LG, I_LB, I_WPW, I_WOUT, I_NFFN, I_WGU, I_WDN };

__device__ __forceinline__ void convert_layer(const Args& a, int l, int slot, int nslots, LAS float* scr, int lane) {
    constexpr int I_IN = (D / 64) * (INW / 32), I_PW = (CC / 64) * (D / 32), I_OUT = (D / 64) * (D / 32), I_GU = (D / 64) * (GU / 32), I_DN = (FF / 64) * (D / 32), PER_L = I_IN + I_PW + I_OUT + I_GU + I_DN;
    unsigned char* wb = a.ws + WS_W + (size_t)l * W_LAYER;
    for (int it = slot; it < PER_L; it += nslots) {
        int r = it;
        if (r < I_IN) { const int nblk = INW / 32, kb = r / nblk, nb = r % nblk; transpose_item(a.in[I_WIN] + (size_t)l * D * INW, D, INW, (bf16_t*)(wb + WO_IN), 64 * kb, perm_in(32 * nb), 32 * nb, a.in[I_NMIX] + l * D, scr, lane); continue; } r -= I_IN;
        if (r < I_PW) { const int nblk = D / 32, kb = r / nblk, nb = r % nblk; transpose_item(a.in[I_WPW] + (size_t)l * CC * D, CC, D, (bf16_t*)(wb + WO_PW), 64 * kb, 32 * nb, 32 * nb, nullptr, scr, lane); continue; } r -= I_PW;
        if (r < I_OUT) { const int nblk = D / 32, kb = r / nblk, nb = r % nblk; transpose_item(a.in[I_WOUT] + (size_t)l * D * D, D, D, (bf16_t*)(wb + WO_OUT), 64 * kb, 32 * nb, 32 * nb, nullptr, scr, lane); continue; } r -= I_OUT;
        if (r < I_GU) { const int nblk = GU / 32, kb = r / nblk, nb = r % nblk; transpose_item(a.in[I_WGU] + (size_t)l * D * GU, D, GU, (bf16_t*)(wb + WO_GU), 64 * kb, perm_gu(32 * nb), 32 * nb, a.in[I_NFFN] + l * D, scr, lane); continue; } r -= I_GU;
        { const int nblk = D / 32, kb = r / nblk, nb = r % nblk; transpose_item(a.in[I_WDN] + (size_t)l * FF * D, FF, D, (bf16_t*)(wb + WO_DN), 64 * kb, 32 * nb, 32 * nb, nullptr, scr, lane); }
    }
}
__device__ __forceinline__ void prologue(const Args& a, LAS unsigned char* lds, int tid, int lane, int wave) {
    LAS float* scr = (LAS float*)(lds + wave * 16384);
    const int gw = blockIdx.x * 8 + wave, NGW = gridDim.x * 8;
    const int lw = gridDim.x == 256 ? 1 : DEPTH;
    for (int l = 0; l < lw; ++l) convert_layer(a, l, gw, NGW, scr, lane);
    float* ss = (float*)(a.ws + WS_SS); bf16_t* XB = (bf16_t*)(a.ws + WS_XB);
    unsigned char* LOA = (unsigned char*)a.out;
    for (int m = gw; m < M; m += NGW) { const f32x4* xr = (const f32x4*)(a.in[I_X] + (size_t)m * D) + lane; u32x2* xo = (u32x2*)(XB + (size_t)m * D) + lane; unsigned* lo = (unsigned*)(LOA + (size_t)m * D) + lane; float s = 0.f;
#pragma unroll
        for (int j = 0; j < 4; ++j) { const f32x4 v = xr[64 * j]; s += (v[0] * v[0] + v[1] * v[1]) + (v[2] * v[2] + v[3] * v[3]); u32x2 w; w.x = pk2(v[0], v[1]); w.y = pk2(v[2], v[3]); xo[64 * j] = w;
            lo[64 * j] = pg8::lo8_enc(v[0], w.x & 0xffffu) | (pg8::lo8_enc(v[1], w.x >> 16) << 8) | (pg8::lo8_enc(v[2], w.y & 0xffffu) << 16) | (pg8::lo8_enc(v[3], w.y >> 16) << 24); }
        s = wave_sum(s); if (lane < 16) ss[(size_t)m * 16 + lane] = lane == 0 ? s : 0.f; }
    float* rope = (float*)(a.ws + WS_ROPE);
    for (int i = blockIdx.x * 512 + tid; i < T * 8; i += gridDim.x * 512) { const int t = i >> 3, f = i & 7;
        double fr = 1.0; for (int k = 0; k < f; ++k) fr *= 0.19392274474868576;
        const float inv_freq = (float)fr; const float ang = (float)t * inv_freq;
        const double x = (double)ang, kq = __builtin_rint(x * 0.6366197723675814);
        const double r = __builtin_fma(-kq, 6.123233995736766e-17, __builtin_fma(-kq, 1.5707963267948966, x)), r2 = r * r;
        const double sp = r * (1.0 + r2 * (-1.0 / 6 + r2 * (1.0 / 120 + r2 * (-1.0 / 5040 + r2 * (1.0 / 362880 + r2 * (-1.0 / 39916800 + r2 * (1.0 / 6227020800.0)))))));
        const double cp = 1.0 + r2 * (-0.5 + r2 * (1.0 / 24 + r2 * (-1.0 / 720 + r2 * (1.0 / 40320 + r2 * (-1.0 / 3628800 + r2 * (1.0 / 479001600 + r2 * (-1.0 / 87178291200.0)))))));
        const int qd = ((int)kq) & 3;
        const double sn = qd == 0 ? sp : qd == 1 ? cp : qd == 2 ? -sp : -cp, cn = qd == 0 ? cp : qd == 1 ? -sp : qd == 2 ? -cp : sp;
        rope[t * 16 + f] = (float)cn; rope[t * 16 + 8 + f] = (float)sn; }
}

#define XB_TMO      128
#define XB_XCNT(j)  (256  + 64 * (j))
#define XB_XSUB(j)  (1280 + 64 * (j))
#define XB_XGEN(j)  (2304 + 64 * (j))
#define XB_TOP      3328
#define XB_TOPGEN   3392
#define XCD_BAR_WORDS 3456
#define XB_SPIN_CAP (1u << 18)

__device__ __forceinline__ unsigned xb_ld(unsigned* p)              { return __hip_atomic_load(p, __ATOMIC_RELAXED, __HIP_MEMORY_SCOPE_AGENT); }
__device__ __forceinline__ unsigned xb_add(unsigned* p, unsigned v) { return __hip_atomic_fetch_add(p, v, __ATOMIC_RELAXED, __HIP_MEMORY_SCOPE_AGENT); }
__device__ __forceinline__ unsigned xb_xcc_id() { return (unsigned)__builtin_amdgcn_s_getreg((3 << 11) | 20) & 0xFu; }
#define XB_SPIN(cond, bar) do { unsigned _sp = 0; while (cond) { __builtin_amdgcn_s_sleep(1); \
    if ((++_sp & 255u) == 0u) { if (xb_ld(&(bar)[XB_TMO])) break; if (_sp > XB_SPIN_CAP) { atomicAdd(&(bar)[XB_TMO], 1u); break; } } } } while (0)

struct XcdBarrier {
    unsigned* bar; unsigned x;
    volatile LAS unsigned* st;
};

__device__ __forceinline__ XcdBarrier xcd_barrier_post(unsigned* bar, volatile LAS unsigned* st) {
    XcdBarrier b; b.bar = bar; b.x = xb_xcc_id(); b.st = st;
    if (threadIdx.x == 0) (void)xb_add(&bar[XB_XCNT(b.x)], 1u);
    return b;
}
__device__ __forceinline__ void xcd_barrier_complete(unsigned* bar, unsigned x, unsigned& nloc, unsigned& nx) {
    const unsigned G = gridDim.x * gridDim.y * gridDim.z;
    unsigned sum, cnt, mine, sp = 0u;
    for (;;) {
        sum = 0u; cnt = 0u; mine = 0u;
#pragma unroll
        for (unsigned j = 0; j < 16; ++j) { const unsigned c = xb_ld(&bar[XB_XCNT(j)]); sum += c; cnt += (c > 0u) ? 1u : 0u; mine = (j == x) ? c : mine; }
        if (sum == G) break;
        __builtin_amdgcn_s_sleep(1);
        if ((++sp & 255u) == 0u) { if (xb_ld(&bar[XB_TMO])) break; if (sp > XB_SPIN_CAP) { atomicAdd(&bar[XB_TMO], 1u); break; } }
    }
    nloc = mine > 0u ? mine : 1u; nx = cnt > 0u ? cnt : 1u;
}

__device__ __forceinline__ void xcd_barrier(const XcdBarrier& b) {
    asm volatile("s_waitcnt vmcnt(0)" ::: "memory");
    __syncthreads();
    if (threadIdx.x == 0) {
        unsigned* bar = b.bar;
        __builtin_amdgcn_s_waitcnt(0);
        unsigned nloc = b.st[0], nx = b.st[1];
        if (nloc == 0u) { xcd_barrier_complete(bar, b.x, nloc, nx); b.st[0] = nloc; b.st[1] = nx; }
        const unsigned old = xb_add(&bar[XB_XSUB(b.x)], 1u);
        const unsigned gen = old / nloc;
        if (old + 1u == (gen + 1u) * nloc) {
            __builtin_amdgcn_fence(__ATOMIC_RELEASE, "agent");
            asm volatile("s_waitcnt vmcnt(0)" ::: "memory");
            const unsigned og = xb_add(&bar[XB_TOP], 1u);
            const unsigned tg = og / nx;
            if (og + 1u == (tg + 1u) * nx) xb_add(&bar[XB_TOPGEN], 1u);
            else XB_SPIN(xb_ld(&bar[XB_TOPGEN]) == tg, bar);
            __builtin_amdgcn_fence(__ATOMIC_ACQUIRE, "agent");
            xb_add(&bar[XB_XGEN(b.x)], 1u);
            asm volatile("s_waitcnt vmcnt(0)" ::: "memory");
        } else {
            XB_SPIN(xb_ld(&bar[XB_XGEN(b.x)]) == gen, bar);
            __builtin_amdgcn_fence(__ATOMIC_ACQUIRE, "agent");
            asm volatile("s_waitcnt vmcnt(0)" ::: "memory");
        }
    }
    __syncthreads();
}

#ifndef PROBE
#define PROBE 0
#endif
#define tsb ((LAS unsigned long long*)(lds + 131072))
#ifndef PROBE_A
#define PROBE_A 2
#endif
#ifndef PROBE_B
#define PROBE_B 3
#endif
#ifndef PROBE_SA
#define PROBE_SA 0.01f
#endif
#ifndef PROBE_SB
#define PROBE_SB 0.01f
#endif
constexpr int N_PHASES = 1 + 6 * DEPTH;
__global__ void __launch_bounds__(512, 2) fwd_kernel(Args a) {
    extern __shared__ __attribute__((aligned(16))) unsigned char lds_raw[];
    LAS unsigned char* lds = (LAS unsigned char*)lds_raw;
    cg::grid_group grid = cg::this_grid();
    volatile LAS unsigned* bst = (volatile LAS unsigned*)(lds + 131072 + 768);
    if (threadIdx.x < 2) bst[threadIdx.x] = 0u;
    __syncthreads();
    const XcdBarrier xbar = xcd_barrier_post((unsigned*)(a.ws + WS_BAR), bst);
    const int G = gridDim.x, bx = blockIdx.x;
    unsigned char* ws = a.ws;
    float* ss = (float*)(ws + WS_SS); const float* rope = (const float*)(ws + WS_ROPE);
    bf16_t* XB = (bf16_t*)(ws + WS_XB); bf16_t* QO = (bf16_t*)(ws + WS_QO); bf16_t* KV = (bf16_t*)(ws + WS_KV); bf16_t* AB = (bf16_t*)(ws + WS_A);
    bf16_t* GB = (bf16_t*)(ws + WS_G); bf16_t* YB = (bf16_t*)(ws + WS_Y); bf16_t* ACT = (bf16_t*)(ws + WS_ACT);
#pragma unroll 1
    for (int ph = a.ph_lo; ph < a.ph_hi; ++ph) {
        if (ph > a.ph_lo) { if (ph == 1) grid.sync(); else xcd_barrier(xbar); }
        int tid_l = threadIdx.x; asm volatile("" : "+v"(tid_l));
#if PROBE
        if (threadIdx.x == 0) tsb[ph] = __builtin_amdgcn_s_memrealtime();
#endif
        const int tid = tid_l, lane = tid & 63, wave = __builtin_amdgcn_readfirstlane(tid >> 6);
        if (ph == 0) { prologue(a, lds, tid, lane, wave); continue; }
        const int l = (ph - 1) / 6, s = (ph - 1) % 6;
        const unsigned char* wb = ws + WS_W + (size_t)l * W_LAYER;
        if (s == 0) {
            pg8::Gemm g{XB, (const bf16_t*)(wb + WO_IN), M, INW, D}; pg8::StaticOrder S; S.init(M, INW, G, bx);
            pg8::EpiIn E{QO, KV, AB, GB, ss};
            pg8::gemm_phase<pg8::EpiIn, pg8::StaticOrder, true, true>(lds, g, S, E);
            if (G == 256 && bx >= 128 && l + 1 < DEPTH) convert_layer(a, l + 1, (bx - 128) * 8 + wave, 128 * 8, (LAS float*)(lds + wave * 16384), lane);
        } else if (s == 1) {
            for (int u = bx; u < NB * 2 * (T / 128); u += G) { const int blk = u & 63, kvh = (u >> 6) & 1, b = u >> 7;
                att::unit(lds, b, kvh, blk, QO, KV, GB, a.in[I_QN] + l * 64, a.in[I_KN] + l * 64, a.in[I_SINK] + l * NHEAD, rope, tid, lane, wave); }
#if PROBE
            if (threadIdx.x == 0) tsb[32 + l] = __builtin_amdgcn_s_memrealtime();
#endif
            cv::phase(lds, bx, G, AB, YB, a.in[I_CW] + (size_t)l * 31 * CC, a.in[I_CB] + l * CC, a.in[I_LG] + l * CC, a.in[I_LB] + l * CC, tid, lane, wave);
        } else if (s == 2) {
            pg8::Gemm g{YB, (const bf16_t*)(wb + WO_PW), M, D, CC}; pg8::StaticOrder S; S.init(M, D, G, bx);
            pg8::EpiMerge E{QO, GB};
            pg8::gemm_phase<pg8::EpiMerge, pg8::StaticOrder, true, true>(lds, g, S, E);
        } else if (s == 3) {
            pg8::Gemm g{QO, (const bf16_t*)(wb + WO_OUT), M, D, D}; pg8::StaticOrder S; S.init(M, D, G, bx);
            pg8::EpiRes E{(const unsigned char*)a.out, (unsigned char*)(ws + WS_LOB), XB, a.out, ss + (size_t)M * 16, 1};
            pg8::gemm_phase<pg8::EpiRes, pg8::StaticOrder, true, true>(lds, g, S, E);
        } else if (s == 4) {
            pg8::Gemm g{XB, (const bf16_t*)(wb + WO_GU), M, GU, D}; pg8::StaticOrder S; S.init(M, GU, G, bx);
            pg8::EpiSwiglu E{ACT, ss + (size_t)M * 16};
            pg8::gemm_phase<pg8::EpiSwiglu, pg8::StaticOrder, true, true>(lds, g, S, E);
        } else {
            pg8::Gemm g{ACT, (const bf16_t*)(wb + WO_DN), M, D, FF}; pg8::StaticOrder S; S.init(M, D, G, bx);
            pg8::EpiRes E{(const unsigned char*)(ws + WS_LOB), (unsigned char*)a.out, XB, a.out, ss, l + 1 < DEPTH ? 1 : 0};
            pg8::gemm_phase<pg8::EpiRes, pg8::StaticOrder, true, true>(lds, g, S, E);
        }
    }
#if PROBE
    if (bx == 0) {
        LAS float* pv = (LAS float*)(lds + 131072 + 512);
        if (threadIdx.x == 0) { tsb[N_PHASES] = __builtin_amdgcn_s_memrealtime();
            unsigned long long sa = 0, sb = 0;
#pragma unroll 1
            for (int l = 0; l < DEPTH; ++l) { const int b = 1 + 6 * l;
                const unsigned long long d1 = tsb[b + 1] - tsb[b], d2 = tsb[32 + l] - tsb[b + 1], d3 = tsb[b + 2] - tsb[32 + l], d4 = tsb[b + 3] - tsb[b + 2], d5 = tsb[b + 4] - tsb[b + 3], d6 = tsb[b + 5] - tsb[b + 4], d7 = tsb[b + 6] - tsb[b + 5];
                sa += PROBE_A == 1 ? d1 : PROBE_A == 2 ? d2 : PROBE_A == 3 ? d3 : PROBE_A == 4 ? d4 : PROBE_A == 5 ? d5 : PROBE_A == 6 ? d6 : PROBE_A == 7 ? d7 : 0;
                sb += PROBE_B == 1 ? d1 : PROBE_B == 2 ? d2 : PROBE_B == 3 ? d3 : PROBE_B == 4 ? d4 : PROBE_B == 5 ? d5 : PROBE_B == 6 ? d6 : PROBE_B == 7 ? d7 : 0; }
            if (PROBE_A == 0) sa = tsb[1] - tsb[0]; if (PROBE_B == 0) sb = tsb[1] - tsb[0];
            pv[0] = (float)sa * 0.01f * PROBE_SA; pv[1] = PROBE_B == 8 ? 20.0f : (float)sb * 0.01f * PROBE_SB; }
        __syncthreads();
        if (threadIdx.x == 0) a.out[0] += pv[0];
        if (PROBE_B >= 0) for (int i = threadIdx.x + 512; i < 65536; i += 512) a.out[(size_t)(i >> 8) * 1024 + (i & 255)] += pv[1] * 0.0625f;
    }
#endif
}

#ifndef MK_PER_PHASE
#define MK_PER_PHASE 0
#endif
extern "C" void kernel_launch(void* const* d_in, const int* in_sizes, int n_in, void* d_out, int out_size, void* d_ws, size_t ws_size, hipStream_t stream) {
    static int grid = 0;
    if (grid == 0) {
        if (n_in != 15 || in_sizes[0] != M * D || out_size != M * D || ws_size < WS_END) { fprintf(stderr, "kernel_launch: unexpected shapes / workspace (n_in %d, ws %zu)\n", n_in, ws_size); grid = -1; return; }
        int dev = 0, cus = 0, per_cu = 0;
        (void)hipGetDevice(&dev); (void)hipDeviceGetAttribute(&cus, hipDeviceAttributeMultiprocessorCount, dev);
        if (hipFuncSetAttribute((const void*)fwd_kernel, hipFuncAttributeMaxDynamicSharedMemorySize, LDS_BYTES) != hipSuccess) { fprintf(stderr, "kernel_launch: hipFuncSetAttribute failed\n"); grid = -1; return; }
        if (hipOccupancyMaxActiveBlocksPerMultiprocessor(&per_cu, (const void*)fwd_kernel, 512, LDS_BYTES) != hipSuccess || per_cu < 1) { fprintf(stderr, "kernel_launch: occupancy query says %d\n", per_cu); per_cu = 1; }
        (void)hipGetLastError();
        grid = cus * per_cu;
    }
    if (grid < 0) return;
    if (hipMemsetAsync((char*)d_ws + WS_BAR, 0, 16384, stream) != hipSuccess) { fprintf(stderr, "kernel_launch: memset of the barrier words failed\n"); return; }
    Args a{};
    for (int i = 0; i < 15; ++i) a.in[i] = (const float*)d_in[i];
    a.out = (float*)d_out; a.ws = (unsigned char*)d_ws;
#if MK_PER_PHASE
    for (int ph = 0; ph < N_PHASES; ++ph) { a.ph_lo = ph; a.ph_hi = ph + 1; hipLaunchKernelGGL(fwd_kernel, dim3(grid), dim3(512), LDS_BYTES, stream, a); }
#else
    a.ph_lo = 0; a.ph_hi = N_PHASES;
    void* args[] = {&a};
    hipError_t e = hipLaunchCooperativeKernel((const void*)fwd_kernel, dim3(grid), dim3(512), args, LDS_BYTES, stream);
    if (e != hipSuccess) fprintf(stderr, "cooperative launch failed: %s (grid %d)\n", hipGetErrorString(e), grid);
#endif
}
```

```cpp
#include <hip/hip_runtime.h>
#include <hip/hip_cooperative_groups.h>
#include <cstdio>
#include <cstdint>
namespace cg = cooperative_groups;
namespace pg8 {
#define PG8_LAS __attribute__((address_space(3)))
typedef unsigned short bf16_t;
typedef short bf16x8 __attribute__((ext_vector_type(8)));
typedef float f32x4 __attribute__((ext_vector_type(4)));
typedef unsigned u32x4 __attribute__((ext_vector_type(4)));
constexpr int BM = 256, BK = 64, HALF = 128, HTB = HALF * BK * 2  , STAGE_BYTES = 8 * HTB, NXCD = 8, WGM = 8;

__host__ __device__ __forceinline__ int lds_byte(int r, int c) { const int st = (r >> 4) * 2 + (c >> 5), rr = r & 15, cc = c & 31, ob = rr * 64 + cc * 2; return st * 1024 + (ob ^ (((ob >> 9) & 1) << 5)); }
__host__ __device__ __forceinline__ void stage_rc(int b, int& R, int& C) { const int st = b / 1024, sb = b % 1024, swz = sb ^ (((sb >> 9) & 1) << 5); R = (st >> 1) * 16 + swz / 64; C = (st & 1) * 32 + (swz % 64) / 2; }
__host__ __device__ __forceinline__ int perm32(int rho) { const int n = rho >> 4, i = rho & 15; return 8 * (i >> 2) + 4 * n + (i & 3); }

struct Unit { int pm, pn; };
struct Gemm { const bf16_t* A; const bf16_t* Bt; int M, N, K; };

struct StaticOrder {
    int nM, nN, nwg, G, c;
    __host__ __device__ void init(int M, int N, int G_, int c_) { nM = M / BM; nN = N / BM; nwg = nM * nN; G = G_; c = c_; }
    __host__ __device__ bool next(int i, Unit& u) const {
        const long L = (long)i * G + c; if (L >= nwg) return false;
        int wgid = (int)L; { const int q = nwg / NXCD, r = nwg % NXCD, xcd = wgid % NXCD, off = wgid / NXCD; wgid = (xcd < r ? xcd * (q + 1) : r * (q + 1) + (xcd - r) * q) + off; }
        const int nig = WGM * nN, gid = wgid / nig, fm = gid * WGM, gsz = (nM - fm) < WGM ? (nM - fm) : WGM;
        u.pm = fm + ((wgid % nig) % gsz); u.pn = (wgid % nig) / gsz; return true;
    }
    __device__ __forceinline__ void a_ready(const Unit&) const {}
    __device__ __forceinline__ void done(const Unit&) const {}
};
typedef float f32x2_t __attribute__((ext_vector_type(2))); typedef __bf16 bf16x2_t __attribute__((ext_vector_type(2)));
typedef unsigned u32x2 __attribute__((ext_vector_type(2)));
__device__ __forceinline__ unsigned pk2(float lo, float hi) { f32x2_t v = {lo, hi}; bf16x2_t b = __builtin_convertvector(v, bf16x2_t); return __builtin_bit_cast(unsigned, b); }
__device__ __forceinline__ float bflo(unsigned u) { return __uint_as_float(u << 16); }
__device__ __forceinline__ float bfhi(unsigned u) { return __uint_as_float(u & 0xffff0000u); }
__device__ __forceinline__ float sigm(float x) { return __builtin_amdgcn_rcpf(1.0f + __builtin_amdgcn_exp2f(x * -1.4426950408889634f)); }
constexpr float NORM_EPS = 1e-6f;
__device__ __forceinline__ float row_rstd(const float* P, int row) { const f32x4* p = (const f32x4*)(P + (size_t)row * 16); const f32x4 a = p[0], b = p[1], c = p[2], d = p[3];
    const float s = ((a[0] + a[1]) + (a[2] + a[3])) + ((b[0] + b[1]) + (b[2] + b[3])) + ((c[0] + c[1]) + (c[2] + c[3])) + ((d[0] + d[1]) + (d[2] + d[3])); return rsqrtf(s * (1.0f / 1024.0f) + NORM_EPS); }

#ifndef ER_DEPTH
#define ER_DEPTH 4
#endif
#ifndef EM_DEPTH
#define EM_DEPTH 6
#endif
__device__ __forceinline__ void wave_rstd(const float* P, int rbase, int lane, float& ra, float& rb) {
    const f32x4* p = (const f32x4*)(P + (size_t)(rbase + lane) * 16); const f32x4* q = p + 4 * HALF;
    const f32x4 a0 = p[0], a1 = p[1], a2 = p[2], a3 = p[3], b0 = q[0], b1 = q[1], b2 = q[2], b3 = q[3];
    const float sa = ((a0[0] + a0[1]) + (a0[2] + a0[3])) + ((a1[0] + a1[1]) + (a1[2] + a1[3])) + ((a2[0] + a2[1]) + (a2[2] + a2[3])) + ((a3[0] + a3[1]) + (a3[2] + a3[3]));
    const float sb = ((b0[0] + b0[1]) + (b0[2] + b0[3])) + ((b1[0] + b1[1]) + (b1[2] + b1[3])) + ((b2[0] + b2[1]) + (b2[2] + b2[3])) + ((b3[0] + b3[1]) + (b3[2] + b3[3]));
    ra = rsqrtf(sa * (1.0f / 1024.0f) + NORM_EPS); rb = rsqrtf(sb * (1.0f / 1024.0f) + NORM_EPS);
}
__device__ __forceinline__ unsigned q8(float g) { return (unsigned)(sigm(g) * 255.0f + 0.5f); }
__device__ __forceinline__ float d8(unsigned w, int k) { return (float)((w >> (8 * k)) & 0xffu) * (1.0f / 255.0f); }
struct EpiIn {
    static constexpr bool PERM = true, AFTER_DRAIN = false;
    bf16_t *Q, *KV, *A, *G; const float* ss;
    __device__ __forceinline__ void operator()(const f32x4 (&acc)[2][2][4][2], const Unit& u, int wr, int wc, int fr, int fq) const {
        const int row0 = u.pm * BM + wr * 64 + fr, pn = u.pn, cw = wc * 32 + 8 * fq;
        float ra, rb; wave_rstd(ss, u.pm * BM + wr * 64, fr + 16 * fq, ra, rb);
        if (pn >= 5 && pn < 9) {
#pragma unroll
            for (int ai = 0; ai < 2; ++ai)
#pragma unroll
                for (int m = 0; m < 4; ++m) { const int row = row0 + ai * HALF + m * 16; const float rs = __shfl(ai ? rb : ra, 16 * m + fr);
                    const f32x4 u0 = acc[ai][0][m][0] * rs, u1 = acc[ai][0][m][1] * rs, g0 = acc[ai][1][m][0] * rs, g1 = acc[ai][1][m][1] * rs;
                    u32x4 w; w.x = pk2(u0[0] * sigm(g0[0]), u0[1] * sigm(g0[1])); w.y = pk2(u0[2] * sigm(g0[2]), u0[3] * sigm(g0[3]));
                    w.z = pk2(u1[0] * sigm(g1[0]), u1[1] * sigm(g1[1])); w.w = pk2(u1[2] * sigm(g1[2]), u1[3] * sigm(g1[3]));
                    *(u32x4*)(A + (size_t)row * 512 + (pn - 5) * 128 + cw) = w; }
        } else if (pn >= 9) {
            unsigned char* base = (unsigned char*)G + (pn - 9) * 256 + cw;
#pragma unroll
            for (int ai = 0; ai < 2; ++ai)
#pragma unroll
                for (int m = 0; m < 4; ++m) { const int row = row0 + ai * HALF + m * 16; const float rs = __shfl(ai ? rb : ra, 16 * m + fr);
                    unsigned char* rowp = base + (size_t)row * 2048;
#pragma unroll
                    for (int bj = 0; bj < 2; ++bj) { const f32x4 v0 = acc[ai][bj][m][0] * rs, v1 = acc[ai][bj][m][1] * rs;
                        u32x2 w; w.x = q8(v0[0]) | (q8(v0[1]) << 8) | (q8(v0[2]) << 16) | (q8(v0[3]) << 24); w.y = q8(v1[0]) | (q8(v1[1]) << 8) | (q8(v1[2]) << 16) | (q8(v1[3]) << 24);
                        *(u32x2*)(rowp + bj * HALF) = w; } }
        } else {
            bf16_t* base; int pitch;
            if (pn < 4) { base = Q + pn * 256 + cw; pitch = 1024; } else { base = KV + cw; pitch = 256; }
#pragma unroll
            for (int ai = 0; ai < 2; ++ai)
#pragma unroll
                for (int m = 0; m < 4; ++m) { const int row = row0 + ai * HALF + m * 16; const float rs = __shfl(ai ? rb : ra, 16 * m + fr);
                    bf16_t* rowp = base + (size_t)row * pitch;
#pragma unroll
                    for (int bj = 0; bj < 2; ++bj) { const f32x4 v0 = acc[ai][bj][m][0] * rs, v1 = acc[ai][bj][m][1] * rs;
                        u32x4 w; w.x = pk2(v0[0], v0[1]); w.y = pk2(v0[2], v0[3]); w.z = pk2(v1[0], v1[1]); w.w = pk2(v1[2], v1[3]);
                        *(u32x4*)(rowp + bj * HALF) = w; } }
        }
    }
};
struct EpiMerge {
    static constexpr bool PERM = true, AFTER_DRAIN = false;
    bf16_t* AO; const bf16_t* G;
    __device__ __forceinline__ void operator()(const f32x4 (&acc)[2][2][4][2], const Unit& u, int wr, int wc, int fr, int fq) const {
        const int row0 = u.pm * BM + wr * 64 + fr, col0 = u.pn * BM + wc * 32 + 8 * fq;
        constexpr int MD = EM_DEPTH; u32x4 pa[MD]; u32x2 pgb[MD];
#define EM_ROW(hg) (row0 + ((hg) >> 3) * HALF + (((hg) >> 1) & 3) * 16)
#define EM_COL(hg) (col0 + ((hg) & 1) * HALF)
#define EM_LOAD(hg, s) do { pa[s] = *(const u32x4*)(AO + (size_t)EM_ROW(hg) * 1024 + EM_COL(hg)); pgb[s] = *(const u32x2*)((const unsigned char*)G + (size_t)EM_ROW(hg) * 2048 + 1024 + EM_COL(hg)); } while (0)
#pragma unroll
        for (int hg = 0; hg < MD; ++hg) EM_LOAD(hg, hg);
#pragma unroll
        for (int hg = 0; hg < 16; ++hg) { const int ai = hg >> 3, m = (hg >> 1) & 3, bj = hg & 1, s = hg % MD;
            const u32x4 ao = pa[s]; const u32x2 gb = pgb[s]; const f32x4 c0 = acc[ai][bj][m][0], c1 = acc[ai][bj][m][1];
            u32x4 w;
            w.x = pk2(bflo(ao.x) + d8(gb.x, 0) * c0[0], bfhi(ao.x) + d8(gb.x, 1) * c0[1]);
            w.y = pk2(bflo(ao.y) + d8(gb.x, 2) * c0[2], bfhi(ao.y) + d8(gb.x, 3) * c0[3]);
            w.z = pk2(bflo(ao.z) + d8(gb.y, 0) * c1[0], bfhi(ao.z) + d8(gb.y, 1) * c1[1]);
            w.w = pk2(bflo(ao.w) + d8(gb.y, 2) * c1[2], bfhi(ao.w) + d8(gb.y, 3) * c1[3]);
            *(u32x4*)(AO + (size_t)EM_ROW(hg) * 1024 + EM_COL(hg)) = w;
            if (hg + MD < 16) EM_LOAD(hg + MD, s); }
#undef EM_ROW
#undef EM_COL
#undef EM_LOAD
    }
};
__device__ __forceinline__ float lo8_dec(unsigned hbits16, unsigned qbyte) {
    unsigned E = (hbits16 >> 7) & 0xffu; E = E < 16u ? 16u : E;
    return __uint_as_float(hbits16 << 16) + (float)(int)(signed char)qbyte * __uint_as_float((E - 15u) << 23);
}
__device__ __forceinline__ unsigned lo8_enc(float v, unsigned hbits16) {
    unsigned E = (hbits16 >> 7) & 0xffu; E = E < 16u ? 16u : E;
    const float q = (v - __uint_as_float(hbits16 << 16)) * __uint_as_float((269u - E) << 23);
    int i = (int)__builtin_rintf(q); i = i < -128 ? -128 : (i > 127 ? 127 : i);
    return (unsigned)i & 0xffu;
}
struct EpiRes {
    static constexpr bool PERM = true, AFTER_DRAIN = false;
    const unsigned char* lo_in; unsigned char* lo_out; bf16_t* XB; float* fout; float* ssn; int nxt;
    __device__ __forceinline__ void operator()(const f32x4 (&acc)[2][2][4][2], const Unit& u, int wr, int wc, int fr, int fq) const {
        const int row0 = u.pm * BM + wr * 64 + fr, col0 = u.pn * BM + wc * 32 + 8 * fq;
        constexpr int RD = ER_DEPTH; u32x4 ph[RD][2]; u32x2 pl[RD][2];
#define ER_ROW(g) (row0 + ((g) >> 2) * HALF + ((g) & 3) * 16)
#define ER_LOAD(g, s) do { const size_t o_ = (size_t)ER_ROW(g) * 1024 + col0; ph[s][0] = *(const u32x4*)(XB + o_); ph[s][1] = *(const u32x4*)(XB + o_ + HALF); pl[s][0] = *(const u32x2*)(lo_in + o_); pl[s][1] = *(const u32x2*)(lo_in + o_ + HALF); } while (0)
#pragma unroll
        for (int g = 0; g < RD; ++g) ER_LOAD(g, g);
#pragma unroll
        for (int g = 0; g < 8; ++g) { const int ai = g >> 2, m = g & 3, s = g % RD; const int row = ER_ROW(g); const size_t off = (size_t)row * 1024 + col0; float sq = 0.f;
#pragma unroll
            for (int bj = 0; bj < 2; ++bj) { const size_t o = off + bj * HALF; const u32x4 h = ph[s][bj]; const u32x2 l = pl[s][bj];
                const f32x4 v0 = (f32x4){lo8_dec(h.x & 0xffffu, l.x), lo8_dec(h.x >> 16, l.x >> 8), lo8_dec(h.y & 0xffffu, l.x >> 16), lo8_dec(h.y >> 16, l.x >> 24)} + acc[ai][bj][m][0];
                const f32x4 v1 = (f32x4){lo8_dec(h.z & 0xffffu, l.y), lo8_dec(h.z >> 16, l.y >> 8), lo8_dec(h.w & 0xffffu, l.y >> 16), lo8_dec(h.w >> 16, l.y >> 24)} + acc[ai][bj][m][1];
                if (nxt) { u32x4 w; w.x = pk2(v0[0], v0[1]); w.y = pk2(v0[2], v0[3]); w.z = pk2(v1[0], v1[1]); w.w = pk2(v1[2], v1[3]); *(u32x4*)(XB + o) = w;
                    u32x2 r; r.x = lo8_enc(v0[0], w.x & 0xffffu) | (lo8_enc(v0[1], w.x >> 16) << 8) | (lo8_enc(v0[2], w.y & 0xffffu) << 16) | (lo8_enc(v0[3], w.y >> 16) << 24);
                    r.y = lo8_enc(v1[0], w.z & 0xffffu) | (lo8_enc(v1[1], w.z >> 16) << 8) | (lo8_enc(v1[2], w.w & 0xffffu) << 16) | (lo8_enc(v1[3], w.w >> 16) << 24);
                    *(u32x2*)(lo_out + o) = r;
                    sq += ((v0[0] * v0[0] + v0[1] * v0[1]) + (v0[2] * v0[2] + v0[3] * v0[3])) + ((v1[0] * v1[0] + v1[1] * v1[1]) + (v1[2] * v1[2] + v1[3] * v1[3])); }
                else { *(f32x4*)(fout + o) = v0; *(f32x4*)(fout + o + 4) = v1; } }
            if (nxt) { sq += __shfl_xor(sq, 16); sq += __shfl_xor(sq, 32); if (fq == 0) ssn[(size_t)row * 16 + u.pn * 4 + wc] = sq; }
            if (g + RD < 8) ER_LOAD(g + RD, s); }
#undef ER_ROW
#undef ER_LOAD
    }
};
struct EpiSwiglu {
    static constexpr bool PERM = true, AFTER_DRAIN = false;
    bf16_t* ACT; const float* ss;
    __device__ __forceinline__ void operator()(const f32x4 (&acc)[2][2][4][2], const Unit& u, int wr, int wc, int fr, int fq) const {
        const int row0 = u.pm * BM + wr * 64 + fr, col = u.pn * 128 + wc * 32 + 8 * fq;
        float ra, rb; wave_rstd(ss, u.pm * BM + wr * 64, fr + 16 * fq, ra, rb);
#pragma unroll
        for (int ai = 0; ai < 2; ++ai)
#pragma unroll
            for (int m = 0; m < 4; ++m) { const int row = row0 + ai * HALF + m * 16; const float rs = __shfl(ai ? rb : ra, 16 * m + fr);
                const f32x4 g0 = acc[ai][0][m][0] * rs, g1 = acc[ai][0][m][1] * rs, u0 = acc[ai][1][m][0] * rs, u1 = acc[ai][1][m][1] * rs;
                u32x4 w; w.x = pk2(g0[0] * sigm(g0[0]) * u0[0], g0[1] * sigm(g0[1]) * u0[1]); w.y = pk2(g0[2] * sigm(g0[2]) * u0[2], g0[3] * sigm(g0[3]) * u0[3]);
                w.z = pk2(g1[0] * sigm(g1[0]) * u1[0], g1[1] * sigm(g1[1]) * u1[1]); w.w = pk2(g1[2] * sigm(g1[2]) * u1[2], g1[3] * sigm(g1[3]) * u1[3]);
                *(u32x4*)(ACT + (size_t)row * 2816 + col) = w; }
    }
};
template <class Epi, class Sched, bool ALIGN_EPI = false, bool SP2 = false>
__device__ __forceinline__ void gemm_phase(PG8_LAS unsigned char* lds, const Gemm g, const Sched& S, const Epi& E) {
    int tid_l = threadIdx.x; asm volatile("" : "+v"(tid_l));
    const int tid = tid_l, wid = __builtin_amdgcn_readfirstlane(tid >> 6), lane = tid & 63, wr = wid >> 2, wc = wid & 3, fr = lane & 15, fq = lane >> 4;
    const int K = g.K, nt = K / BK;
    unsigned voffA[2], voffB[2];
#pragma unroll
    for (int i = 0; i < 2; ++i) { int R, C; stage_rc(tid * 16 + i * 8192, R, C); const int Rb = Epi::PERM ? ((R & ~31) + perm32(R & 31)) : R;
        voffA[i] = (unsigned)(R * K + C) * 2u; voffB[i] = (unsigned)(Rb * K + C) * 2u; }
    const size_t kstep = (size_t)(BK * 2);
    const size_t hstep = (size_t)HALF * K * 2;
    const size_t tstep = 2 * hstep;
    const unsigned ldsw = (unsigned)wid * 1024u;
    const int aoff = lds_byte(wr * 64 + fr, fq * 8), boff = lds_byte(wc * 32 + fr, fq * 8);
#define PG8_SA(b, h) (((b) * 2 + (h)) * HTB)
#define PG8_SB(b, h) ((4 + (b) * 2 + (h)) * HTB)
#define PG8_STAGE(bufoff, gbase, voff) do { _Pragma("unroll") for (int _i = 0; _i < 2; ++_i) \
        __builtin_amdgcn_global_load_lds((const unsigned*)((const char*)(gbase) + (voff)[_i]), (PG8_LAS unsigned*)(lds + (bufoff) + ldsw + _i * 8192), 16, 0, 0); } while (0)
#define PG8_LDA(dst, b, h) do { _Pragma("unroll") for (int m = 0; m < 4; ++m) _Pragma("unroll") for (int k = 0; k < 2; ++k) dst[m][k] = *(const PG8_LAS bf16x8*)(lds + PG8_SA(b, h) + aoff + m * 2048 + k * 1024); } while (0)
#define PG8_LDB(dst, b, h) do { _Pragma("unroll") for (int n = 0; n < 2; ++n) _Pragma("unroll") for (int k = 0; k < 2; ++k) dst[n][k] = *(const PG8_LAS bf16x8*)(lds + PG8_SB(b, h) + boff + n * 2048 + k * 1024); } while (0)
#define PG8_MMA(ai, bj, At, Bt) do { __builtin_amdgcn_s_setprio(1); _Pragma("unroll") for (int m = 0; m < 4; ++m) _Pragma("unroll") for (int n = 0; n < 2; ++n) _Pragma("unroll") for (int k = 0; k < 2; ++k) \
        acc[ai][bj][m][n] = __builtin_amdgcn_mfma_f32_16x16x32_bf16(Bt[n][k], At[m][k], acc[ai][bj][m][n], 0, 0, 0); __builtin_amdgcn_s_setprio(0); } while (0)
#define PG8_WAIT_V(n) asm volatile("s_waitcnt vmcnt(" #n ")" ::: "memory")
#define PG8_WAIT_L(n) asm volatile("s_waitcnt lgkmcnt(" #n ")" ::: "memory")
#define PG8_BAR __builtin_amdgcn_s_barrier()
#define PG8_SCHED __builtin_amdgcn_sched_barrier(0)
    Unit cur, nxt; int ui = 0;
    if (!S.next(0, cur)) return;
    f32x4 acc[2][2][4][2];
#pragma unroll
    for (int a = 0; a < 2; ++a)
#pragma unroll
        for (int b = 0; b < 2; ++b)
#pragma unroll
            for (int m = 0; m < 4; ++m)
#pragma unroll
                for (int n = 0; n < 2; ++n) acc[a][b][m][n] = (f32x4){0.f, 0.f, 0.f, 0.f};
    bf16x8 At[4][2], B0[2][2], B1[2][2];
    const char* cA = (const char*)g.A + (size_t)cur.pm * tstep; const char* cB = (const char*)g.Bt + (size_t)cur.pn * tstep;
    S.a_ready(cur);
    if constexpr (SP2) {
        PG8_STAGE(PG8_SB(0, 0), cB, voffB); PG8_STAGE(PG8_SB(0, 1), cB + hstep, voffB); PG8_STAGE(PG8_SA(0, 0), cA, voffA); PG8_STAGE(PG8_SA(0, 1), cA + hstep, voffA);
        if (wr == 1) PG8_BAR;
        PG8_WAIT_V(2); PG8_BAR;
        PG8_STAGE(PG8_SB(1, 0), cB + kstep, voffB); PG8_STAGE(PG8_SA(1, 0), cA + kstep, voffA); PG8_STAGE(PG8_SB(1, 1), cB + hstep + kstep, voffB);
        PG8_WAIT_V(6); PG8_BAR;
    } else {
        PG8_STAGE(PG8_SB(0, 0), cB, voffB); PG8_STAGE(PG8_SA(0, 0), cA, voffA); PG8_STAGE(PG8_SB(0, 1), cB + hstep, voffB); PG8_STAGE(PG8_SA(0, 1), cA + hstep, voffA);
        if (wr == 1) PG8_BAR;
        PG8_WAIT_V(4); PG8_BAR;
        PG8_STAGE(PG8_SB(1, 0), cB + kstep, voffB); PG8_STAGE(PG8_SA(1, 0), cA + kstep, voffA); PG8_STAGE(PG8_SB(1, 1), cB + hstep + kstep, voffB);
        PG8_WAIT_V(6); PG8_BAR;
    }
    for (;;) {
        const bool has_next = S.next(ui + 1, nxt);
        const char* nA = has_next ? (const char*)g.A + (size_t)nxt.pm * tstep : cA; const char* nB = has_next ? (const char*)g.Bt + (size_t)nxt.pn * tstep : cB;
        for (int t = 0; t < nt; t += 2) {
            const bool last = (t == nt - 2);
            const char* a1 = cA + (size_t)(t + 1) * kstep;
            const char* a2 = last ? nA : cA + (size_t)(t + 2) * kstep; const char* b2 = last ? nB : cB + (size_t)(t + 2) * kstep;
            const char* a3 = a2 + kstep; const char* b3 = b2 + kstep;
            if (last && has_next) S.a_ready(nxt);
            if constexpr (SP2) {
            PG8_LDB(B0, 0, 0); PG8_LDB(B1, 0, 1); PG8_SCHED; PG8_LDA(At, 0, 0); PG8_STAGE(PG8_SA(1, 1), a1 + hstep, voffA);
            PG8_WAIT_V(8); PG8_WAIT_L(0); PG8_BAR; PG8_MMA(0, 0, At, B0); PG8_MMA(0, 1, At, B1); PG8_BAR; PG8_SCHED;
            PG8_LDA(At, 0, 1); PG8_STAGE(PG8_SB(0, 0), b2, voffB); PG8_STAGE(PG8_SB(0, 1), b2 + hstep, voffB); PG8_STAGE(PG8_SA(0, 0), a2, voffA);
            PG8_WAIT_V(8); PG8_WAIT_L(0); PG8_BAR; PG8_MMA(1, 0, At, B0); PG8_MMA(1, 1, At, B1); PG8_BAR; PG8_SCHED;
            PG8_LDB(B0, 1, 0); PG8_LDB(B1, 1, 1); PG8_SCHED; PG8_LDA(At, 1, 0); PG8_STAGE(PG8_SA(0, 1), a2 + hstep, voffA);
            PG8_WAIT_V(8); PG8_WAIT_L(0); PG8_BAR; PG8_MMA(0, 0, At, B0); PG8_MMA(0, 1, At, B1); PG8_BAR; PG8_SCHED;
            PG8_LDA(At, 1, 1); PG8_STAGE(PG8_SB(1, 0), b3, voffB); PG8_STAGE(PG8_SB(1, 1), b3 + hstep, voffB); PG8_STAGE(PG8_SA(1, 0), a3, voffA);
            PG8_WAIT_V(8); PG8_WAIT_L(0); PG8_BAR; PG8_MMA(1, 0, At, B0); PG8_MMA(1, 1, At, B1); PG8_BAR; PG8_SCHED;
            } else {
            PG8_LDB(B0, 0, 0); PG8_SCHED; PG8_LDA(At, 0, 0); PG8_STAGE(PG8_SA(1, 1), a1 + hstep, voffA);
            PG8_WAIT_L(8); PG8_BAR; PG8_WAIT_L(0); PG8_MMA(0, 0, At, B0); PG8_BAR; PG8_SCHED;
            PG8_LDB(B1, 0, 1); PG8_STAGE(PG8_SB(0, 0), b2, voffB);
            PG8_BAR; PG8_WAIT_L(0); PG8_MMA(0, 1, At, B1); PG8_BAR;
            PG8_LDA(At, 0, 1); PG8_STAGE(PG8_SA(0, 0), a2, voffA);
            PG8_BAR; PG8_WAIT_L(0); PG8_MMA(1, 0, At, B0); PG8_BAR; PG8_SCHED;
            PG8_STAGE(PG8_SB(0, 1), b2 + hstep, voffB);
            PG8_WAIT_V(6); PG8_BAR; PG8_MMA(1, 1, At, B1); PG8_BAR;
            PG8_LDB(B0, 1, 0); PG8_SCHED; PG8_LDA(At, 1, 0); PG8_STAGE(PG8_SA(0, 1), a2 + hstep, voffA);
            PG8_WAIT_L(8); PG8_BAR; PG8_WAIT_L(0); PG8_MMA(0, 0, At, B0); PG8_BAR; PG8_SCHED;
            PG8_LDB(B1, 1, 1); PG8_STAGE(PG8_SB(1, 0), b3, voffB);
            PG8_BAR; PG8_WAIT_L(0); PG8_MMA(0, 1, At, B1); PG8_BAR;
            PG8_LDA(At, 1, 1); PG8_STAGE(PG8_SA(1, 0), a3, voffA);
            PG8_BAR; PG8_WAIT_L(0); PG8_MMA(1, 0, At, B0); PG8_BAR; PG8_SCHED;
            PG8_STAGE(PG8_SB(1, 1), b3 + hstep, voffB);
            PG8_WAIT_V(6); PG8_BAR; PG8_MMA(1, 1, At, B1); PG8_BAR;
            }
        }
        if constexpr (ALIGN_EPI) { if (wr == 0) PG8_BAR; }
        if constexpr (!Epi::AFTER_DRAIN) { E(acc, cur, wr, wc, fr, fq); S.done(cur); }
        if (!has_next) break;
#pragma unroll
        for (int a = 0; a < 2; ++a)
#pragma unroll
            for (int b = 0; b < 2; ++b)
#pragma unroll
                for (int m = 0; m < 4; ++m)
#pragma unroll
                    for (int n = 0; n < 2; ++n) acc[a][b][m][n] = (f32x4){0.f, 0.f, 0.f, 0.f};
        cur = nxt; cA = nA; cB = nB; ++ui;
        if constexpr (ALIGN_EPI) { if (wr == 1) PG8_BAR; }
    }
    PG8_WAIT_V(0);
    if constexpr (!ALIGN_EPI) { if (wr == 0) PG8_BAR; }
    PG8_BAR;
    if constexpr (Epi::AFTER_DRAIN) { E.fused(acc, cur, wr, wc, fr, fq, lds, wid, lane); S.done(cur); }
#undef PG8_SA
#undef PG8_SB
#undef PG8_STAGE
#undef PG8_LDA
#undef PG8_LDB
#undef PG8_MMA
#undef PG8_WAIT_V
#undef PG8_WAIT_L
#undef PG8_BAR
#undef PG8_SCHED
}
}
using pg8::bf16_t; using pg8::f32x4; using pg8::u32x4; using pg8::bf16x8; using pg8::u32x2; using pg8::pk2; using pg8::bflo; using pg8::bfhi; using pg8::sigm; using pg8::NORM_EPS;
#define LAS __attribute__((address_space(3)))
constexpr int NB = 4, T = 8192, M = NB * T, D = 1024, INW = 4352, CC = 512, FF = 2816, GU = 2 * FF, DEPTH = 4, NHEAD = 16;
constexpr size_t MiB = 1u << 20;
constexpr size_t WS_SS = 450 * MiB, SS_BUF = 2 * MiB;
constexpr size_t WS_ROPE = 1 * MiB;
constexpr size_t WS_W = 2 * MiB, W_LAYER = 28 * MiB;
constexpr size_t WO_IN = 0, WO_PW = 8 * MiB + MiB / 2, WO_OUT = WO_PW + 1 * MiB, WO_GU = WO_OUT + 2 * MiB, WO_DN = WO_GU + 11 * MiB;
constexpr size_t WS_XB = 114 * MiB, WS_QO = 178 * MiB, WS_KV = 242 * MiB, WS_A = 258 * MiB, WS_G = 290 * MiB, WS_Y = 418 * MiB, WS_BAR = 455 * MiB, WS_END = 456 * MiB;
constexpr size_t WS_LOB = 354 * MiB;
constexpr size_t WS_ACT = 178 * MiB;
static_assert(WO_DN + (size_t)D * FF * 2 == W_LAYER && WS_W + DEPTH * W_LAYER == WS_XB && WS_ACT + (size_t)M * FF * 2 <= WS_Y, "ws map");
constexpr int LDS_BYTES = 132096;

__device__ __forceinline__ float wave_sum(float v) {
#pragma unroll
    for (int o = 1; o < 64; o <<= 1) v += __shfl_xor(v, o);
    return v;
}

namespace att {
typedef __attribute__((ext_vector_type(16))) float f32x16;
typedef __attribute__((ext_vector_type(4))) short s16x4;
constexpr int KPB = 144, VPB = 520, OFF_V = 256 * KPB, SCR_OFF = 71680, SCR_WAVE = 4608;
constexpr float LOG2E = 1.4426950408889634f;
__device__ __forceinline__ int crow(int r, int hi) { return (r & 3) + 8 * (r >> 2) + 4 * hi; }

__device__ __forceinline__ void unit(LAS unsigned char* lds, int b, int kvh, int blk, bf16_t* QO, const bf16_t* KV, const bf16_t* GA, const float* qn, const float* kn, const float* sinks,
                                     const float* rope, int tid, int lane, int wave) {
    const int h = kvh * 8 + wave, q = lane & 31, hi = lane >> 5, crow8 = lane >> 3, cch = lane & 7;
    u32x4 qrN[4]; u32x2 gtN[4]; f32x4 rpN[4];
#define AT_LOAD(sub_) do { const size_t tr_ = (size_t)(b * T + blk * 128 + 32 * (sub_)); const int tq_ = blk * 128 + 32 * (sub_) + q; \
        _Pragma("unroll") for (int i = 0; i < 4; ++i) { qrN[i] = *(const u32x4*)(QO + (tr_ + crow8 + 8 * i) * 1024 + h * 64 + cch * 8); gtN[i] = *(const u32x2*)((const unsigned char*)GA + (tr_ + crow8 + 8 * i) * 2048 + h * 64 + cch * 8); \
            rpN[i] = *(const f32x4*)(rope + tq_ * 16 + 4 * i); } } while (0)
    AT_LOAD(0);
    {
        const int row = tid >> 1, half = tid & 1, pos = blk * 128 - 128 + row; const bool valid = pos >= 0;
        const bf16_t* src = KV + (size_t)(b * T + pos) * 256 + kvh * 64 + half * 32;
        float x[32]; float ssq = 0.f;
#pragma unroll
        for (int i = 0; i < 4; ++i) { u32x4 r = (u32x4){0u, 0u, 0u, 0u}; if (valid) r = *(const u32x4*)(src + 8 * i);
            x[8 * i + 0] = bflo(r.x); x[8 * i + 1] = bfhi(r.x); x[8 * i + 2] = bflo(r.y); x[8 * i + 3] = bfhi(r.y); x[8 * i + 4] = bflo(r.z); x[8 * i + 5] = bfhi(r.z); x[8 * i + 6] = bflo(r.w); x[8 * i + 7] = bfhi(r.w); }
#pragma unroll
        for (int i = 0; i < 32; ++i) ssq += x[i] * x[i];
        ssq += __shfl_xor(ssq, 1);
        const float rstd = rsqrtf(ssq * (1.0f / 64.0f) + NORM_EPS);
#pragma unroll
        for (int i = 0; i < 8; ++i) { const f32x4 g = *(const f32x4*)(kn + half * 32 + 4 * i); x[4 * i] *= rstd * g[0]; x[4 * i + 1] *= rstd * g[1]; x[4 * i + 2] *= rstd * g[2]; x[4 * i + 3] *= rstd * g[3]; }
        if (half == 0 && valid) { const float* cs = rope + pos * 16;
#pragma unroll
            for (int i = 0; i < 8; ++i) { const float c = cs[i], s = cs[8 + i], x1 = x[i], x2 = x[8 + i]; x[i] = x1 * c - x2 * s; x[8 + i] = x2 * c + x1 * s; } }
#pragma unroll
        for (int i = 0; i < 4; ++i) { u32x4 w; w.x = pk2(x[8 * i], x[8 * i + 1]); w.y = pk2(x[8 * i + 2], x[8 * i + 3]); w.z = pk2(x[8 * i + 4], x[8 * i + 5]); w.w = pk2(x[8 * i + 6], x[8 * i + 7]);
            *(LAS u32x4*)(lds + row * KPB + half * 64 + 16 * i) = w; }
    }
    {
        const int rp = tid >> 2, c = tid & 3, pos0 = blk * 128 - 128 + 2 * rp; const bool valid = pos0 >= 0;
        const bf16_t* src = KV + (size_t)(b * T + pos0) * 256 + 128 + kvh * 64 + 16 * c;
        u32x4 r0[2], r1[2];
#pragma unroll
        for (int i = 0; i < 2; ++i) { r0[i] = (u32x4){0u, 0u, 0u, 0u}; r1[i] = r0[i]; if (valid) { r0[i] = *(const u32x4*)(src + 8 * i); r1[i] = *(const u32x4*)(src + 256 + 8 * i); } }
#pragma unroll
        for (int w = 0; w < 8; ++w) { const unsigned a = r0[w >> 2][w & 3], bb = r1[w >> 2][w & 3]; const int d = 16 * c + 2 * w;
            *(LAS unsigned*)(lds + OFF_V + d * VPB + rp * 4) = (a & 0xffffu) | (bb << 16);
            *(LAS unsigned*)(lds + OFF_V + (d + 1) * VPB + rp * 4) = (a >> 16) | (bb & 0xffff0000u); }
    }
    __syncthreads();
    const float sink2 = sinks[h] * LOG2E;
#pragma unroll 1
    for (int sub = 0; sub < 4; ++sub) {
        const int tq = blk * 128 + 32 * sub + q;
        LAS unsigned char* scr = lds + SCR_OFF + wave * SCR_WAVE;
        const size_t trow = (size_t)(b * T + blk * 128 + 32 * sub);
        u32x2 gtc[4]; f32x4 rp[4];
#pragma unroll
        for (int i = 0; i < 4; ++i) { gtc[i] = gtN[i]; rp[i] = rpN[i]; *(LAS u32x4*)(scr + (crow8 + 8 * i) * 144 + cch * 16) = qrN[i]; }
        if (sub < 3) AT_LOAD(sub + 1);
        asm volatile("s_waitcnt lgkmcnt(0)" ::: "memory");
        float x[4][8]; float ssq = 0.f;
#pragma unroll
        for (int d0 = 0; d0 < 4; ++d0) { const u32x4 r = *(const LAS u32x4*)(scr + q * 144 + (16 * d0 + 8 * hi) * 2);
            x[d0][0] = bflo(r.x); x[d0][1] = bfhi(r.x); x[d0][2] = bflo(r.y); x[d0][3] = bfhi(r.y); x[d0][4] = bflo(r.z); x[d0][5] = bfhi(r.z); x[d0][6] = bflo(r.w); x[d0][7] = bfhi(r.w); }
#pragma unroll
        for (int d0 = 0; d0 < 4; ++d0)
#pragma unroll
            for (int i = 0; i < 8; ++i) ssq += x[d0][i] * x[d0][i];
        ssq += __shfl_xor(ssq, 32);
        const float rstd = rsqrtf(ssq * (1.0f / 64.0f) + NORM_EPS) * (0.125f * LOG2E);
#pragma unroll
        for (int d0 = 0; d0 < 4; ++d0) { const f32x4 g0 = *(const f32x4*)(qn + 16 * d0 + 8 * hi), g1 = *(const f32x4*)(qn + 16 * d0 + 8 * hi + 4);
            x[d0][0] *= rstd * g0[0]; x[d0][1] *= rstd * g0[1]; x[d0][2] *= rstd * g0[2]; x[d0][3] *= rstd * g0[3]; x[d0][4] *= rstd * g1[0]; x[d0][5] *= rstd * g1[1]; x[d0][6] *= rstd * g1[2]; x[d0][7] *= rstd * g1[3]; }
#pragma unroll
        for (int i = 0; i < 8; ++i) { const float c = rp[i >> 2][i & 3], s = rp[2 + (i >> 2)][i & 3], me = x[0][i], ot = __shfl_xor(me, 32); x[0][i] = hi == 0 ? me * c - ot * s : me * c + ot * s; }
        bf16x8 qf[4];
#pragma unroll
        for (int d0 = 0; d0 < 4; ++d0) { u32x4 w; w.x = pk2(x[d0][0], x[d0][1]); w.y = pk2(x[d0][2], x[d0][3]); w.z = pk2(x[d0][4], x[d0][5]); w.w = pk2(x[d0][6], x[d0][7]); qf[d0] = __builtin_bit_cast(bf16x8, w); }
        f32x16 p[5];
#pragma unroll
        for (int kt = 0; kt < 5; ++kt) {
#pragma unroll
            for (int r = 0; r < 16; ++r) p[kt][r] = 0.f;
#pragma unroll
            for (int d0 = 0; d0 < 4; ++d0) { const bf16x8 kf = *(const LAS bf16x8*)(lds + (32 * (sub + kt) + q) * KPB + (16 * d0 + 8 * hi) * 2);
                p[kt] = __builtin_amdgcn_mfma_f32_32x32x16_bf16(kf, qf[d0], p[kt], 0, 0, 0); } }
        const bool first = (blk == 0);
        bool lowtri[16];
#pragma unroll
        for (int r = 0; r < 16; ++r) lowtri[r] = crow(r, hi) <= q;
        f32x16 pc;
#pragma unroll
        for (int r = 0; r < 16; ++r) pc[r] = lowtri[r] ? p[4][r] : (first ? -INFINITY : p[0][r]);
        if (first) {
#pragma unroll
            for (int kt = 1; kt < 4; ++kt) if (sub + kt < 4) {
#pragma unroll
                for (int r = 0; r < 16; ++r) p[kt][r] = -INFINITY; } }
        float mx = sink2;
#pragma unroll
        for (int r = 0; r < 16; ++r) mx = fmaxf(fmaxf(mx, pc[r]), fmaxf(fmaxf(p[1][r], p[2][r]), p[3][r]));
        mx = fmaxf(mx, __shfl_xor(mx, 32));
#pragma unroll
        for (int r = 0; r < 16; ++r) { pc[r] = __builtin_amdgcn_exp2f(pc[r] - mx); p[1][r] = __builtin_amdgcn_exp2f(p[1][r] - mx); p[2][r] = __builtin_amdgcn_exp2f(p[2][r] - mx); p[3][r] = __builtin_amdgcn_exp2f(p[3][r] - mx); }
        const f32x16 sv = (pc + p[1]) + (p[2] + p[3]);
        float lsum = ((sv[0] + sv[1]) + (sv[2] + sv[3])) + ((sv[4] + sv[5]) + (sv[6] + sv[7])) + (((sv[8] + sv[9]) + (sv[10] + sv[11])) + ((sv[12] + sv[13]) + (sv[14] + sv[15])));
        lsum += __shfl_xor(lsum, 32); lsum += __builtin_amdgcn_exp2f(sink2 - mx);
        const float inv = 1.0f / lsum;
#pragma unroll
        for (int r = 0; r < 16; ++r) { p[0][r] = lowtri[r] ? 0.f : pc[r]; p[4][r] = lowtri[r] ? pc[r] : 0.f; }
        f32x16 o[2];
#pragma unroll
        for (int r = 0; r < 16; ++r) { o[0][r] = 0.f; o[1][r] = 0.f; }
#pragma unroll
        for (int kt = 0; kt < 5; ++kt)
#pragma unroll
            for (int s = 0; s < 2; ++s) { u32x4 w; w.x = pk2(p[kt][8 * s], p[kt][8 * s + 1]); w.y = pk2(p[kt][8 * s + 2], p[kt][8 * s + 3]); w.z = pk2(p[kt][8 * s + 4], p[kt][8 * s + 5]); w.w = pk2(p[kt][8 * s + 6], p[kt][8 * s + 7]);
                const bf16x8 pf = __builtin_bit_cast(bf16x8, w);
#pragma unroll
                for (int d0 = 0; d0 < 2; ++d0) { const LAS unsigned char* vp = lds + OFF_V + (32 * d0 + q) * VPB + (32 * (sub + kt) + 16 * s + 4 * hi) * 2;
                    const s16x4 lo = *(const LAS s16x4*)vp, hi4 = *(const LAS s16x4*)(vp + 16);
                    const bf16x8 vf = (bf16x8){lo[0], lo[1], lo[2], lo[3], hi4[0], hi4[1], hi4[2], hi4[3]};
                    o[d0] = __builtin_amdgcn_mfma_f32_32x32x16_bf16(vf, pf, o[d0], 0, 0, 0); } }
        asm volatile("s_waitcnt lgkmcnt(0)" ::: "memory");
#pragma unroll
        for (int d0 = 0; d0 < 2; ++d0)
#pragma unroll
            for (int g = 0; g < 4; ++g) { u32x2 w; w.x = pk2(o[d0][4 * g] * inv, o[d0][4 * g + 1] * inv); w.y = pk2(o[d0][4 * g + 2] * inv, o[d0][4 * g + 3] * inv);
                *(LAS u32x2*)(scr + q * 144 + (32 * d0 + 8 * g + 4 * hi) * 2) = w; }
        asm volatile("s_waitcnt lgkmcnt(0)" ::: "memory");
#pragma unroll
        for (int i = 0; i < 4; ++i) { const u32x4 ov = *(const LAS u32x4*)(scr + (crow8 + 8 * i) * 144 + cch * 16); const u32x2 gg = gtc[i]; u32x4 w;
            w.x = pk2(bflo(ov.x) * pg8::d8(gg.x, 0), bfhi(ov.x) * pg8::d8(gg.x, 1)); w.y = pk2(bflo(ov.y) * pg8::d8(gg.x, 2), bfhi(ov.y) * pg8::d8(gg.x, 3));
            w.z = pk2(bflo(ov.z) * pg8::d8(gg.y, 0), bfhi(ov.z) * pg8::d8(gg.y, 1)); w.w = pk2(bflo(ov.w) * pg8::d8(gg.y, 2), bfhi(ov.w) * pg8::d8(gg.y, 3));
            *(u32x4*)(QO + (trow + crow8 + 8 * i) * 1024 + h * 64 + cch * 8) = w; }
        asm volatile("s_waitcnt lgkmcnt(0)" ::: "memory");
    }
#undef AT_LOAD
    __syncthreads();
}
}

namespace cv {
constexpr int ROWS = 62, OFF_Y = ROWS * 1024, NU = M / 32;
typedef pg8::f32x2_t f32x2;
__device__ __forceinline__ void phase(LAS unsigned char* lds, int bx, int G, const bf16_t* A, bf16_t* Y, const float* cw, const float* cb, const float* lg, const float* lb, int tid, int lane, int wave) {
    const int cp = tid & 255, tg = tid >> 8;
    f32x2 wv[31];
#pragma unroll
    for (int j = 0; j < 31; ++j) wv[j] = *(const f32x2*)(cw + j * CC + 2 * cp);
    const f32x2 bias = *(const f32x2*)(cb + 2 * cp);
    const f32x4 g0 = *(const f32x4*)(lg + 4 * lane), g1 = *(const f32x4*)(lg + 256 + 4 * lane), b0 = *(const f32x4*)(lb + 4 * lane), b1 = *(const f32x4*)(lb + 256 + 4 * lane);
    u32x4 pre[8];
#define CV_FETCH(un) do { const int t0_ = (un) * 32, p0_ = t0_ & (T - 1); _Pragma("unroll") for (int i = 0; i < 8; ++i) { const int idx = tid + 512 * i, r = idx >> 6, ch = idx & 63; pre[i] = (u32x4){0u, 0u, 0u, 0u}; \
        if (idx < ROWS * 64 && p0_ - 30 + r >= 0) pre[i] = *(const u32x4*)(A + (size_t)(t0_ - 30 + r) * CC + ch * 8); } } while (0)
    int un = bx;
    if (un < NU) CV_FETCH(un);
#pragma unroll 1
    for (; un < NU; un += G) {
        const int t0 = un * 32;
#pragma unroll
        for (int i = 0; i < 8; ++i) { const int idx = tid + 512 * i; if (idx < ROWS * 64) *(LAS u32x4*)(lds + idx * 16) = pre[i]; }
        __syncthreads();
        if (un + G < NU) CV_FETCH(un + G);
#pragma unroll 1
        for (int sb = 0; sb < 2; ++sb) { const int tb = 16 * tg + 8 * sb;
            f32x2 ac[8];
#pragma unroll
            for (int i = 0; i < 8; ++i) ac[i] = bias;
#pragma unroll
            for (int rr = 0; rr < 38; ++rr) { const unsigned v = *(const LAS unsigned*)(lds + (tb + rr) * 1024 + cp * 4); const f32x2 vv = (f32x2){bflo(v), bfhi(v)};
#pragma unroll
                for (int i = 0; i < 8; ++i) { const int j = rr - i; if (j >= 0 && j <= 30) ac[i] = __builtin_elementwise_fma(wv[j], vv, ac[i]); } }
#pragma unroll
            for (int i = 0; i < 8; ++i) *(LAS f32x2*)(lds + OFF_Y + (tb + i) * 2048 + cp * 8) = ac[i]; }
        __syncthreads();
#pragma unroll
        for (int k = 0; k < 4; ++k) { const int tok = 4 * wave + k;
            f32x4 v0 = *(const LAS f32x4*)(lds + OFF_Y + tok * 2048 + lane * 16), v1 = *(const LAS f32x4*)(lds + OFF_Y + tok * 2048 + 1024 + lane * 16);
            const float mean = wave_sum((v0[0] + v0[1]) + (v0[2] + v0[3]) + (v1[0] + v1[1]) + (v1[2] + v1[3])) * (1.0f / 512.0f);
            v0 = v0 - mean; v1 = v1 - mean;
            const float var = wave_sum((v0[0] * v0[0] + v0[1] * v0[1]) + (v0[2] * v0[2] + v0[3] * v0[3]) + (v1[0] * v1[0] + v1[1] * v1[1]) + (v1[2] * v1[2] + v1[3] * v1[3])) * (1.0f / 512.0f);
            const float rstd = rsqrtf(var + NORM_EPS);
            v0 = v0 * rstd * g0 + b0; v1 = v1 * rstd * g1 + b1;
            u32x2 w0, w1; w0.x = pk2(v0[0] * sigm(v0[0]), v0[1] * sigm(v0[1])); w0.y = pk2(v0[2] * sigm(v0[2]), v0[3] * sigm(v0[3]));
            w1.x = pk2(v1[0] * sigm(v1[0]), v1[1] * sigm(v1[1])); w1.y = pk2(v1[2] * sigm(v1[2]), v1[3] * sigm(v1[3]));
            bf16_t* yp = Y + (size_t)(t0 + tok) * CC + 4 * lane; *(u32x2*)yp = w0; *(u32x2*)(yp + 256) = w1; }
        __syncthreads();
    }
#undef CV_FETCH
}
}
__device__ __forceinline__ void transpose_item(const float* W, int K, int N, bf16_t* WT, int k0, int n0s, int n0d, const float* gain, LAS float* scr, int lane) {
    const int r8 = lane >> 3, c4 = (lane & 7) * 4;
    f32x4 v[8]; float gs[8];
#pragma unroll
    for (int i = 0; i < 8; ++i) { v[i] = *(const f32x4*)(W + (size_t)(k0 + 8 * i + r8) * N + n0s + c4); gs[i] = gain ? gain[k0 + 8 * i + r8] : 1.0f; }
#pragma unroll
    for (int i = 0; i < 8; ++i) { LAS float* d = scr + (8 * i + r8) * 33 + c4; d[0] = v[i][0] * gs[i]; d[1] = v[i][1] * gs[i]; d[2] = v[i][2] * gs[i]; d[3] = v[i][3] * gs[i]; }
    asm volatile("s_waitcnt lgkmcnt(0)" ::: "memory");
    const int c = lane & 7;
#pragma unroll
    for (int j = 0; j < 4; ++j) { const int n = (lane >> 3) + 8 * j; const LAS float* s = scr + (8 * c) * 33 + n;
        u32x4 o; o.x = pk2(s[0 * 33], s[1 * 33]); o.y = pk2(s[2 * 33], s[3 * 33]); o.z = pk2(s[4 * 33], s[5 * 33]); o.w = pk2(s[6 * 33], s[7 * 33]);
        *(u32x4*)(WT + (size_t)(n0d + n) * K + k0 + 8 * c) = o; }
    asm volatile("s_waitcnt lgkmcnt(0)" ::: "memory");
}
__device__ __forceinline__ int perm_in(int n0d) { const int pn = n0d >> 8, h = (n0d >> 7) & 1, j = n0d & 127; if (pn >= 5 && pn < 9) return (h ? 1792 : 1280) + 128 * (pn - 5) + j; return n0d; }
__device__ __forceinline__ int perm_gu(int n0d) { const int pn = n0d >> 8, h = (n0d >> 7) & 1, j = n0d & 127; return (h ? FF : 0) + 128 * pn + j; }

struct Args { const float* in[15]; float* out; unsigned char* ws; int ph_lo, ph_hi; };
enum { I_X = 0, I_NMIX, I_WIN, I_QN, I_KN, I_SINK, I_CW, I_CB, I_LG, I_LB, I_WPW, I_WOUT, I_NFFN, I_WGU, I_WDN };

__device__ __forceinline__ void convert_layer(const Args& a, int l, int slot, int nslots, LAS float* scr, int lane) {
    constexpr int I_IN = (D / 64) * (INW / 32), I_PW = (CC / 64) * (D / 32), I_OUT = (D / 64) * (D / 32), I_GU = (D / 64) * (GU / 32), I_DN = (FF / 64) * (D / 32), PER_L = I_IN + I_PW + I_OUT + I_GU + I_DN;
    unsigned char* wb = a.ws + WS_W + (size_t)l * W_LAYER;
    for (int it = slot; it < PER_L; it += nslots) {
        int r = it;
        if (r < I_IN) { const int nblk = INW / 32, kb = r / nblk, nb = r % nblk; transpose_item(a.in[I_WIN] + (size_t)l * D * INW, D, INW, (bf16_t*)(wb + WO_IN), 64 * kb, perm_in(32 * nb), 32 * nb, a.in[I_NMIX] + l * D, scr, lane); continue; } r -= I_IN;
        if (r < I_PW) { const int nblk = D / 32, kb = r / nblk, nb = r % nblk; transpose_item(a.in[I_WPW] + (size_t)l * CC * D, CC, D, (bf16_t*)(wb + WO_PW), 64 * kb, 32 * nb, 32 * nb, nullptr, scr, lane); continue; } r -= I_PW;
        if (r < I_OUT) { const int nblk = D / 32, kb = r / nblk, nb = r % nblk; transpose_item(a.in[I_WOUT] + (size_t)l * D * D, D, D, (bf16_t*)(wb + WO_OUT), 64 * kb, 32 * nb, 32 * nb, nullptr, scr, lane); continue; } r -= I_OUT;
        if (r < I_GU) { const int nblk = GU / 32, kb = r / nblk, nb = r % nblk; transpose_item(a.in[I_WGU] + (size_t)l * D * GU, D, GU, (bf16_t*)(wb + WO_GU), 64 * kb, perm_gu(32 * nb), 32 * nb, a.in[I_NFFN] + l * D, scr, lane); continue; } r -= I_GU;
        { const int nblk = D / 32, kb = r / nblk, nb = r % nblk; transpose_item(a.in[I_WDN] + (size_t)l * FF * D, FF, D, (bf16_t*)(wb + WO_DN), 64 * kb, 32 * nb, 32 * nb, nullptr, scr, lane); }
    }
}
__device__ __forceinline__ void prologue(const Args& a, LAS unsigned char* lds, int tid, int lane, int wave) {
    LAS float* scr = (LAS float*)(lds + wave * 16384);
    const int gw = blockIdx.x * 8 + wave, NGW = gridDim.x * 8;
    const int lw = gridDim.x == 256 ? 1 : DEPTH;
    for (int l = 0; l < lw; ++l) convert_layer(a, l, gw, NGW, scr, lane);
    float* ss = (float*)(a.ws + WS_SS); bf16_t* XB = (bf16_t*)(a.ws + WS_XB);
    unsigned char* LOA = (unsigned char*)a.out;
    for (int m = gw; m < M; m += NGW) { const f32x4* xr = (const f32x4*)(a.in[I_X] + (size_t)m * D) + lane; u32x2* xo = (u32x2*)(XB + (size_t)m * D) + lane; unsigned* lo = (unsigned*)(LOA + (size_t)m * D) + lane; float s = 0.f;
#pragma unroll
        for (int j = 0; j < 4; ++j) { const f32x4 v = xr[64 * j]; s += (v[0] * v[0] + v[1] * v[1]) + (v[2] * v[2] + v[3] * v[3]); u32x2 w; w.x = pk2(v[0], v[1]); w.y = pk2(v[2], v[3]); xo[64 * j] = w;
            lo[64 * j] = pg8::lo8_enc(v[0], w.x & 0xffffu) | (pg8::lo8_enc(v[1], w.x >> 16) << 8) | (pg8::lo8_enc(v[2], w.y & 0xffffu) << 16) | (pg8::lo8_enc(v[3], w.y >> 16) << 24); }
        s = wave_sum(s); if (lane < 16) ss[(size_t)m * 16 + lane] = lane == 0 ? s : 0.f; }
    float* rope = (float*)(a.ws + WS_ROPE);
    for (int i = blockIdx.x * 512 + tid; i < T * 8; i += gridDim.x * 512) { const int t = i >> 3, f = i & 7;
        double fr = 1.0; for (int k = 0; k < f; ++k) fr *= 0.19392274474868576;
        const float inv_freq = (float)fr; const float ang = (float)t * inv_freq;
        const double x = (double)ang, kq = __builtin_rint(x * 0.6366197723675814);
        const double r = __builtin_fma(-kq, 6.123233995736766e-17, __builtin_fma(-kq, 1.5707963267948966, x)), r2 = r * r;
        const double sp = r * (1.0 + r2 * (-1.0 / 6 + r2 * (1.0 / 120 + r2 * (-1.0 / 5040 + r2 * (1.0 / 362880 + r2 * (-1.0 / 39916800 + r2 * (1.0 / 6227020800.0)))))));
        const double cp = 1.0 + r2 * (-0.5 + r2 * (1.0 / 24 + r2 * (-1.0 / 720 + r2 * (1.0 / 40320 + r2 * (-1.0 / 3628800 + r2 * (1.0 / 479001600 + r2 * (-1.0 / 87178291200.0)))))));
        const int qd = ((int)kq) & 3;
        const double sn = qd == 0 ? sp : qd == 1 ? cp : qd == 2 ? -sp : -cp, cn = qd == 0 ? cp : qd == 1 ? -sp : qd == 2 ? -cp : sp;
        rope[t * 16 + f] = (float)cn; rope[t * 16 + 8 + f] = (float)sn; }
}

#define XB_TMO      128
#define XB_XCNT(j)  (256  + 64 * (j))
#define XB_XSUB(j)  (1280 + 64 * (j))
#define XB_XGEN(j)  (2304 + 64 * (j))
#define XB_TOP      3328
#define XB_TOPGEN   3392
#define XCD_BAR_WORDS 3456
#define XB_SPIN_CAP (1u << 18)

__device__ __forceinline__ unsigned xb_ld(unsigned* p)              { return __hip_atomic_load(p, __ATOMIC_RELAXED, __HIP_MEMORY_SCOPE_AGENT); }
__device__ __forceinline__ unsigned xb_add(unsigned* p, unsigned v) { return __hip_atomic_fetch_add(p, v, __ATOMIC_RELAXED, __HIP_MEMORY_SCOPE_AGENT); }
__device__ __forceinline__ unsigned xb_xcc_id() { return (unsigned)__builtin_amdgcn_s_getreg((3 << 11) | 20) & 0xFu; }
#define XB_SPIN(cond, bar) do { unsigned _sp = 0; while (cond) { __builtin_amdgcn_s_sleep(1); \
    if ((++_sp & 255u) == 0u) { if (xb_ld(&(bar)[XB_TMO])) break; if (_sp > XB_SPIN_CAP) { atomicAdd(&(bar)[XB_TMO], 1u); break; } } } } while (0)

struct XcdBarrier {
    unsigned* bar; unsigned x;
    volatile LAS unsigned* st;
};

__device__ __forceinline__ XcdBarrier xcd_barrier_post(unsigned* bar, volatile LAS unsigned* st) {
    XcdBarrier b; b.bar = bar; b.x = xb_xcc_id(); b.st = st;
    if (threadIdx.x == 0) (void)xb_add(&bar[XB_XCNT(b.x)], 1u);
    return b;
}
__device__ __forceinline__ void xcd_barrier_complete(unsigned* bar, unsigned x, unsigned& nloc, unsigned& nx) {
    const unsigned G = gridDim.x * gridDim.y * gridDim.z;
    unsigned sum, cnt, mine, sp = 0u;
    for (;;) {
        sum = 0u; cnt = 0u; mine = 0u;
#pragma unroll
        for (unsigned j = 0; j < 16; ++j) { const unsigned c = xb_ld(&bar[XB_XCNT(j)]); sum += c; cnt += (c > 0u) ? 1u : 0u; mine = (j == x) ? c : mine; }
        if (sum == G) break;
        __builtin_amdgcn_s_sleep(1);
        if ((++sp & 255u) == 0u) { if (xb_ld(&bar[XB_TMO])) break; if (sp > XB_SPIN_CAP) { atomicAdd(&bar[XB_TMO], 1u); break; } }
    }
    nloc = mine > 0u ? mine : 1u; nx = cnt > 0u ? cnt : 1u;
}

__device__ __forceinline__ void xcd_barrier(const XcdBarrier& b) {
    asm volatile("s_waitcnt vmcnt(0)" ::: "memory");
    __syncthreads();
    if (threadIdx.x == 0) {
        unsigned* bar = b.bar;
        __builtin_amdgcn_s_waitcnt(0);
        unsigned nloc = b.st[0], nx = b.st[1];
        if (nloc == 0u) { xcd_barrier_complete(bar, b.x, nloc, nx); b.st[0] = nloc; b.st[1] = nx; }
        const unsigned old = xb_add(&bar[XB_XSUB(b.x)], 1u);
        const unsigned gen = old / nloc;
        if (old + 1u == (gen + 1u) * nloc) {
            __builtin_amdgcn_fence(__ATOMIC_RELEASE, "agent");
            asm volatile("s_waitcnt vmcnt(0)" ::: "memory");
            const unsigned og = xb_add(&bar[XB_TOP], 1u);
            const unsigned tg = og / nx;
            if (og + 1u == (tg + 1u) * nx) xb_add(&bar[XB_TOPGEN], 1u);
            else XB_SPIN(xb_ld(&bar[XB_TOPGEN]) == tg, bar);
            __builtin_amdgcn_fence(__ATOMIC_ACQUIRE, "agent");
            xb_add(&bar[XB_XGEN(b.x)], 1u);
            asm volatile("s_waitcnt vmcnt(0)" ::: "memory");
        } else {
            XB_SPIN(xb_ld(&bar[XB_XGEN(b.x)]) == gen, bar);
            __builtin_amdgcn_fence(__ATOMIC_ACQUIRE, "agent");
            asm volatile("s_waitcnt vmcnt(0)" ::: "memory");
        }
    }
    __syncthreads();
}

#ifndef PROBE
#define PROBE 0
#endif
#define tsb ((LAS unsigned long long*)(lds + 131072))
#ifndef PROBE_A
#define PROBE_A 2
#endif
#ifndef PROBE_B
#define PROBE_B 3
#endif
#ifndef PROBE_SA
#define PROBE_SA 0.01f
#endif
#ifndef PROBE_SB
#define PROBE_SB 0.01f
#endif
constexpr int N_PHASES = 1 + 6 * DEPTH;
__global__ void __launch_bounds__(512, 2) fwd_kernel(Args a) {
    extern __shared__ __attribute__((aligned(16))) unsigned char lds_raw[];
    LAS unsigned char* lds = (LAS unsigned char*)lds_raw;
    cg::grid_group grid = cg::this_grid();
    volatile LAS unsigned* bst = (volatile LAS unsigned*)(lds + 131072 + 768);
    if (threadIdx.x < 2) bst[threadIdx.x] = 0u;
    __syncthreads();
    const XcdBarrier xbar = xcd_barrier_post((unsigned*)(a.ws + WS_BAR), bst);
    const int G = gridDim.x, bx = blockIdx.x;
    unsigned char* ws = a.ws;
    float* ss = (float*)(ws + WS_SS); const float* rope = (const float*)(ws + WS_ROPE);
    bf16_t* XB = (bf16_t*)(ws + WS_XB); bf16_t* QO = (bf16_t*)(ws + WS_QO); bf16_t* KV = (bf16_t*)(ws + WS_KV); bf16_t* AB = (bf16_t*)(ws + WS_A);
    bf16_t* GB = (bf16_t*)(ws + WS_G); bf16_t* YB = (bf16_t*)(ws + WS_Y); bf16_t* ACT = (bf16_t*)(ws + WS_ACT);
#pragma unroll 1
    for (int ph = a.ph_lo; ph < a.ph_hi; ++ph) {
        if (ph > a.ph_lo) { if (ph == 1) grid.sync(); else xcd_barrier(xbar); }
        int tid_l = threadIdx.x; asm volatile("" : "+v"(tid_l));
#if PROBE
        if (threadIdx.x == 0) tsb[ph] = __builtin_amdgcn_s_memrealtime();
#endif
        const int tid = tid_l, lane = tid & 63, wave = __builtin_amdgcn_readfirstlane(tid >> 6);
        if (ph == 0) { prologue(a, lds, tid, lane, wave); continue; }
        const int l = (ph - 1) / 6, s = (ph - 1) % 6;
        const unsigned char* wb = ws + WS_W + (size_t)l * W_LAYER;
        if (s == 0) {
            pg8::Gemm g{XB, (const bf16_t*)(wb + WO_IN), M, INW, D}; pg8::StaticOrder S; S.init(M, INW, G, bx);
            pg8::EpiIn E{QO, KV, AB, GB, ss};
            pg8::gemm_phase<pg8::EpiIn, pg8::StaticOrder, true, true>(lds, g, S, E);
            if (G == 256 && bx >= 128 && l + 1 < DEPTH) convert_layer(a, l + 1, (bx - 128) * 8 + wave, 128 * 8, (LAS float*)(lds + wave * 16384), lane);
        } else if (s == 1) {
            for (int u = bx; u < NB * 2 * (T / 128); u += G) { const int blk = u & 63, kvh = (u >> 6) & 1, b = u >> 7;
                att::unit(lds, b, kvh, blk, QO, KV, GB, a.in[I_QN] + l * 64, a.in[I_KN] + l * 64, a.in[I_SINK] + l * NHEAD, rope, tid, lane, wave); }
#if PROBE
            if (threadIdx.x == 0) tsb[32 + l] = __builtin_amdgcn_s_memrealtime();
#endif
            cv::phase(lds, bx, G, AB, YB, a.in[I_CW] + (size_t)l * 31 * CC, a.in[I_CB] + l * CC, a.in[I_LG] + l * CC, a.in[I_LB] + l * CC, tid, lane, wave);
        } else if (s == 2) {
            pg8::Gemm g{YB, (const bf16_t*)(wb + WO_PW), M, D, CC}; pg8::StaticOrder S; S.init(M, D, G, bx);
            pg8::EpiMerge E{QO, GB};
            pg8::gemm_phase<pg8::EpiMerge, pg8::StaticOrder, true, true>(lds, g, S, E);
        } else if (s == 3) {
            pg8::Gemm g{QO, (const bf16_t*)(wb + WO_OUT), M, D, D}; pg8::StaticOrder S; S.init(M, D, G, bx);
            pg8::EpiRes E{(const unsigned char*)a.out, (unsigned char*)(ws + WS_LOB), XB, a.out, ss + (size_t)M * 16, 1};
            pg8::gemm_phase<pg8::EpiRes, pg8::StaticOrder, true, true>(lds, g, S, E);
        } else if (s == 4) {
            pg8::Gemm g{XB, (const bf16_t*)(wb + WO_GU), M, GU, D}; pg8::StaticOrder S; S.init(M, GU, G, bx);
            pg8::EpiSwiglu E{ACT, ss + (size_t)M * 16};
            pg8::gemm_phase<pg8::EpiSwiglu, pg8::StaticOrder, true, true>(lds, g, S, E);
        } else {
            pg8::Gemm g{ACT, (const bf16_t*)(wb + WO_DN), M, D, FF}; pg8::StaticOrder S; S.init(M, D, G, bx);
            pg8::EpiRes E{(const unsigned char*)(ws + WS_LOB), (unsigned char*)a.out, XB, a.out, ss, l + 1 < DEPTH ? 1 : 0};
            pg8::gemm_phase<pg8::EpiRes, pg8::StaticOrder, true, true>(lds, g, S, E);
        }
    }
#if PROBE
    if (bx == 0) {
        LAS float* pv = (LAS float*)(lds + 131072 + 512);
        if (threadIdx.x == 0) { tsb[N_PHASES] = __builtin_amdgcn_s_memrealtime();
            unsigned long long sa = 0, sb = 0;
#pragma unroll 1
            for (int l = 0; l < DEPTH; ++l) { const int b = 1 + 6 * l;
                const unsigned long long d1 = tsb[b + 1] - tsb[b], d2 = tsb[32 + l] - tsb[b + 1], d3 = tsb[b + 2] - tsb[32 + l], d4 = tsb[b + 3] - tsb[b + 2], d5 = tsb[b + 4] - tsb[b + 3], d6 = tsb[b + 5] - tsb[b + 4], d7 = tsb[b + 6] - tsb[b + 5];
                sa += PROBE_A == 1 ? d1 : PROBE_A == 2 ? d2 : PROBE_A == 3 ? d3 : PROBE_A == 4 ? d4 : PROBE_A == 5 ? d5 : PROBE_A == 6 ? d6 : PROBE_A == 7 ? d7 : 0;
                sb += PROBE_B == 1 ? d1 : PROBE_B == 2 ? d2 : PROBE_B == 3 ? d3 : PROBE_B == 4 ? d4 : PROBE_B == 5 ? d5 : PROBE_B == 6 ? d6 : PROBE_B == 7 ? d7 : 0; }
            if (PROBE_A == 0) sa = tsb[1] - tsb[0]; if (PROBE_B == 0) sb = tsb[1] - tsb[0];
            pv[0] = (float)sa * 0.01f * PROBE_SA; pv[1] = PROBE_B == 8 ? 20.0f : (float)sb * 0.01f * PROBE_SB; }
        __syncthreads();
        if (threadIdx.x == 0) a.out[0] += pv[0];
        if (PROBE_B >= 0) for (int i = threadIdx.x + 512; i < 65536; i += 512) a.out[(size_t)(i >> 8) * 1024 + (i & 255)] += pv[1] * 0.0625f;
    }
#endif
}

#ifndef MK_PER_PHASE
#define MK_PER_PHASE 0
#endif
extern "C" void kernel_launch(void* const* d_in, const int* in_sizes, int n_in, void* d_out, int out_size, void* d_ws, size_t ws_size, hipStream_t stream) {
    static int grid = 0;
    if (grid == 0) {
        if (n_in != 15 || in_sizes[0] != M * D || out_size != M * D || ws_size < WS_END) { fprintf(stderr, "kernel_launch: unexpected shapes / workspace (n_in %d, ws %zu)\n", n_in, ws_size); grid = -1; return; }
        int dev = 0, cus = 0, per_cu = 0;
        (void)hipGetDevice(&dev); (void)hipDeviceGetAttribute(&cus, hipDeviceAttributeMultiprocessorCount, dev);
        if (hipFuncSetAttribute((const void*)fwd_kernel, hipFuncAttributeMaxDynamicSharedMemorySize, LDS_BYTES) != hipSuccess) { fprintf(stderr, "kernel_launch: hipFuncSetAttribute failed\n"); grid = -1; return; }
        if (hipOccupancyMaxActiveBlocksPerMultiprocessor(&per_cu, (const void*)fwd_kernel, 512, LDS_BYTES) != hipSuccess || per_cu < 1) { fprintf(stderr, "kernel_launch: occupancy query says %d\n", per_cu); per_cu = 1; }
        (void)hipGetLastError();
        grid = cus * per_cu;
    }
    if (grid < 0) return;
    if (hipMemsetAsync((char*)d_ws + WS_BAR, 0, 16384, stream) != hipSuccess) { fprintf(stderr, "kernel_launch: memset of the barrier words failed\n"); return; }
    Args a{};
    for (int i = 0; i < 15; ++i) a.in[i] = (const float*)d_in[i];
    a.out = (float*)d_out; a.ws = (unsigned char*)d_ws;
#if MK_PER_PHASE
    for (int ph = 0; ph < N_PHASES; ++ph) { a.ph_lo = ph; a.ph_hi = ph + 1; hipLaunchKernelGGL(fwd_kernel, dim3(grid), dim3(512), LDS_BYTES, stream, a); }
#else
    a.ph_lo = 0; a.ph_hi = N_PHASES;
    void* args[] = {&a};
    hipError_t e = hipLaunchCooperativeKernel((const void*)fwd_kernel, dim3(grid), dim3(512), args, LDS_BYTES, stream);
    if (e != hipSuccess) fprintf(stderr, "cooperative launch failed: %s (grid %d)\n", hipGetErrorString(e), grid);
#endif
}
```

```cpp
#include <hip/hip_runtime.h>
#include <hip/hip_cooperative_groups.h>
#include <cstdio>
#include <cstdint>
namespace cg = cooperative_groups;
namespace pg8 {
#define PG8_LAS __attribute__((address_space(3)))
typedef unsigned short bf16_t;
typedef short bf16x8 __attribute__((ext_vector_type(8)));
typedef float f32x4 __attribute__((ext_vector_type(4)));
typedef unsigned u32x4 __attribute__((ext_vector_type(4)));
constexpr int BM = 256, BK = 64, HALF = 128, HTB = HALF * BK * 2  , STAGE_BYTES = 8 * HTB, NXCD = 8, WGM = 8;

__host__ __device__ __forceinline__ int lds_byte(int r, int c) { const int st = (r >> 4) * 2 + (c >> 5), rr = r & 15, cc = c & 31, ob = rr * 64 + cc * 2; return st * 1024 + (ob ^ (((ob >> 9) & 1) << 5)); }
__host__ __device__ __forceinline__ void stage_rc(int b, int& R, int& C) { const int st = b / 1024, sb = b % 1024, swz = sb ^ (((sb >> 9) & 1) << 5); R = (st >> 1) * 16 + swz / 64; C = (st & 1) * 32 + (swz % 64) / 2; }
__host__ __device__ __forceinline__ int perm32(int rho) { const int n = rho >> 4, i = rho & 15; return 8 * (i >> 2) + 4 * n + (i & 3); }

struct Unit { int pm, pn; };
struct Gemm { const bf16_t* A; const bf16_t* Bt; int M, N, K; };

struct StaticOrder {
    int nM, nN, nwg, G, c;
    __host__ __device__ void init(int M, int N, int G_, int c_) { nM = M / BM; nN = N / BM; nwg = nM * nN; G = G_; c = c_; }
    __host__ __device__ bool next(int i, Unit& u) const {
        const long L = (long)i * G + c; if (L >= nwg) return false;
        int wgid = (int)L; { const int q = nwg / NXCD, r = nwg % NXCD, xcd = wgid % NXCD, off = wgid / NXCD; wgid = (xcd < r ? xcd * (q + 1) : r * (q + 1) + (xcd - r) * q) + off; }
        const int nig = WGM * nN, gid = wgid / nig, fm = gid * WGM, gsz = (nM - fm) < WGM ? (nM - fm) : WGM;
        u.pm = fm + ((wgid % nig) % gsz); u.pn = (wgid % nig) / gsz; return true;
    }
    __device__ __forceinline__ void a_ready(const Unit&) const {}
    __device__ __forceinline__ void done(const Unit&) const {}
};
typedef float f32x2_t __attribute__((ext_vector_type(2))); typedef __bf16 bf16x2_t __attribute__((ext_vector_type(2)));
typedef unsigned u32x2 __attribute__((ext_vector_type(2)));
__device__ __forceinline__ unsigned pk2(float lo, float hi) { f32x2_t v = {lo, hi}; bf16x2_t b = __builtin_convertvector(v, bf16x2_t); return __builtin_bit_cast(unsigned, b); }
__device__ __forceinline__ float bflo(unsigned u) { return __uint_as_float(u << 16); }
__device__ __forceinline__ float bfhi(unsigned u) { return __uint_as_float(u & 0xffff0000u); }
__device__ __forceinline__ float sigm(float x) { return __builtin_amdgcn_rcpf(1.0f + __builtin_amdgcn_exp2f(x * -1.4426950408889634f)); }
constexpr float NORM_EPS = 1e-6f;
__device__ __forceinline__ float row_rstd(const float* P, int row) { const f32x4* p = (const f32x4*)(P + (size_t)row * 16); const f32x4 a = p[0], b = p[1], c = p[2], d = p[3];
    const float s = ((a[0] + a[1]) + (a[2] + a[3])) + ((b[0] + b[1]) + (b[2] + b[3])) + ((c[0] + c[1]) + (c[2] + c[3])) + ((d[0] + d[1]) + (d[2] + d[3])); return rsqrtf(s * (1.0f / 1024.0f) + NORM_EPS); }

#ifndef ER_DEPTH
#define ER_DEPTH 4
#endif
#ifndef EM_DEPTH
#define EM_DEPTH 6
#endif
__device__ __forceinline__ void wave_rstd(const float* P, int rbase, int lane, float& ra, float& rb) {
    const f32x4* p = (const f32x4*)(P + (size_t)(rbase + lane) * 16); const f32x4* q = p + 4 * HALF;
    const f32x4 a0 = p[0], a1 = p[1], a2 = p[2], a3 = p[3], b0 = q[0], b1 = q[1], b2 = q[2], b3 = q[3];
    const float sa = ((a0[0] + a0[1]) + (a0[2] + a0[3])) + ((a1[0] + a1[1]) + (a1[2] + a1[3])) + ((a2[0] + a2[1]) + (a2[2] + a2[3])) + ((a3[0] + a3[1]) + (a3[2] + a3[3]));
    const float sb = ((b0[0] + b0[1]) + (b0[2] + b0[3])) + ((b1[0] + b1[1]) + (b1[2] + b1[3])) + ((b2[0] + b2[1]) + (b2[2] + b2[3])) + ((b3[0] + b3[1]) + (b3[2] + b3[3]));
    ra = rsqrtf(sa * (1.0f / 1024.0f) + NORM_EPS); rb = rsqrtf(sb * (1.0f / 1024.0f) + NORM_EPS);
}
__device__ __forceinline__ unsigned q8(float g) { return (unsigned)(sigm(g) * 255.0f + 0.5f); }
__device__ __forceinline__ float d8(unsigned w, int k) { return (float)((w >> (8 * k)) & 0xffu) * (1.0f / 255.0f); }
struct EpiIn {
    static constexpr bool PERM = true, AFTER_DRAIN = false;
    bf16_t *Q, *KV, *A, *G; const float* ss;
    __device__ __forceinline__ void operator()(const f32x4 (&acc)[2][2][4][2], const Unit& u, int wr, int wc, int fr, int fq) const {
        const int row0 = u.pm * BM + wr * 64 + fr, pn = u.pn, cw = wc * 32 + 8 * fq;
        float ra, rb; wave_rstd(ss, u.pm * BM + wr * 64, fr + 16 * fq, ra, rb);
        if (pn >= 5 && pn < 9) {
#pragma unroll
            for (int ai = 0; ai < 2; ++ai)
#pragma unroll
                for (int m = 0; m < 4; ++m) { const int row = row0 + ai * HALF + m * 16; const float rs = __shfl(ai ? rb : ra, 16 * m + fr);
                    const f32x4 u0 = acc[ai][0][m][0] * rs, u1 = acc[ai][0][m][1] * rs, g0 = acc[ai][1][m][0] * rs, g1 = acc[ai][1][m][1] * rs;
                    u32x4 w; w.x = pk2(u0[0] * sigm(g0[0]), u0[1] * sigm(g0[1])); w.y = pk2(u0[2] * sigm(g0[2]), u0[3] * sigm(g0[3]));
                    w.z = pk2(u1[0] * sigm(g1[0]), u1[1] * sigm(g1[1])); w.w = pk2(u1[2] * sigm(g1[2]), u1[3] * sigm(g1[3]));
                    *(u32x4*)(A + (size_t)row * 512 + (pn - 5) * 128 + cw) = w; }
        } else if (pn >= 9) {
            unsigned char* base = (unsigned char*)G + (pn - 9) * 256 + cw;
#pragma unroll
            for (int ai = 0; ai < 2; ++ai)
#pragma unroll
                for (int m = 0; m < 4; ++m) { const int row = row0 + ai * HALF + m * 16; const float rs = __shfl(ai ? rb : ra, 16 * m + fr);
                    unsigned char* rowp = base + (size_t)row * 2048;
#pragma unroll
                    for (int bj = 0; bj < 2; ++bj) { const f32x4 v0 = acc[ai][bj][m][0] * rs, v1 = acc[ai][bj][m][1] * rs;
                        u32x2 w; w.x = q8(v0[0]) | (q8(v0[1]) << 8) | (q8(v0[2]) << 16) | (q8(v0[3]) << 24); w.y = q8(v1[0]) | (q8(v1[1]) << 8) | (q8(v1[2]) << 16) | (q8(v1[3]) << 24);
                        *(u32x2*)(rowp + bj * HALF) = w; } }
        } else {
            bf16_t* base; int pitch;
            if (pn < 4) { base = Q + pn * 256 + cw; pitch = 1024; } else { base = KV + cw; pitch = 256; }
#pragma unroll
            for (int ai = 0; ai < 2; ++ai)
#pragma unroll
                for (int m = 0; m < 4; ++m) { const int row = row0 + ai * HALF + m * 16; const float rs = __shfl(ai ? rb : ra, 16 * m + fr);
                    bf16_t* rowp = base + (size_t)row * pitch;
#pragma unroll
                    for (int bj = 0; bj < 2; ++bj) { const f32x4 v0 = acc[ai][bj][m][0] * rs, v1 = acc[ai][bj][m][1] * rs;
                        u32x4 w; w.x = pk2(v0[0], v0[1]); w.y = pk2(v0[2], v0[3]); w.z = pk2(v1[0], v1[1]); w.w = pk2(v1[2], v1[3]);
                        *(u32x4*)(rowp + bj * HALF) = w; } }
        }
    }
};
struct EpiMerge {
    static constexpr bool PERM = true, AFTER_DRAIN = false;
    bf16_t* AO; const bf16_t* G;
    __device__ __forceinline__ void operator()(const f32x4 (&acc)[2][2][4][2], const Unit& u, int wr, int wc, int fr, int fq) const {
        const int row0 = u.pm * BM + wr * 64 + fr, col0 = u.pn * BM + wc * 32 + 8 * fq;
        constexpr int MD = EM_DEPTH; u32x4 pa[MD]; u32x2 pgb[MD];
#define EM_ROW(hg) (row0 + ((hg) >> 3) * HALF + (((hg) >> 1) & 3) * 16)
#define EM_COL(hg) (col0 + ((hg) & 1) * HALF)
#define EM_LOAD(hg, s) do { pa[s] = *(const u32x4*)(AO + (size_t)EM_ROW(hg) * 1024 + EM_COL(hg)); pgb[s] = *(const u32x2*)((const unsigned char*)G + (size_t)EM_ROW(hg) * 2048 + 1024 + EM_COL(hg)); } while (0)
#pragma unroll
        for (int hg = 0; hg < MD; ++hg) EM_LOAD(hg, hg);
#pragma unroll
        for (int hg = 0; hg < 16; ++hg) { const int ai = hg >> 3, m = (hg >> 1) & 3, bj = hg & 1, s = hg % MD;
            const u32x4 ao = pa[s]; const u32x2 gb = pgb[s]; const f32x4 c0 = acc[ai][bj][m][0], c1 = acc[ai][bj][m][1];
            u32x4 w;
            w.x = pk2(bflo(ao.x) + d8(gb.x, 0) * c0[0], bfhi(ao.x) + d8(gb.x, 1) * c0[1]);
            w.y = pk2(bflo(ao.y) + d8(gb.x, 2) * c0[2], bfhi(ao.y) + d8(gb.x, 3) * c0[3]);
            w.z = pk2(bflo(ao.z) + d8(gb.y, 0) * c1[0], bfhi(ao.z) + d8(gb.y, 1) * c1[1]);
            w.w = pk2(bflo(ao.w) + d8(gb.y, 2) * c1[2], bfhi(ao.w) + d8(gb.y, 3) * c1[3]);
            *(u32x4*)(AO + (size_t)EM_ROW(hg) * 1024 + EM_COL(hg)) = w;
            if (hg + MD < 16) EM_LOAD(hg + MD, s); }
#undef EM_ROW
#undef EM_COL
#undef EM_LOAD
    }
};
__device__ __forceinline__ float lo8_dec(unsigned hbits16, unsigned qbyte) {
    unsigned E = (hbits16 >> 7) & 0xffu; E = E < 16u ? 16u : E;
    return __uint_as_float(hbits16 << 16) + (float)(int)(signed char)qbyte * __uint_as_float((E - 15u) << 23);
}
__device__ __forceinline__ unsigned lo8_enc(float v, unsigned hbits16) {
    unsigned E = (hbits16 >> 7) & 0xffu; E = E < 16u ? 16u : E;
    const float q = (v - __uint_as_float(hbits16 << 16)) * __uint_as_float((269u - E) << 23);
    int i = (int)__builtin_rintf(q); i = i < -128 ? -128 : (i > 127 ? 127 : i);
    return (unsigned)i & 0xffu;
}
struct EpiRes {
    static constexpr bool PERM = true, AFTER_DRAIN = false;
    const unsigned char* lo_in; unsigned char* lo_out; bf16_t* XB; float* fout; float* ssn; int nxt;
    __device__ __forceinline__ void operator()(const f32x4 (&acc)[2][2][4][2], const Unit& u, int wr, int wc, int fr, int fq) const {
        const int row0 = u.pm * BM + wr * 64 + fr, col0 = u.pn * BM + wc * 32 + 8 * fq;
        constexpr int RD = ER_DEPTH; u32x4 ph[RD][2]; u32x2 pl[RD][2];
#define ER_ROW(g) (row0 + ((g) >> 2) * HALF + ((g) & 3) * 16)
#define ER_LOAD(g, s) do { const size_t o_ = (size_t)ER_ROW(g) * 1024 + col0; ph[s][0] = *(const u32x4*)(XB + o_); ph[s][1] = *(const u32x4*)(XB + o_ + HALF); pl[s][0] = *(const u32x2*)(lo_in + o_); pl[s][1] = *(const u32x2*)(lo_in + o_ + HALF); } while (0)
#pragma unroll
        for (int g = 0; g < RD; ++g) ER_LOAD(g, g);
#pragma unroll
        for (int g = 0; g < 8; ++g) { const int ai = g >> 2, m = g & 3, s = g % RD; const int row = ER_ROW(g); const size_t off = (size_t)row * 1024 + col0; float sq = 0.f;
#pragma unroll
            for (int bj = 0; bj < 2; ++bj) { const size_t o = off + bj * HALF; const u32x4 h = ph[s][bj]; const u32x2 l = pl[s][bj];
                const f32x4 v0 = (f32x4){lo8_dec(h.x & 0xffffu, l.x), lo8_dec(h.x >> 16, l.x >> 8), lo8_dec(h.y & 0xffffu, l.x >> 16), lo8_dec(h.y >> 16, l.x >> 24)} + acc[ai][bj][m][0];
                const f32x4 v1 = (f32x4){lo8_dec(h.z & 0xffffu, l.y), lo8_dec(h.z >> 16, l.y >> 8), lo8_dec(h.w & 0xffffu, l.y >> 16), lo8_dec(h.w >> 16, l.y >> 24)} + acc[ai][bj][m][1];
                if (nxt) { u32x4 w; w.x = pk2(v0[0], v0[1]); w.y = pk2(v0[2], v0[3]); w.z = pk2(v1[0], v1[1]); w.w = pk2(v1[2], v1[3]); *(u32x4*)(XB + o) = w;
                    u32x2 r; r.x = lo8_enc(v0[0], w.x & 0xffffu) | (lo8_enc(v0[1], w.x >> 16) << 8) | (lo8_enc(v0[2], w.y & 0xffffu) << 16) | (lo8_enc(v0[3], w.y >> 16) << 24);
                    r.y = lo8_enc(v1[0], w.z & 0xffffu) | (lo8_enc(v1[1], w.z >> 16) << 8) | (lo8_enc(v1[2], w.w & 0xffffu) << 16) | (lo8_enc(v1[3], w.w >> 16) << 24);
                    *(u32x2*)(lo_out + o) = r;
                    sq += ((v0[0] * v0[0] + v0[1] * v0[1]) + (v0[2] * v0[2] + v0[3] * v0[3])) + ((v1[0] * v1[0] + v1[1] * v1[1]) + (v1[2] * v1[2] + v1[3] * v1[3])); }
                else { *(f32x4*)(fout + o) = v0; *(f32x4*)(fout + o + 4) = v1; } }
            if (nxt) { sq += __shfl_xor(sq, 16); sq += __shfl_xor(sq, 32); if (fq == 0) ssn[(size_t)row * 16 + u.pn * 4 + wc] = sq; }
            if (g + RD < 8) ER_LOAD(g + RD, s); }
#undef ER_ROW
#undef ER_LOAD
    }
};
struct EpiSwiglu {
    static constexpr bool PERM = true, AFTER_DRAIN = false;
    bf16_t* ACT; const float* ss;
    __device__ __forceinline__ void operator()(const f32x4 (&acc)[2][2][4][2], const Unit& u, int wr, int wc, int fr, int fq) const {
        const int row0 = u.pm * BM + wr * 64 + fr, col = u.pn * 128 + wc * 32 + 8 * fq;
        float ra, rb; wave_rstd(ss, u.pm * BM + wr * 64, fr + 16 * fq, ra, rb);
#pragma unroll
        for (int ai = 0; ai < 2; ++ai)
#pragma unroll
            for (int m = 0; m < 4; ++m) { const int row = row0 + ai * HALF + m * 16; const float rs = __shfl(ai ? rb : ra, 16 * m + fr);
                const f32x4 g0 = acc[ai][0][m][0] * rs, g1 = acc[ai][0][m][1] * rs, u0 = acc[ai][1][m][0] * rs, u1 = acc[ai][1][m][1] * rs;
                u32x4 w; w.x = pk2(g0[0] * sigm(g0[0]) * u0[0], g0[1] * sigm(g0[1]) * u0[1]); w.y = pk2(g0[2] * sigm(g0[2]) * u0[2], g0[3] * sigm(g0[3]) * u0[3]);
                w.z = pk2(g1[0] * sigm(g1[0]) * u1[0], g1[1] * sigm(g1[1]) * u1[1]); w.w = pk2(g1[2] * sigm(g1[2]) * u1[2], g1[3] * sigm(g1[3]) * u1[3]);
                *(u32x4*)(ACT + (size_t)row * 2816 + col) = w; }
    }
};
template <class Epi, class Sched, bool ALIGN_EPI = false, bool SP2 = false>
__device__ __forceinline__ void gemm_phase(PG8_LAS unsigned char* lds, const Gemm g, const Sched& S, const Epi& E) {
    int tid_l = threadIdx.x; asm volatile("" : "+v"(tid_l));
    const int tid = tid_l, wid = __builtin_amdgcn_readfirstlane(tid >> 6), lane = tid & 63, wr = wid >> 2, wc = wid & 3, fr = lane & 15, fq = lane >> 4;
    const int K = g.K, nt = K / BK;
    unsigned voffA[2], voffB[2];
#pragma unroll
    for (int i = 0; i < 2; ++i) { int R, C; stage_rc(tid * 16 + i * 8192, R, C); const int Rb = Epi::PERM ? ((R & ~31) + perm32(R & 31)) : R;
        voffA[i] = (unsigned)(R * K + C) * 2u; voffB[i] = (unsigned)(Rb * K + C) * 2u; }
    const size_t kstep = (size_t)(BK * 2);
    const size_t hstep = (size_t)HALF * K * 2;
    const size_t tstep = 2 * hstep;
    const unsigned ldsw = (unsigned)wid * 1024u;
    const int aoff = lds_byte(wr * 64 + fr, fq * 8), boff = lds_byte(wc * 32 + fr, fq * 8);
#define PG8_SA(b, h) (((b) * 2 + (h)) * HTB)
#define PG8_SB(b, h) ((4 + (b) * 2 + (h)) * HTB)
#define PG8_STAGE(bufoff, gbase, voff) do { _Pragma("unroll") for (int _i = 0; _i < 2; ++_i) \
        __builtin_amdgcn_global_load_lds((const unsigned*)((const char*)(gbase) + (voff)[_i]), (PG8_LAS unsigned*)(lds + (bufoff) + ldsw + _i * 8192), 16, 0, 0); } while (0)
#define PG8_LDA(dst, b, h) do { _Pragma("unroll") for (int m = 0; m < 4; ++m) _Pragma("unroll") for (int k = 0; k < 2; ++k) dst[m][k] = *(const PG8_LAS bf16x8*)(lds + PG8_SA(b, h) + aoff + m * 2048 + k * 1024); } while (0)
#define PG8_LDB(dst, b, h) do { _Pragma("unroll") for (int n = 0; n < 2; ++n) _Pragma("unroll") for (int k = 0; k < 2; ++k) dst[n][k] = *(const PG8_LAS bf16x8*)(lds + PG8_SB(b, h) + boff + n * 2048 + k * 1024); } while (0)
#define PG8_MMA(ai, bj, At, Bt) do { __builtin_amdgcn_s_setprio(1); _Pragma("unroll") for (int m = 0; m < 4; ++m) _Pragma("unroll") for (int n = 0; n < 2; ++n) _Pragma("unroll") for (int k = 0; k < 2; ++k) \
        acc[ai][bj][m][n] = __builtin_amdgcn_mfma_f32_16x16x32_bf16(Bt[n][k], At[m][k], acc[ai][bj][m][n], 0, 0, 0); __builtin_amdgcn_s_setprio(0); } while (0)
#define PG8_WAIT_V(n) asm volatile("s_waitcnt vmcnt(" #n ")" ::: "memory")
#define PG8_WAIT_L(n) asm volatile("s_waitcnt lgkmcnt(" #n ")" ::: "memory")
#define PG8_BAR __builtin_amdgcn_s_barrier()
#define PG8_SCHED __builtin_amdgcn_sched_barrier(0)
    Unit cur, nxt; int ui = 0;
    if (!S.next(0, cur)) return;
    f32x4 acc[2][2][4][2];
#pragma unroll
    for (int a = 0; a < 2; ++a)
#pragma unroll
        for (int b = 0; b < 2; ++b)
#pragma unroll
            for (int m = 0; m < 4; ++m)
#pragma unroll
                for (int n = 0; n < 2; ++n) acc[a][b][m][n] = (f32x4){0.f, 0.f, 0.f, 0.f};
    bf16x8 At[4][2], B0[2][2], B1[2][2];
    const char* cA = (const char*)g.A + (size_t)cur.pm * tstep; const char* cB = (const char*)g.Bt + (size_t)cur.pn * tstep;
    S.a_ready(cur);
    if constexpr (SP2) {
        PG8_STAGE(PG8_SB(0, 0), cB, voffB); PG8_STAGE(PG8_SB(0, 1), cB + hstep, voffB); PG8_STAGE(PG8_SA(0, 0), cA, voffA); PG8_STAGE(PG8_SA(0, 1), cA + hstep, voffA);
        if (wr == 1) PG8_BAR;
        PG8_WAIT_V(2); PG8_BAR;
        PG8_STAGE(PG8_SB(1, 0), cB + kstep, voffB); PG8_STAGE(PG8_SA(1, 0), cA + kstep, voffA); PG8_STAGE(PG8_SB(1, 1), cB + hstep + kstep, voffB);
        PG8_WAIT_V(6); PG8_BAR;
    } else {
        PG8_STAGE(PG8_SB(0, 0), cB, voffB); PG8_STAGE(PG8_SA(0, 0), cA, voffA); PG8_STAGE(PG8_SB(0, 1), cB + hstep, voffB); PG8_STAGE(PG8_SA(0, 1), cA + hstep, voffA);
        if (wr == 1) PG8_BAR;
        PG8_WAIT_V(4); PG8_BAR;
        PG8_STAGE(PG8_SB(1, 0), cB + kstep, voffB); PG8_STAGE(PG8_SA(1, 0), cA + kstep, voffA); PG8_STAGE(PG8_SB(1, 1), cB + hstep + kstep, voffB);
        PG8_WAIT_V(6); PG8_BAR;
    }
    for (;;) {
        const bool has_next = S.next(ui + 1, nxt);
        const char* nA = has_next ? (const char*)g.A + (size_t)nxt.pm * tstep : cA; const char* nB = has_next ? (const char*)g.Bt + (size_t)nxt.pn * tstep : cB;
        for (int t = 0; t < nt; t += 2) {
            const bool last = (t == nt - 2);
            const char* a1 = cA + (size_t)(t + 1) * kstep;
            const char* a2 = last ? nA : cA + (size_t)(t + 2) * kstep; const char* b2 = last ? nB : cB + (size_t)(t + 2) * kstep;
            const char* a3 = a2 + kstep; const char* b3 = b2 + kstep;
            if (last && has_next) S.a_ready(nxt);
            if constexpr (SP2) {
            PG8_LDB(B0, 0, 0); PG8_LDB(B1, 0, 1); PG8_SCHED; PG8_LDA(At, 0, 0); PG8_STAGE(PG8_SA(1, 1), a1 + hstep, voffA);
            PG8_WAIT_V(8); PG8_WAIT_L(0); PG8_BAR; PG8_MMA(0, 0, At, B0); PG8_MMA(0, 1, At, B1); PG8_BAR; PG8_SCHED;
            PG8_LDA(At, 0, 1); PG8_STAGE(PG8_SB(0, 0), b2, voffB); PG8_STAGE(PG8_SB(0, 1), b2 + hstep, voffB); PG8_STAGE(PG8_SA(0, 0), a2, voffA);
            PG8_WAIT_V(8); PG8_WAIT_L(0); PG8_BAR; PG8_MMA(1, 0, At, B0); PG8_MMA(1, 1, At, B1); PG8_BAR; PG8_SCHED;
            PG8_LDB(B0, 1, 0); PG8_LDB(B1, 1, 1); PG8_SCHED; PG8_LDA(At, 1, 0); PG8_STAGE(PG8_SA(0, 1), a2 + hstep, voffA);
            PG8_WAIT_V(8); PG8_WAIT_L(0); PG8_BAR; PG8_MMA(0, 0, At, B0); PG8_MMA(0, 1, At, B1); PG8_BAR; PG8_SCHED;
            PG8_LDA(At, 1, 1); PG8_STAGE(PG8_SB(1, 0), b3, voffB); PG8_STAGE(PG8_SB(1, 1), b3 + hstep, voffB); PG8_STAGE(PG8_SA(1, 0), a3, voffA);
            PG8_WAIT_V(8); PG8_WAIT_L(0); PG8_BAR; PG8_MMA(1, 0, At, B0); PG8_MMA(1, 1, At, B1); PG8_BAR; PG8_SCHED;
            } else {
            PG8_LDB(B0, 0, 0); PG8_SCHED; PG8_LDA(At, 0, 0); PG8_STAGE(PG8_SA(1, 1), a1 + hstep, voffA);
            PG8_WAIT_L(8); PG8_BAR; PG8_WAIT_L(0); PG8_MMA(0, 0, At, B0); PG8_BAR; PG8_SCHED;
            PG8_LDB(B1, 0, 1); PG8_STAGE(PG8_SB(0, 0), b2, voffB);
            PG8_BAR; PG8_WAIT_L(0); PG8_MMA(0, 1, At, B1); PG8_BAR;
            PG8_LDA(At, 0, 1); PG8_STAGE(PG8_SA(0, 0), a2, voffA);
            PG8_BAR; PG8_WAIT_L(0); PG8_MMA(1, 0, At, B0); PG8_BAR; PG8_SCHED;
            PG8_STAGE(PG8_SB(0, 1), b2 + hstep, voffB);
            PG8_WAIT_V(6); PG8_BAR; PG8_MMA(1, 1, At, B1); PG8_BAR;
            PG8_LDB(B0, 1, 0); PG8_SCHED; PG8_LDA(At, 1, 0); PG8_STAGE(PG8_SA(0, 1), a2 + hstep, voffA);
            PG8_WAIT_L(8); PG8_BAR; PG8_WAIT_L(0); PG8_MMA(0, 0, At, B0); PG8_BAR; PG8_SCHED;
            PG8_LDB(B1, 1, 1); PG8_STAGE(PG8_SB(1, 0), b3, voffB);
            PG8_BAR; PG8_WAIT_L(0); PG8_MMA(0, 1, At, B1); PG8_BAR;
            PG8_LDA(At, 1, 1); PG8_STAGE(PG8_SA(1, 0), a3, voffA);
            PG8_BAR; PG8_WAIT_L(0); PG8_MMA(1, 0, At, B0); PG8_BAR; PG8_SCHED;
            PG8_STAGE(PG8_SB(1, 1), b3 + hstep, voffB);
            PG8_WAIT_V(6); PG8_BAR; PG8_MMA(1, 1, At, B1); PG8_BAR;
            }
        }
        if constexpr (ALIGN_EPI) { if (wr == 0) PG8_BAR; }
        if constexpr (!Epi::AFTER_DRAIN) { E(acc, cur, wr, wc, fr, fq); S.done(cur); }
        if (!has_next) break;
#pragma unroll
        for (int a = 0; a < 2; ++a)
#pragma unroll
            for (int b = 0; b < 2; ++b)
#pragma unroll
                for (int m = 0; m < 4; ++m)
#pragma unroll
                    for (int n = 0; n < 2; ++n) acc[a][b][m][n] = (f32x4){0.f, 0.f, 0.f, 0.f};
        cur = nxt; cA = nA; cB = nB; ++ui;
        if constexpr (ALIGN_EPI) { if (wr == 1) PG8_BAR; }
    }
    PG8_WAIT_V(0);
    if constexpr (!ALIGN_EPI) { if (wr == 0) PG8_BAR; }
    PG8_BAR;
    if constexpr (Epi::AFTER_DRAIN) { E.fused(acc, cur, wr, wc, fr, fq, lds, wid, lane); S.done(cur); }
#undef PG8_SA
#undef PG8_SB
#undef PG8_STAGE
#undef PG8_LDA
#undef PG8_LDB
#undef PG8_MMA
#undef PG8_WAIT_V
#undef PG8_WAIT_L
#undef PG8_BAR
#undef PG8_SCHED
}
}
using pg8::bf16_t; using pg8::f32x4; using pg8::u32x4; using pg8::bf16x8; using pg8::u32x2; using pg8::pk2; using pg8::bflo; using pg8::bfhi; using pg8::sigm; using pg8::NORM_EPS;
#define LAS __attribute__((address_space(3)))
constexpr int NB = 4, T = 8192, M = NB * T, D = 1024, INW = 4352, CC = 512, FF = 2816, GU = 2 * FF, DEPTH = 4, NHEAD = 16;
constexpr size_t MiB = 1u << 20;
constexpr size_t WS_SS = 450 * MiB, SS_BUF = 2 * MiB;
constexpr size_t WS_ROPE = 1 * MiB;
constexpr size_t WS_W = 2 * MiB, W_LAYER = 28 * MiB;
constexpr size_t WO_IN = 0, WO_PW = 8 * MiB + MiB / 2, WO_OUT = WO_PW + 1 * MiB, WO_GU = WO_OUT + 2 * MiB, WO_DN = WO_GU + 11 * MiB;
constexpr size_t WS_XB = 114 * MiB, WS_QO = 178 * MiB, WS_KV = 242 * MiB, WS_A = 258 * MiB, WS_G = 290 * MiB, WS_Y = 418 * MiB, WS_BAR = 455 * MiB, WS_END = 456 * MiB;
constexpr size_t WS_LOB = 354 * MiB;
constexpr size_t WS_ACT = 178 * MiB;
static_assert(WO_DN + (size_t)D * FF * 2 == W_LAYER && WS_W + DEPTH * W_LAYER == WS_XB && WS_ACT + (size_t)M * FF * 2 <= WS_Y, "ws map");
constexpr int LDS_BYTES = 132096;

__device__ __forceinline__ float wave_sum(float v) {
#pragma unroll
    for (int o = 1; o < 64; o <<= 1) v += __shfl_xor(v, o);
    return v;
}

namespace att {
typedef __attribute__((ext_vector_type(16))) float f32x16;
typedef __attribute__((ext_vector_type(4))) short s16x4;
constexpr int KPB = 144, VPB = 520, OFF_V = 256 * KPB, SCR_OFF = 71680, SCR_WAVE = 4608;
constexpr float LOG2E = 1.4426950408889634f;
__device__ __forceinline__ int crow(int r, int hi) { return (r & 3) + 8 * (r >> 2) + 4 * hi; }

struct KVRaw { u32x4 kr[4], v0[2], v1[2]; f32x4 cs[4]; };
__device__ __forceinline__ void kv_fetch(KVRaw& R, const bf16_t* KV, const float* rope, int b, int kvh, int blk, int tid) {
    { const int row = tid >> 1, half = tid & 1, pos = blk * 128 - 128 + row; const bool valid = pos >= 0;
      const bf16_t* src = KV + (size_t)(b * T + pos) * 256 + kvh * 64 + half * 32;
#pragma unroll
      for (int i = 0; i < 4; ++i) { R.kr[i] = (u32x4){0u, 0u, 0u, 0u}; R.cs[i] = (f32x4){0.f, 0.f, 0.f, 0.f}; if (valid) { R.kr[i] = *(const u32x4*)(src + 8 * i); R.cs[i] = *(const f32x4*)(rope + pos * 16 + 4 * i); } } }
    { const int rp = tid >> 2, c = tid & 3, pos0 = blk * 128 - 128 + 2 * rp; const bool valid = pos0 >= 0;
      const bf16_t* src = KV + (size_t)(b * T + pos0) * 256 + 128 + kvh * 64 + 16 * c;
#pragma unroll
      for (int i = 0; i < 2; ++i) { R.v0[i] = (u32x4){0u, 0u, 0u, 0u}; R.v1[i] = R.v0[i]; if (valid) { R.v0[i] = *(const u32x4*)(src + 8 * i); R.v1[i] = *(const u32x4*)(src + 256 + 8 * i); } } }
}
__device__ __forceinline__ void unit(LAS unsigned char* lds, int b, int kvh, int blk, bf16_t* QO, const bf16_t* KV, const bf16_t* GA, const float* qn, const float* kn, const float* sinks,
                                     const float* rope, int tid, int lane, int wave) {
    const int h = kvh * 8 + wave, q = lane & 31, hi = lane >> 5, crow8 = lane >> 3, cch = lane & 7;
    u32x4 qrN[4]; u32x2 gtN[4]; f32x4 rpN[4];
#define AT_LOAD(sub_) do { const size_t tr_ = (size_t)(b * T + blk * 128 + 32 * (sub_)); const int tq_ = blk * 128 + 32 * (sub_) + q; \
        _Pragma("unroll") for (int i = 0; i < 4; ++i) { qrN[i] = *(const u32x4*)(QO + (tr_ + crow8 + 8 * i) * 1024 + h * 64 + cch * 8); gtN[i] = *(const u32x2*)((const unsigned char*)GA + (tr_ + crow8 + 8 * i) * 2048 + h * 64 + cch * 8); \
            rpN[i] = *(const f32x4*)(rope + tq_ * 16 + 4 * i); } } while (0)
    KVRaw R; kv_fetch(R, KV, rope, b, kvh, blk, tid);
    AT_LOAD(0);
    {
        const int row = tid >> 1, half = tid & 1, pos = blk * 128 - 128 + row; const bool valid = pos >= 0;
        float x[32]; float ssq = 0.f;
#pragma unroll
        for (int i = 0; i < 4; ++i) { const u32x4 r = R.kr[i];
            x[8 * i + 0] = bflo(r.x); x[8 * i + 1] = bfhi(r.x); x[8 * i + 2] = bflo(r.y); x[8 * i + 3] = bfhi(r.y); x[8 * i + 4] = bflo(r.z); x[8 * i + 5] = bfhi(r.z); x[8 * i + 6] = bflo(r.w); x[8 * i + 7] = bfhi(r.w); }
#pragma unroll
        for (int i = 0; i < 32; ++i) ssq += x[i] * x[i];
        ssq += __shfl_xor(ssq, 1);
        const float rstd = rsqrtf(ssq * (1.0f / 64.0f) + NORM_EPS);
#pragma unroll
        for (int i = 0; i < 8; ++i) { const f32x4 g = *(const f32x4*)(kn + half * 32 + 4 * i); x[4 * i] *= rstd * g[0]; x[4 * i + 1] *= rstd * g[1]; x[4 * i + 2] *= rstd * g[2]; x[4 * i + 3] *= rstd * g[3]; }
        if (half == 0 && valid) {
#pragma unroll
            for (int i = 0; i < 8; ++i) { const float c = R.cs[i >> 2][i & 3], s = R.cs[2 + (i >> 2)][i & 3], x1 = x[i], x2 = x[8 + i]; x[i] = x1 * c - x2 * s; x[8 + i] = x2 * c + x1 * s; } }
#pragma unroll
        for (int i = 0; i < 4; ++i) { u32x4 w; w.x = pk2(x[8 * i], x[8 * i + 1]); w.y = pk2(x[8 * i + 2], x[8 * i + 3]); w.z = pk2(x[8 * i + 4], x[8 * i + 5]); w.w = pk2(x[8 * i + 6], x[8 * i + 7]);
            *(LAS u32x4*)(lds + row * KPB + half * 64 + 16 * i) = w; }
    }
    {
        const int rp = tid >> 2, c = tid & 3;
#pragma unroll
        for (int w = 0; w < 8; ++w) { const unsigned a = R.v0[w >> 2][w & 3], bb = R.v1[w >> 2][w & 3]; const int d = 16 * c + 2 * w;
            *(LAS unsigned*)(lds + OFF_V + d * VPB + rp * 4) = (a & 0xffffu) | (bb << 16);
            *(LAS unsigned*)(lds + OFF_V + (d + 1) * VPB + rp * 4) = (a >> 16) | (bb & 0xffff0000u); }
    }
    __syncthreads();
    const float sink2 = sinks[h] * LOG2E;
#pragma unroll 1
    for (int sub = 0; sub < 4; ++sub) {
        const int tq = blk * 128 + 32 * sub + q;
        LAS unsigned char* scr = lds + SCR_OFF + wave * SCR_WAVE;
        const size_t trow = (size_t)(b * T + blk * 128 + 32 * sub);
        u32x2 gtc[4]; f32x4 rp[4];
#pragma unroll
        for (int i = 0; i < 4; ++i) { gtc[i] = gtN[i]; rp[i] = rpN[i]; *(LAS u32x4*)(scr + (crow8 + 8 * i) * 144 + cch * 16) = qrN[i]; }
        if (sub < 3) AT_LOAD(sub + 1);
        asm volatile("s_waitcnt lgkmcnt(0)" ::: "memory");
        float x[4][8]; float ssq = 0.f;
#pragma unroll
        for (int d0 = 0; d0 < 4; ++d0) { const u32x4 r = *(const LAS u32x4*)(scr + q * 144 + (16 * d0 + 8 * hi) * 2);
            x[d0][0] = bflo(r.x); x[d0][1] = bfhi(r.x); x[d0][2] = bflo(r.y); x[d0][3] = bfhi(r.y); x[d0][4] = bflo(r.z); x[d0][5] = bfhi(r.z); x[d0][6] = bflo(r.w); x[d0][7] = bfhi(r.w); }
#pragma unroll
        for (int d0 = 0; d0 < 4; ++d0)
#pragma unroll
            for (int i = 0; i < 8; ++i) ssq += x[d0][i] * x[d0][i];
        ssq += __shfl_xor(ssq, 32);
        const float rstd = rsqrtf(ssq * (1.0f / 64.0f) + NORM_EPS) * (0.125f * LOG2E);
#pragma unroll
        for (int d0 = 0; d0 < 4; ++d0) { const f32x4 g0 = *(const f32x4*)(qn + 16 * d0 + 8 * hi), g1 = *(const f32x4*)(qn + 16 * d0 + 8 * hi + 4);
            x[d0][0] *= rstd * g0[0]; x[d0][1] *= rstd * g0[1]; x[d0][2] *= rstd * g0[2]; x[d0][3] *= rstd * g0[3]; x[d0][4] *= rstd * g1[0]; x[d0][5] *= rstd * g1[1]; x[d0][6] *= rstd * g1[2]; x[d0][7] *= rstd * g1[3]; }
#pragma unroll
        for (int i = 0; i < 8; ++i) { const float c = rp[i >> 2][i & 3], s = rp[2 + (i >> 2)][i & 3], me = x[0][i], ot = __shfl_xor(me, 32); x[0][i] = hi == 0 ? me * c - ot * s : me * c + ot * s; }
        bf16x8 qf[4];
#pragma unroll
        for (int d0 = 0; d0 < 4; ++d0) { u32x4 w; w.x = pk2(x[d0][0], x[d0][1]); w.y = pk2(x[d0][2], x[d0][3]); w.z = pk2(x[d0][4], x[d0][5]); w.w = pk2(x[d0][6], x[d0][7]); qf[d0] = __builtin_bit_cast(bf16x8, w); }
        f32x16 p[5];
#pragma unroll
        for (int kt = 0; kt < 5; ++kt) {
#pragma unroll
            for (int r = 0; r < 16; ++r) p[kt][r] = 0.f;
#pragma unroll
            for (int d0 = 0; d0 < 4; ++d0) { const bf16x8 kf = *(const LAS bf16x8*)(lds + (32 * (sub + kt) + q) * KPB + (16 * d0 + 8 * hi) * 2);
                p[kt] = __builtin_amdgcn_mfma_f32_32x32x16_bf16(kf, qf[d0], p[kt], 0, 0, 0); } }
        const bool first = (blk == 0);
        bool lowtri[16];
#pragma unroll
        for (int r = 0; r < 16; ++r) lowtri[r] = crow(r, hi) <= q;
        f32x16 pc;
#pragma unroll
        for (int r = 0; r < 16; ++r) pc[r] = lowtri[r] ? p[4][r] : (first ? -INFINITY : p[0][r]);
        if (first) {
#pragma unroll
            for (int kt = 1; kt < 4; ++kt) if (sub + kt < 4) {
#pragma unroll
                for (int r = 0; r < 16; ++r) p[kt][r] = -INFINITY; } }
        float mx = sink2;
#pragma unroll
        for (int r = 0; r < 16; ++r) mx = fmaxf(fmaxf(mx, pc[r]), fmaxf(fmaxf(p[1][r], p[2][r]), p[3][r]));
        mx = fmaxf(mx, __shfl_xor(mx, 32));
#pragma unroll
        for (int r = 0; r < 16; ++r) { pc[r] = __builtin_amdgcn_exp2f(pc[r] - mx); p[1][r] = __builtin_amdgcn_exp2f(p[1][r] - mx); p[2][r] = __builtin_amdgcn_exp2f(p[2][r] - mx); p[3][r] = __builtin_amdgcn_exp2f(p[3][r] - mx); }
        const f32x16 sv = (pc + p[1]) + (p[2] + p[3]);
        float lsum = ((sv[0] + sv[1]) + (sv[2] + sv[3])) + ((sv[4] + sv[5]) + (sv[6] + sv[7])) + (((sv[8] + sv[9]) + (sv[10] + sv[11])) + ((sv[12] + sv[13]) + (sv[14] + sv[15])));
        lsum += __shfl_xor(lsum, 32); lsum += __builtin_amdgcn_exp2f(sink2 - mx);
        const float inv = 1.0f / lsum;
#pragma unroll
        for (int r = 0; r < 16; ++r) { p[0][r] = lowtri[r] ? 0.f : pc[r]; p[4][r] = lowtri[r] ? pc[r] : 0.f; }
        f32x16 o[2];
#pragma unroll
        for (int r = 0; r < 16; ++r) { o[0][r] = 0.f; o[1][r] = 0.f; }
#pragma unroll
        for (int kt = 0; kt < 5; ++kt)
#pragma unroll
            for (int s = 0; s < 2; ++s) { u32x4 w; w.x = pk2(p[kt][8 * s], p[kt][8 * s + 1]); w.y = pk2(p[kt][8 * s + 2], p[kt][8 * s + 3]); w.z = pk2(p[kt][8 * s + 4], p[kt][8 * s + 5]); w.w = pk2(p[kt][8 * s + 6], p[kt][8 * s + 7]);
                const bf16x8 pf = __builtin_bit_cast(bf16x8, w);
#pragma unroll
                for (int d0 = 0; d0 < 2; ++d0) { const LAS unsigned char* vp = lds + OFF_V + (32 * d0 + q) * VPB + (32 * (sub + kt) + 16 * s + 4 * hi) * 2;
                    const s16x4 lo = *(const LAS s16x4*)vp, hi4 = *(const LAS s16x4*)(vp + 16);
                    const bf16x8 vf = (bf16x8){lo[0], lo[1], lo[2], lo[3], hi4[0], hi4[1], hi4[2], hi4[3]};
                    o[d0] = __builtin_amdgcn_mfma_f32_32x32x16_bf16(vf, pf, o[d0], 0, 0, 0); } }
        asm volatile("s_waitcnt lgkmcnt(0)" ::: "memory");
#pragma unroll
        for (int d0 = 0; d0 < 2; ++d0)
#pragma unroll
            for (int g = 0; g < 4; ++g) { u32x2 w; w.x = pk2(o[d0][4 * g] * inv, o[d0][4 * g + 1] * inv); w.y = pk2(o[d0][4 * g + 2] * inv, o[d0][4 * g + 3] * inv);
                *(LAS u32x2*)(scr + q * 144 + (32 * d0 + 8 * g + 4 * hi) * 2) = w; }
        asm volatile("s_waitcnt lgkmcnt(0)" ::: "memory");
#pragma unroll
        for (int i = 0; i < 4; ++i) { const u32x4 ov = *(const LAS u32x4*)(scr + (crow8 + 8 * i) * 144 + cch * 16); const u32x2 gg = gtc[i]; u32x4 w;
            w.x = pk2(bflo(ov.x) * pg8::d8(gg.x, 0), bfhi(ov.x) * pg8::d8(gg.x, 1)); w.y = pk2(bflo(ov.y) * pg8::d8(gg.x, 2), bfhi(ov.y) * pg8::d8(gg.x, 3));
            w.z = pk2(bflo(ov.z) * pg8::d8(gg.y, 0), bfhi(ov.z) * pg8::d8(gg.y, 1)); w.w = pk2(bflo(ov.w) * pg8::d8(gg.y, 2), bfhi(ov.w) * pg8::d8(gg.y, 3));
            *(u32x4*)(QO + (trow + crow8 + 8 * i) * 1024 + h * 64 + cch * 8) = w; }
        asm volatile("s_waitcnt lgkmcnt(0)" ::: "memory");
    }
#undef AT_LOAD
    __syncthreads();
}
}

namespace cv {
constexpr int ROWS = 62, OFF_Y = ROWS * 1024, NU = M / 32;
typedef pg8::f32x2_t f32x2;
__device__ __forceinline__ void phase(LAS unsigned char* lds, int bx, int G, const bf16_t* A, bf16_t* Y, const float* cw, const float* cb, const float* lg, const float* lb, int tid, int lane, int wave) {
    const int cp = tid & 255, tg = tid >> 8;
    f32x2 wv[31];
#pragma unroll
    for (int j = 0; j < 31; ++j) wv[j] = *(const f32x2*)(cw + j * CC + 2 * cp);
    const f32x2 bias = *(const f32x2*)(cb + 2 * cp);
    const f32x4 g0 = *(const f32x4*)(lg + 4 * lane), g1 = *(const f32x4*)(lg + 256 + 4 * lane), b0 = *(const f32x4*)(lb + 4 * lane), b1 = *(const f32x4*)(lb + 256 + 4 * lane);
    u32x4 pre[8];
#define CV_FETCH(un) do { const int t0_ = (un) * 32, p0_ = t0_ & (T - 1); _Pragma("unroll") for (int i = 0; i < 8; ++i) { const int idx = tid + 512 * i, r = idx >> 6, ch = idx & 63; pre[i] = (u32x4){0u, 0u, 0u, 0u}; \
        if (idx < ROWS * 64 && p0_ - 30 + r >= 0) pre[i] = *(const u32x4*)(A + (size_t)(t0_ - 30 + r) * CC + ch * 8); } } while (0)
    int un = bx;
    if (un < NU) CV_FETCH(un);
#pragma unroll 1
    for (; un < NU; un += G) {
        const int t0 = un * 32;
#pragma unroll
        for (int i = 0; i < 8; ++i) { const int idx = tid + 512 * i; if (idx < ROWS * 64) *(LAS u32x4*)(lds + idx * 16) = pre[i]; }
        __syncthreads();
        if (un + G < NU) CV_FETCH(un + G);
#pragma unroll 1
        for (int sb = 0; sb < 2; ++sb) { const int tb = 16 * tg + 8 * sb;
            f32x2 ac[8];
#pragma unroll
            for (int i = 0; i < 8; ++i) ac[i] = bias;
#pragma unroll
            for (int rr = 0; rr < 38; ++rr) { const unsigned v = *(const LAS unsigned*)(lds + (tb + rr) * 1024 + cp * 4); const f32x2 vv = (f32x2){bflo(v), bfhi(v)};
#pragma unroll
                for (int i = 0; i < 8; ++i) { const int j = rr - i; if (j >= 0 && j <= 30) ac[i] = __builtin_elementwise_fma(wv[j], vv, ac[i]); } }
#pragma unroll
            for (int i = 0; i < 8; ++i) *(LAS f32x2*)(lds + OFF_Y + (tb + i) * 2048 + cp * 8) = ac[i]; }
        __syncthreads();
#pragma unroll
        for (int k = 0; k < 4; ++k) { const int tok = 4 * wave + k;
            f32x4 v0 = *(const LAS f32x4*)(lds + OFF_Y + tok * 2048 + lane * 16), v1 = *(const LAS f32x4*)(lds + OFF_Y + tok * 2048 + 1024 + lane * 16);
            const float mean = wave_sum((v0[0] + v0[1]) + (v0[2] + v0[3]) + (v1[0] + v1[1]) + (v1[2] + v1[3])) * (1.0f / 512.0f);
            v0 = v0 - mean; v1 = v1 - mean;
            const float var = wave_sum((v0[0] * v0[0] + v0[1] * v0[1]) + (v0[2] * v0[2] + v0[3] * v0[3]) + (v1[0] * v1[0] + v1[1] * v1[1]) + (v1[2] * v1[2] + v1[3] * v1[3])) * (1.0f / 512.0f);
            const float rstd = rsqrtf(var + NORM_EPS);
            v0 = v0 * rstd * g0 + b0; v1 = v1 * rstd * g1 + b1;
            u32x2 w0, w1; w0.x = pk2(v0[0] * sigm(v0[0]), v0[1] * sigm(v0[1])); w0.y = pk2(v0[2] * sigm(v0[2]), v0[3] * sigm(v0[3]));
            w1.x = pk2(v1[0] * sigm(v1[0]), v1[1] * sigm(v1[1])); w1.y = pk2(v1[2] * sigm(v1[2]), v1[3] * sigm(v1[3]));
            bf16_t* yp = Y + (size_t)(t0 + tok) * CC + 4 * lane; *(u32x2*)yp = w0; *(u32x2*)(yp + 256) = w1; }
        __syncthreads();
    }
#undef CV_FETCH
}
}
__device__ __forceinline__ void transpose_item(const float* W, int K, int N, bf16_t* WT, int k0, int n0s, int n0d, const float* gain, LAS float* scr, int lane) {
    const int r8 = lane >> 3, c4 = (lane & 7) * 4;
    f32x4 v[8]; float gs[8];
#pragma unroll
    for (int i = 0; i < 8; ++i) { v[i] = *(const f32x4*)(W + (size_t)(k0 + 8 * i + r8) * N + n0s + c4); gs[i] = gain ? gain[k0 + 8 * i + r8] : 1.0f; }
#pragma unroll
    for (int i = 0; i < 8; ++i) { LAS float* d = scr + (8 * i + r8) * 33 + c4; d[0] = v[i][0] * gs[i]; d[1] = v[i][1] * gs[i]; d[2] = v[i][2] * gs[i]; d[3] = v[i][3] * gs[i]; }
    asm volatile("s_waitcnt lgkmcnt(0)" ::: "memory");
    const int c = lane & 7;
#pragma unroll
    for (int j = 0; j < 4; ++j) { const int n = (lane >> 3) + 8 * j; const LAS float* s = scr + (8 * c) * 33 + n;
        u32x4 o; o.x = pk2(s[0 * 33], s[1 * 33]); o.y = pk2(s[2 * 33], s[3 * 33]); o.z = pk2(s[4 * 33], s[5 * 33]); o.w = pk2(s[6 * 33], s[7 * 33]);
        *(u32x4*)(WT + (size_t)(n0d + n) * K + k0 + 8 * c) = o; }
    asm volatile("s_waitcnt lgkmcnt(0)" ::: "memory");
}
__device__ __forceinline__ int perm_in(int n0d) { const int pn = n0d >> 8, h = (n0d >> 7) & 1, j = n0d & 127; if (pn >= 5 && pn < 9) return (h ? 1792 : 1280) + 128 * (pn - 5) + j; return n0d; }
__device__ __forceinline__ int perm_gu(int n0d) { const int pn = n0d >> 8, h = (n0d >> 7) & 1, j = n0d & 127; return (h ? FF : 0) + 128 * pn + j; }

struct Args { const float* in[15]; float* out; unsigned char* ws; int ph_lo, ph_hi; };
enum { I_X = 0, I_NMIX, I_WIN, I_QN, I_KN, I_SINK, I_CW, I_CB, I_LG, I_LB, I_WPW, I_WOUT, I_NFFN, I_WGU, I_WDN };

__device__ __forceinline__ void convert_layer(const Args& a, int l, int slot, int nslots, LAS float* scr, int lane) {
    constexpr int I_IN = (D / 64) * (INW / 32), I_PW = (CC / 64) * (D / 32), I_OUT = (D / 64) * (D / 32), I_GU = (D / 64) * (GU / 32), I_DN = (FF / 64) * (D / 32), PER_L = I_IN + I_PW + I_OUT + I_GU + I_DN;
    unsigned char* wb = a.ws + WS_W + (size_t)l * W_LAYER;
    for (int it = slot; it < PER_L; it += nslots) {
        int r = it;
        if (r < I_IN) { const int nblk = INW / 32, kb = r / nblk, nb = r % nblk; transpose_item(a.in[I_WIN] + (size_t)l * D * INW, D, INW, (bf16_t*)(wb + WO_IN), 64 * kb, perm_in(32 * nb), 32 * nb, a.in[I_NMIX] + l * D, scr, lane); continue; } r -= I_IN;
        if (r < I_PW) { const int nblk = D / 32, kb = r / nblk, nb = r % nblk; transpose_item(a.in[I_WPW] + (size_t)l * CC * D, CC, D, (bf16_t*)(wb + WO_PW), 64 * kb, 32 * nb, 32 * nb, nullptr, scr, lane); continue; } r -= I_PW;
        if (r < I_OUT) { const int nblk = D / 32, kb = r / nblk, nb = r % nblk; transpose_item(a.in[I_WOUT] + (size_t)l * D * D, D, D, (bf16_t*)(wb + WO_OUT), 64 * kb, 32 * nb, 32 * nb, nullptr, scr, lane); continue; } r -= I_OUT;
        if (r < I_GU) { const int nblk = GU / 32, kb = r / nblk, nb = r % nblk; transpose_item(a.in[I_WGU] + (size_t)l * D * GU, D, GU, (bf16_t*)(wb + WO_GU), 64 * kb, perm_gu(32 * nb), 32 * nb, a.in[I_NFFN] + l * D, scr, lane); continue; } r -= I_GU;
        { const int nblk = D / 32, kb = r / nblk, nb = r % nblk; transpose_item(a.in[I_WDN] + (size_t)l * FF * D, FF, D, (bf16_t*)(wb + WO_DN), 64 * kb, 32 * nb, 32 * nb, nullptr, scr, lane); }
    }
}
__device__ __forceinline__ void prologue(const Args& a, LAS unsigned char* lds, int tid, int lane, int wave) {
    LAS float* scr = (LAS float*)(lds + wave * 16384);
    const int gw = blockIdx.x * 8 + wave, NGW = gridDim.x * 8;
    const int lw = gridDim.x == 256 ? 1 : DEPTH;
    for (int l = 0; l < lw; ++l) convert_layer(a, l, gw, NGW, scr, lane);
    float* ss = (float*)(a.ws + WS_SS); bf16_t* XB = (bf16_t*)(a.ws + WS_XB);
    unsigned char* LOA = (unsigned char*)a.out;
    for (int m = gw; m < M; m += NGW) { const f32x4* xr = (const f32x4*)(a.in[I_X] + (size_t)m * D) + lane; u32x2* xo = (u32x2*)(XB + (size_t)m * D) + lane; unsigned* lo = (unsigned*)(LOA + (size_t)m * D) + lane; float s = 0.f;
#pragma unroll
        for (int j = 0; j < 4; ++j) { const f32x4 v = xr[64 * j]; s += (v[0] * v[0] + v[1] * v[1]) + (v[2] * v[2] + v[3] * v[3]); u32x2 w; w.x = pk2(v[0], v[1]); w.y = pk2(v[2], v[3]); xo[64 * j] = w;
            lo[64 * j] = pg8::lo8_enc(v[0], w.x & 0xffffu) | (pg8::lo8_enc(v[1], w.x >> 16) << 8) | (pg8::lo8_enc(v[2], w.y & 0xffffu) << 16) | (pg8::lo8_enc(v[3], w.y >> 16) << 24); }
        s = wave_sum(s); if (lane < 16) ss[(size_t)m * 16 + lane] = lane == 0 ? s : 0.f; }
    float* rope = (float*)(a.ws + WS_ROPE);
    for (int i = blockIdx.x * 512 + tid; i < T * 8; i += gridDim.x * 512) { const int t = i >> 3, f = i & 7;
        double fr = 1.0; for (int k = 0; k < f; ++k) fr *= 0.19392274474868576;
        const float inv_freq = (float)fr; const float ang = (float)t * inv_freq;
        const double x = (double)ang, kq = __builtin_rint(x * 0.6366197723675814);
        const double r = __builtin_fma(-kq, 6.123233995736766e-17, __builtin_fma(-kq, 1.5707963267948966, x)), r2 = r * r;
        const double sp = r * (1.0 + r2 * (-1.0 / 6 + r2 * (1.0 / 120 + r2 * (-1.0 / 5040 + r2 * (1.0 / 362880 + r2 * (-1.0 / 39916800 + r2 * (1.0 / 6227020800.0)))))));
        const double cp = 1.0 + r2 * (-0.5 + r2 * (1.0 / 24 + r2 * (-1.0 / 720 + r2 * (1.0 / 40320 + r2 * (-1.0 / 3628800 + r2 * (1.0 / 479001600 + r2 * (-1.0 / 87178291200.0)))))));
        const int qd = ((int)kq) & 3;
        const double sn = qd == 0 ? sp : qd == 1 ? cp : qd == 2 ? -sp : -cp, cn = qd == 0 ? cp : qd == 1 ? -sp : qd == 2 ? -cp : sp;
        rope[t * 16 + f] = (float)cn; rope[t * 16 + 8 + f] = (float)sn; }
}

#define XB_TMO      128
#define XB_XCNT(j)  (256  + 64 * (j))
#define XB_XSUB(j)  (1280 + 64 * (j))
#define XB_XGEN(j)  (2304 + 64 * (j))
#define XB_TOP      3328
#define XB_TOPGEN   3392
#define XCD_BAR_WORDS 3456
#define XB_SPIN_CAP (1u << 18)

__device__ __forceinline__ unsigned xb_ld(unsigned* p)              { return __hip_atomic_load(p, __ATOMIC_RELAXED, __HIP_MEMORY_SCOPE_AGENT); }
__device__ __forceinline__ unsigned xb_add(unsigned* p, unsigned v) { return __hip_atomic_fetch_add(p, v, __ATOMIC_RELAXED, __HIP_MEMORY_SCOPE_AGENT); }
__device__ __forceinline__ unsigned xb_xcc_id() { return (unsigned)__builtin_amdgcn_s_getreg((3 << 11) | 20) & 0xFu; }
#define XB_SPIN(cond, bar) do { unsigned _sp = 0; while (cond) { __builtin_amdgcn_s_sleep(1); \
    if ((++_sp & 255u) == 0u) { if (xb_ld(&(bar)[XB_TMO])) break; if (_sp > XB_SPIN_CAP) { atomicAdd(&(bar)[XB_TMO], 1u); break; } } } } while (0)

struct XcdBarrier {
    unsigned* bar; unsigned x;
    volatile LAS unsigned* st;
};

__device__ __forceinline__ XcdBarrier xcd_barrier_post(unsigned* bar, volatile LAS unsigned* st) {
    XcdBarrier b; b.bar = bar; b.x = xb_xcc_id(); b.st = st;
    if (threadIdx.x == 0) (void)xb_add(&bar[XB_XCNT(b.x)], 1u);
    return b;
}
__device__ __forceinline__ void xcd_barrier_complete(unsigned* bar, unsigned x, unsigned& nloc, unsigned& nx) {
    const unsigned G = gridDim.x * gridDim.y * gridDim.z;
    unsigned sum, cnt, mine, sp = 0u;
    for (;;) {
        sum = 0u; cnt = 0u; mine = 0u;
#pragma unroll
        for (unsigned j = 0; j < 16; ++j) { const unsigned c = xb_ld(&bar[XB_XCNT(j)]); sum += c; cnt += (c > 0u) ? 1u : 0u; mine = (j == x) ? c : mine; }
        if (sum == G) break;
        __builtin_amdgcn_s_sleep(1);
        if ((++sp & 255u) == 0u) { if (xb_ld(&bar[XB_TMO])) break; if (sp > XB_SPIN_CAP) { atomicAdd(&bar[XB_TMO], 1u); break; } }
    }
    nloc = mine > 0u ? mine : 1u; nx = cnt > 0u ? cnt : 1u;
}

__device__ __forceinline__ void xcd_barrier(const XcdBarrier& b) {
    asm volatile("s_waitcnt vmcnt(0)" ::: "memory");
    __syncthreads();
    if (threadIdx.x == 0) {
        unsigned* bar = b.bar;
        __builtin_amdgcn_s_waitcnt(0);
        unsigned nloc = b.st[0], nx = b.st[1];
        if (nloc == 0u) { xcd_barrier_complete(bar, b.x, nloc, nx); b.st[0] = nloc; b.st[1] = nx; }
        const unsigned old = xb_add(&bar[XB_XSUB(b.x)], 1u);
        const unsigned gen = old / nloc;
        if (old + 1u == (gen + 1u) * nloc) {
            __builtin_amdgcn_fence(__ATOMIC_RELEASE, "agent");
            asm volatile("s_waitcnt vmcnt(0)" ::: "memory");
            const unsigned og = xb_add(&bar[XB_TOP], 1u);
            const unsigned tg = og / nx;
            if (og + 1u == (tg + 1u) * nx) xb_add(&bar[XB_TOPGEN], 1u);
            else XB_SPIN(xb_ld(&bar[XB_TOPGEN]) == tg, bar);
            __builtin_amdgcn_fence(__ATOMIC_ACQUIRE, "agent");
            xb_add(&bar[XB_XGEN(b.x)], 1u);
            asm volatile("s_waitcnt vmcnt(0)" ::: "memory");
        } else {
            XB_SPIN(xb_ld(&bar[XB_XGEN(b.x)]) == gen, bar);
            __builtin_amdgcn_fence(__ATOMIC_ACQUIRE, "agent");
            asm volatile("s_waitcnt vmcnt(0)" ::: "memory");
        }
    }
    __syncthreads();
}

#ifndef PROBE
#define PROBE 0
#endif
#define tsb ((LAS unsigned long long*)(lds + 131072))
#ifndef PROBE_A
#define PROBE_A 2
#endif
#ifndef PROBE_B
#define PROBE_B 3
#endif
#ifndef PROBE_SA
#define PROBE_SA 0.01f
#endif
#ifndef PROBE_SB
#define PROBE_SB 0.01f
#endif
constexpr int N_PHASES = 1 + 6 * DEPTH;
__global__ void __launch_bounds__(512, 2) fwd_kernel(Args a) {
    extern __shared__ __attribute__((aligned(16))) unsigned char lds_raw[];
    LAS unsigned char* lds = (LAS unsigned char*)lds_raw;
    cg::grid_group grid = cg::this_grid();
    volatile LAS unsigned* bst = (volatile LAS unsigned*)(lds + 131072 + 768);
    if (threadIdx.x < 2) bst[threadIdx.x] = 0u;
    __syncthreads();
    const XcdBarrier xbar = xcd_barrier_post((unsigned*)(a.ws + WS_BAR), bst);
    const int G = gridDim.x, bx = blockIdx.x;
    unsigned char* ws = a.ws;
    float* ss = (float*)(ws + WS_SS); const float* rope = (const float*)(ws + WS_ROPE);
    bf16_t* XB = (bf16_t*)(ws + WS_XB); bf16_t* QO = (bf16_t*)(ws + WS_QO); bf16_t* KV = (bf16_t*)(ws + WS_KV); bf16_t* AB = (bf16_t*)(ws + WS_A);
    bf16_t* GB = (bf16_t*)(ws + WS_G); bf16_t* YB = (bf16_t*)(ws + WS_Y); bf16_t* ACT = (bf16_t*)(ws + WS_ACT);
#pragma unroll 1
    for (int ph = a.ph_lo; ph < a.ph_hi; ++ph) {
        if (ph > a.ph_lo) { if (ph == 1) grid.sync(); else xcd_barrier(xbar); }
        int tid_l = threadIdx.x; asm volatile("" : "+v"(tid_l));
#if PROBE
        if (threadIdx.x == 0) tsb[ph] = __builtin_amdgcn_s_memrealtime();
#endif
        const int tid = tid_l, lane = tid & 63, wave = __builtin_amdgcn_readfirstlane(tid >> 6);
        if (ph == 0) { prologue(a, lds, tid, lane, wave); continue; }
        const int l = (ph - 1) / 6, s = (ph - 1) % 6;
        const unsigned char* wb = ws + WS_W + (size_t)l * W_LAYER;
        if (s == 0) {
            pg8::Gemm g{XB, (const bf16_t*)(wb + WO_IN), M, INW, D}; pg8::StaticOrder S; S.init(M, INW, G, bx);
            pg8::EpiIn E{QO, KV, AB, GB, ss};
            pg8::gemm_phase<pg8::EpiIn, pg8::StaticOrder, true, true>(lds, g, S, E);
            if (G == 256 && bx >= 128 && l + 1 < DEPTH) convert_layer(a, l + 1, (bx - 128) * 8 + wave, 128 * 8, (LAS float*)(lds + wave * 16384), lane);
        } else if (s == 1) {
            for (int u = bx; u < NB * 2 * (T / 128); u += G) { const int blk = u & 63, kvh = (u >> 6) & 1, b = u >> 7;
                att::unit(lds, b, kvh, blk, QO, KV, GB, a.in[I_QN] + l * 64, a.in[I_KN] + l * 64, a.in[I_SINK] + l * NHEAD, rope, tid, lane, wave); }
#if PROBE
            if (threadIdx.x == 0) tsb[32 + l] = __builtin_amdgcn_s_memrealtime();
#endif
            cv::phase(lds, bx, G, AB, YB, a.in[I_CW] + (size_t)l * 31 * CC, a.in[I_CB] + l * CC, a.in[I_LG] + l * CC, a.in[I_LB] + l * CC, tid, lane, wave);
        } else if (s == 2) {
            pg8::Gemm g{YB, (const bf16_t*)(wb + WO_PW), M, D, CC}; pg8::StaticOrder S; S.init(M, D, G, bx);
            pg8::EpiMerge E{QO, GB};
            pg8::gemm_phase<pg8::EpiMerge, pg8::StaticOrder, true, true>(lds, g, S, E);
        } else if (s == 3) {
            pg8::Gemm g{QO, (const bf16_t*)(wb + WO_OUT), M, D, D}; pg8::StaticOrder S; S.init(M, D, G, bx);
            pg8::EpiRes E{(const unsigned char*)a.out, (unsigned char*)(ws + WS_LOB), XB, a.out, ss + (size_t)M * 16, 1};
            pg8::gemm_phase<pg8::EpiRes, pg8::StaticOrder, true, true>(lds, g, S, E);
        } else if (s == 4) {
            pg8::Gemm g{XB, (const bf16_t*)(wb + WO_GU), M, GU, D}; pg8::StaticOrder S; S.init(M, GU, G, bx);
            pg8::EpiSwiglu E{ACT, ss + (size_t)M * 16};
            pg8::gemm_phase<pg8::EpiSwiglu, pg8::StaticOrder, true, true>(lds, g, S, E);
        } else {
            pg8::Gemm g{ACT, (const bf16_t*)(wb + WO_DN), M, D, FF}; pg8::StaticOrder S; S.init(M, D, G, bx);
            pg8::EpiRes E{(const unsigned char*)(ws + WS_LOB), (unsigned char*)a.out, XB, a.out, ss, l + 1 < DEPTH ? 1 : 0};
            pg8::gemm_phase<pg8::EpiRes, pg8::StaticOrder, true, true>(lds, g, S, E);
        }
    }
#if PROBE
    if (bx == 0) {
        LAS float* pv = (LAS float*)(lds + 131072 + 512);
        if (threadIdx.x == 0) { tsb[N_PHASES] = __builtin_amdgcn_s_memrealtime();
            unsigned long long sa = 0, sb = 0;
#pragma unroll 1
            for (int l = 0; l < DEPTH; ++l) { const int b = 1 + 6 * l;
                const unsigned long long d1 = tsb[b + 1] - tsb[b], d2 = tsb[32 + l] - tsb[b + 1], d3 = tsb[b + 2] - tsb[32 + l], d4 = tsb[b + 3] - tsb[b + 2], d5 = tsb[b + 4] - tsb[b + 3], d6 = tsb[b + 5] - tsb[b + 4], d7 = tsb[b + 6] - tsb[b + 5];
                sa += PROBE_A == 1 ? d1 : PROBE_A == 2 ? d2 : PROBE_A == 3 ? d3 : PROBE_A == 4 ? d4 : PROBE_A == 5 ? d5 : PROBE_A == 6 ? d6 : PROBE_A == 7 ? d7 : 0;
                sb += PROBE_B == 1 ? d1 : PROBE_B == 2 ? d2 : PROBE_B == 3 ? d3 : PROBE_B == 4 ? d4 : PROBE_B == 5 ? d5 : PROBE_B == 6 ? d6 : PROBE_B == 7 ? d7 : 0; }
            if (PROBE_A == 0) sa = tsb[1] - tsb[0]; if (PROBE_B == 0) sb = tsb[1] - tsb[0];
            pv[0] = (float)sa * 0.01f * PROBE_SA; pv[1] = PROBE_B == 8 ? 20.0f : (float)sb * 0.01f * PROBE_SB; }
        __syncthreads();
        if (threadIdx.x == 0) a.out[0] += pv[0];
        if (PROBE_B >= 0) for (int i = threadIdx.x + 512; i < 65536; i += 512) a.out[(size_t)(i >> 8) * 1024 + (i & 255)] += pv[1] * 0.0625f;
    }
#endif
}

#ifndef MK_PER_PHASE
#define MK_PER_PHASE 0
#endif
extern "C" void kernel_launch(void* const* d_in, const int* in_sizes, int n_in, void* d_out, int out_size, void* d_ws, size_t ws_size, hipStream_t stream) {
    static int grid = 0;
    if (grid == 0) {
        if (n_in != 15 || in_sizes[0] != M * D || out_size != M * D || ws_size < WS_END) { fprintf(stderr, "kernel_launch: unexpected shapes / workspace (n_in %d, ws %zu)\n", n_in, ws_size); grid = -1; return; }
        int dev = 0, cus = 0, per_cu = 0;
        (void)hipGetDevice(&dev); (void)hipDeviceGetAttribute(&cus, hipDeviceAttributeMultiprocessorCount, dev);
        if (hipFuncSetAttribute((const void*)fwd_kernel, hipFuncAttributeMaxDynamicSharedMemorySize, LDS_BYTES) != hipSuccess) { fprintf(stderr, "kernel_launch: hipFuncSetAttribute failed\n"); grid = -1; return; }
        if (hipOccupancyMaxActiveBlocksPerMultiprocessor(&per_cu, (const void*)fwd_kernel, 512, LDS_BYTES) != hipSuccess || per_cu < 1) { fprintf(stderr, "kernel_launch: occupancy query says %d\n", per_cu); per_cu = 1; }
        (void)hipGetLastError();
        grid = cus * per_cu;
    }
    if (grid < 0) return;
    if (hipMemsetAsync((char*)d_ws + WS_BAR, 0, 16384, stream) != hipSuccess) { fprintf(stderr, "kernel_launch: memset of the barrier words failed\n"); return; }
    Args a{};
    for (int i = 0; i < 15; ++i) a.in[i] = (const float*)d_in[i];
    a.out = (float*)d_out; a.ws = (unsigned char*)d_ws;
#if MK_PER_PHASE
    for (int ph = 0; ph < N_PHASES; ++ph) { a.ph_lo = ph; a.ph_hi = ph + 1; hipLaunchKernelGGL(fwd_kernel, dim3(grid), dim3(512), LDS_BYTES, stream, a); }
#else
    a.ph_lo = 0; a.ph_hi = N_PHASES;
    void* args[] = {&a};
    hipError_t e = hipLaunchCooperativeKernel((const void*)fwd_kernel, dim3(grid), dim3(512), args, LDS_BYTES, stream);
    if (e != hipSuccess) fprintf(stderr, "cooperative launch failed: %s (grid %d)\n", hipGetErrorString(e), grid);
#endif
}
```

```cpp
#include <hip/hip_runtime.h>
#include <hip/hip_cooperative_groups.h>
#include <cstdio>
#include <cstdint>
namespace cg = cooperative_groups;
namespace pg8 {
#define PG8_LAS __attribute__((address_space(3)))
typedef unsigned short bf16_t;
typedef short bf16x8 __attribute__((ext_vector_type(8)));
typedef float f32x4 __attribute__((ext_vector_type(4)));
typedef unsigned u32x4 __attribute__((ext_vector_type(4)));
constexpr int BM = 256, BK = 64, HALF = 128, HTB = HALF * BK * 2  , STAGE_BYTES = 8 * HTB, NXCD = 8, WGM = 8;

__host__ __device__ __forceinline__ int lds_byte(int r, int c) { const int st = (r >> 4) * 2 + (c >> 5), rr = r & 15, cc = c & 31, ob = rr * 64 + cc * 2; return st * 1024 + (ob ^ (((ob >> 9) & 1) << 5)); }
__host__ __device__ __forceinline__ void stage_rc(int b, int& R, int& C) { const int st = b / 1024, sb = b % 1024, swz = sb ^ (((sb >> 9) & 1) << 5); R = (st >> 1) * 16 + swz / 64; C = (st & 1) * 32 + (swz % 64) / 2; }
__host__ __device__ __forceinline__ int perm32(int rho) { const int n = rho >> 4, i = rho & 15; return 8 * (i >> 2) + 4 * n + (i & 3); }

struct Unit { int pm, pn; };
struct Gemm { const bf16_t* A; const bf16_t* Bt; int M, N, K; };

struct StaticOrder {
    int nM, nN, nwg, G, c;
    __host__ __device__ void init(int M, int N, int G_, int c_) { nM = M / BM; nN = N / BM; nwg = nM * nN; G = G_; c = c_; }
    __host__ __device__ bool next(int i, Unit& u) const {
        const long L = (long)i * G + c; if (L >= nwg) return false;
        int wgid = (int)L; { const int q = nwg / NXCD, r = nwg % NXCD, xcd = wgid % NXCD, off = wgid / NXCD; wgid = (xcd < r ? xcd * (q + 1) : r * (q + 1) + (xcd - r) * q) + off; }
        const int nig = WGM * nN, gid = wgid / nig, fm = gid * WGM, gsz = (nM - fm) < WGM ? (nM - fm) : WGM;
        u.pm = fm + ((wgid % nig) % gsz); u.pn = (wgid % nig) / gsz; return true;
    }
    __device__ __forceinline__ void a_ready(const Unit&) const {}
    __device__ __forceinline__ void done(const Unit&) const {}
};
typedef float f32x2_t __attribute__((ext_vector_type(2))); typedef __bf16 bf16x2_t __attribute__((ext_vector_type(2)));
typedef unsigned u32x2 __attribute__((ext_vector_type(2)));
__device__ __forceinline__ unsigned pk2(float lo, float hi) { f32x2_t v = {lo, hi}; bf16x2_t b = __builtin_convertvector(v, bf16x2_t); return __builtin_bit_cast(unsigned, b); }
__device__ __forceinline__ float bflo(unsigned u) { return __uint_as_float(u << 16); }
__device__ __forceinline__ float bfhi(unsigned u) { return __uint_as_float(u & 0xffff0000u); }
__device__ __forceinline__ float sigm(float x) { return __builtin_amdgcn_rcpf(1.0f + __builtin_amdgcn_exp2f(x * -1.4426950408889634f)); }
constexpr float NORM_EPS = 1e-6f;
__device__ __forceinline__ float row_rstd(const float* P, int row) { const f32x4* p = (const f32x4*)(P + (size_t)row * 16); const f32x4 a = p[0], b = p[1], c = p[2], d = p[3];
    const float s = ((a[0] + a[1]) + (a[2] + a[3])) + ((b[0] + b[1]) + (b[2] + b[3])) + ((c[0] + c[1]) + (c[2] + c[3])) + ((d[0] + d[1]) + (d[2] + d[3])); return rsqrtf(s * (1.0f / 1024.0f) + NORM_EPS); }

#ifndef ER_DEPTH
#define ER_DEPTH 4
#endif
#ifndef EM_DEPTH
#define EM_DEPTH 8
#endif
__device__ __forceinline__ void wave_rstd(const float* P, int rbase, int lane, float& ra, float& rb) {
    const f32x4* p = (const f32x4*)(P + (size_t)(rbase + lane) * 16); const f32x4* q = p + 4 * HALF;
    const f32x4 a0 = p[0], a1 = p[1], a2 = p[2], a3 = p[3], b0 = q[0], b1 = q[1], b2 = q[2], b3 = q[3];
    const float sa = ((a0[0] + a0[1]) + (a0[2] + a0[3])) + ((a1[0] + a1[1]) + (a1[2] + a1[3])) + ((a2[0] + a2[1]) + (a2[2] + a2[3])) + ((a3[0] + a3[1]) + (a3[2] + a3[3]));
    const float sb = ((b0[0] + b0[1]) + (b0[2] + b0[3])) + ((b1[0] + b1[1]) + (b1[2] + b1[3])) + ((b2[0] + b2[1]) + (b2[2] + b2[3])) + ((b3[0] + b3[1]) + (b3[2] + b3[3]));
    ra = rsqrtf(sa * (1.0f / 1024.0f) + NORM_EPS); rb = rsqrtf(sb * (1.0f / 1024.0f) + NORM_EPS);
}
__device__ __forceinline__ unsigned q8(float g) { return (unsigned)(sigm(g) * 255.0f + 0.5f); }
__device__ __forceinline__ float d8(unsigned w, int k) { return (float)((w >> (8 * k)) & 0xffu) * (1.0f / 255.0f); }
struct EpiIn {
    static constexpr bool PERM = true, AFTER_DRAIN = false;
    bf16_t *Q, *KV, *A, *G; const float* ss;
    __device__ __forceinline__ void operator()(const f32x4 (&acc)[2][2][4][2], const Unit& u, int wr, int wc, int fr, int fq) const {
        const int row0 = u.pm * BM + wr * 64 + fr, pn = u.pn, cw = wc * 32 + 8 * fq;
        float ra, rb; wave_rstd(ss, u.pm * BM + wr * 64, fr + 16 * fq, ra, rb);
        if (pn >= 5 && pn < 9) {
#pragma unroll
            for (int ai = 0; ai < 2; ++ai)
#pragma unroll
                for (int m = 0; m < 4; ++m) { const int row = row0 + ai * HALF + m * 16; const float rs = __shfl(ai ? rb : ra, 16 * m + fr);
                    const f32x4 u0 = acc[ai][0][m][0] * rs, u1 = acc[ai][0][m][1] * rs, g0 = acc[ai][1][m][0] * rs, g1 = acc[ai][1][m][1] * rs;
                    u32x4 w; w.x = pk2(u0[0] * sigm(g0[0]), u0[1] * sigm(g0[1])); w.y = pk2(u0[2] * sigm(g0[2]), u0[3] * sigm(g0[3]));
                    w.z = pk2(u1[0] * sigm(g1[0]), u1[1] * sigm(g1[1])); w.w = pk2(u1[2] * sigm(g1[2]), u1[3] * sigm(g1[3]));
                    *(u32x4*)(A + (size_t)row * 512 + (pn - 5) * 128 + cw) = w; }
        } else if (pn >= 9) {
            unsigned char* base = (unsigned char*)G + (pn - 9) * 256 + cw;
#pragma unroll
            for (int ai = 0; ai < 2; ++ai)
#pragma unroll
                for (int m = 0; m < 4; ++m) { const int row = row0 + ai * HALF + m * 16; const float rs = __shfl(ai ? rb : ra, 16 * m + fr);
                    unsigned char* rowp = base + (size_t)row * 2048;
#pragma unroll
                    for (int bj = 0; bj < 2; ++bj) { const f32x4 v0 = acc[ai][bj][m][0] * rs, v1 = acc[ai][bj][m][1] * rs;
                        u32x2 w; w.x = q8(v0[0]) | (q8(v0[1]) << 8) | (q8(v0[2]) << 16) | (q8(v0[3]) << 24); w.y = q8(v1[0]) | (q8(v1[1]) << 8) | (q8(v1[2]) << 16) | (q8(v1[3]) << 24);
                        *(u32x2*)(rowp + bj * HALF) = w; } }
        } else {
            bf16_t* base; int pitch;
            if (pn < 4) { base = Q + pn * 256 + cw; pitch = 1024; } else { base = KV + cw; pitch = 256; }
#pragma unroll
            for (int ai = 0; ai < 2; ++ai)
#pragma unroll
                for (int m = 0; m < 4; ++m) { const int row = row0 + ai * HALF + m * 16; const float rs = __shfl(ai ? rb : ra, 16 * m + fr);
                    bf16_t* rowp = base + (size_t)row * pitch;
#pragma unroll
                    for (int bj = 0; bj < 2; ++bj) { const f32x4 v0 = acc[ai][bj][m][0] * rs, v1 = acc[ai][bj][m][1] * rs;
                        u32x4 w; w.x = pk2(v0[0], v0[1]); w.y = pk2(v0[2], v0[3]); w.z = pk2(v1[0], v1[1]); w.w = pk2(v1[2], v1[3]);
                        *(u32x4*)(rowp + bj * HALF) = w; } }
        }
    }
};
struct EpiMerge {
    static constexpr bool PERM = true, AFTER_DRAIN = false;
    bf16_t* AO; const bf16_t* G;
    __device__ __forceinline__ void operator()(const f32x4 (&acc)[2][2][4][2], const Unit& u, int wr, int wc, int fr, int fq) const {
        const int row0 = u.pm * BM + wr * 64 + fr, col0 = u.pn * BM + wc * 32 + 8 * fq;
        constexpr int MD = EM_DEPTH; u32x4 pa[MD]; u32x2 pgb[MD];
#define EM_ROW(hg) (row0 + ((hg) >> 3) * HALF + (((hg) >> 1) & 3) * 16)
#define EM_COL(hg) (col0 + ((hg) & 1) * HALF)
#define EM_LOAD(hg, s) do { pa[s] = *(const u32x4*)(AO + (size_t)EM_ROW(hg) * 1024 + EM_COL(hg)); pgb[s] = *(const u32x2*)((const unsigned char*)G + (size_t)EM_ROW(hg) * 2048 + 1024 + EM_COL(hg)); } while (0)
#pragma unroll
        for (int hg = 0; hg < MD; ++hg) EM_LOAD(hg, hg);
#pragma unroll
        for (int hg = 0; hg < 16; ++hg) { const int ai = hg >> 3, m = (hg >> 1) & 3, bj = hg & 1, s = hg % MD;
            const u32x4 ao = pa[s]; const u32x2 gb = pgb[s]; const f32x4 c0 = acc[ai][bj][m][0], c1 = acc[ai][bj][m][1];
            u32x4 w;
            w.x = pk2(bflo(ao.x) + d8(gb.x, 0) * c0[0], bfhi(ao.x) + d8(gb.x, 1) * c0[1]);
            w.y = pk2(bflo(ao.y) + d8(gb.x, 2) * c0[2], bfhi(ao.y) + d8(gb.x, 3) * c0[3]);
            w.z = pk2(bflo(ao.z) + d8(gb.y, 0) * c1[0], bfhi(ao.z) + d8(gb.y, 1) * c1[1]);
            w.w = pk2(bflo(ao.w) + d8(gb.y, 2) * c1[2], bfhi(ao.w) + d8(gb.y, 3) * c1[3]);
            *(u32x4*)(AO + (size_t)EM_ROW(hg) * 1024 + EM_COL(hg)) = w;
            if (hg + MD < 16) EM_LOAD(hg + MD, s); }
#undef EM_ROW
#undef EM_COL
#undef EM_LOAD
    }
};
__device__ __forceinline__ float lo8_dec(unsigned hbits16, unsigned qbyte) {
    unsigned E = (hbits16 >> 7) & 0xffu; E = E < 16u ? 16u : E;
    return __uint_as_float(hbits16 << 16) + (float)(int)(signed char)qbyte * __uint_as_float((E - 15u) << 23);
}
__device__ __forceinline__ unsigned lo8_enc(float v, unsigned hbits16) {
    unsigned E = (hbits16 >> 7) & 0xffu; E = E < 16u ? 16u : E;
    const float q = (v - __uint_as_float(hbits16 << 16)) * __uint_as_float((269u - E) << 23);
    int i = (int)__builtin_rintf(q); i = i < -128 ? -128 : (i > 127 ? 127 : i);
    return (unsigned)i & 0xffu;
}
struct EpiRes {
    static constexpr bool PERM = true, AFTER_DRAIN = false;
    const unsigned char* lo_in; unsigned char* lo_out; bf16_t* XB; float* fout; float* ssn; int nxt;
    __device__ __forceinline__ void operator()(const f32x4 (&acc)[2][2][4][2], const Unit& u, int wr, int wc, int fr, int fq) const {
        const int row0 = u.pm * BM + wr * 64 + fr, col0 = u.pn * BM + wc * 32 + 8 * fq;
        constexpr int RD = ER_DEPTH; u32x4 ph[RD][2]; u32x2 pl[RD][2];
#define ER_ROW(g) (row0 + ((g) >> 2) * HALF + ((g) & 3) * 16)
#define ER_LOAD(g, s) do { const size_t o_ = (size_t)ER_ROW(g) * 1024 + col0; ph[s][0] = *(const u32x4*)(XB + o_); ph[s][1] = *(const u32x4*)(XB + o_ + HALF); pl[s][0] = *(const u32x2*)(lo_in + o_); pl[s][1] = *(const u32x2*)(lo_in + o_ + HALF); } while (0)
#pragma unroll
        for (int g = 0; g < RD; ++g) ER_LOAD(g, g);
#pragma unroll
        for (int g = 0; g < 8; ++g) { const int ai = g >> 2, m = g & 3, s = g % RD; const int row = ER_ROW(g); const size_t off = (size_t)row * 1024 + col0; float sq = 0.f;
#pragma unroll
            for (int bj = 0; bj < 2; ++bj) { const size_t o = off + bj * HALF; const u32x4 h = ph[s][bj]; const u32x2 l = pl[s][bj];
                const f32x4 v0 = (f32x4){lo8_dec(h.x & 0xffffu, l.x), lo8_dec(h.x >> 16, l.x >> 8), lo8_dec(h.y & 0xffffu, l.x >> 16), lo8_dec(h.y >> 16, l.x >> 24)} + acc[ai][bj][m][0];
                const f32x4 v1 = (f32x4){lo8_dec(h.z & 0xffffu, l.y), lo8_dec(h.z >> 16, l.y >> 8), lo8_dec(h.w & 0xffffu, l.y >> 16), lo8_dec(h.w >> 16, l.y >> 24)} + acc[ai][bj][m][1];
                if (nxt) { u32x4 w; w.x = pk2(v0[0], v0[1]); w.y = pk2(v0[2], v0[3]); w.z = pk2(v1[0], v1[1]); w.w = pk2(v1[2], v1[3]); *(u32x4*)(XB + o) = w;
                    u32x2 r; r.x = lo8_enc(v0[0], w.x & 0xffffu) | (lo8_enc(v0[1], w.x >> 16) << 8) | (lo8_enc(v0[2], w.y & 0xffffu) << 16) | (lo8_enc(v0[3], w.y >> 16) << 24);
                    r.y = lo8_enc(v1[0], w.z & 0xffffu) | (lo8_enc(v1[1], w.z >> 16) << 8) | (lo8_enc(v1[2], w.w & 0xffffu) << 16) | (lo8_enc(v1[3], w.w >> 16) << 24);
                    *(u32x2*)(lo_out + o) = r;
                    sq += ((v0[0] * v0[0] + v0[1] * v0[1]) + (v0[2] * v0[2] + v0[3] * v0[3])) + ((v1[0] * v1[0] + v1[1] * v1[1]) + (v1[2] * v1[2] + v1[3] * v1[3])); }
                else { *(f32x4*)(fout + o) = v0; *(f32x4*)(fout + o + 4) = v1; } }
            if (nxt) { sq += __shfl_xor(sq, 16); sq += __shfl_xor(sq, 32); if (fq == 0) ssn[(size_t)row * 16 + u.pn * 4 + wc] = sq; }
            if (g + RD < 8) ER_LOAD(g + RD, s); }
#undef ER_ROW
#undef ER_LOAD
    }
};
struct EpiSwiglu {
    static constexpr bool PERM = true, AFTER_DRAIN = false;
    bf16_t* ACT; const float* ss;
    __device__ __forceinline__ void operator()(const f32x4 (&acc)[2][2][4][2], const Unit& u, int wr, int wc, int fr, int fq) const {
        const int row0 = u.pm * BM + wr * 64 + fr, col = u.pn * 128 + wc * 32 + 8 * fq;
        float ra, rb; wave_rstd(ss, u.pm * BM + wr * 64, fr + 16 * fq, ra, rb);
#pragma unroll
        for (int ai = 0; ai < 2; ++ai)
#pragma unroll
            for (int m = 0; m < 4; ++m) { const int row = row0 + ai * HALF + m * 16; const float rs = __shfl(ai ? rb : ra, 16 * m + fr);
                const f32x4 g0 = acc[ai][0][m][0] * rs, g1 = acc[ai][0][m][1] * rs, u0 = acc[ai][1][m][0] * rs, u1 = acc[ai][1][m][1] * rs;
                u32x4 w; w.x = pk2(g0[0] * sigm(g0[0]) * u0[0], g0[1] * sigm(g0[1]) * u0[1]); w.y = pk2(g0[2] * sigm(g0[2]) * u0[2], g0[3] * sigm(g0[3]) * u0[3]);
                w.z = pk2(g1[0] * sigm(g1[0]) * u1[0], g1[1] * sigm(g1[1]) * u1[1]); w.w = pk2(g1[2] * sigm(g1[2]) * u1[2], g1[3] * sigm(g1[3]) * u1[3]);
                *(u32x4*)(ACT + (size_t)row * 2816 + col) = w; }
    }
};
template <class Epi, class Sched, bool ALIGN_EPI = false, bool SP2 = false>
__device__ __forceinline__ void gemm_phase(PG8_LAS unsigned char* lds, const Gemm g, const Sched& S, const Epi& E) {
    int tid_l = threadIdx.x; asm volatile("" : "+v"(tid_l));
    const int tid = tid_l, wid = __builtin_amdgcn_readfirstlane(tid >> 6), lane = tid & 63, wr = wid >> 2, wc = wid & 3, fr = lane & 15, fq = lane >> 4;
    const int K = g.K, nt = K / BK;
    unsigned voffA[2], voffB[2];
#pragma unroll
    for (int i = 0; i < 2; ++i) { int R, C; stage_rc(tid * 16 + i * 8192, R, C); const int Rb = Epi::PERM ? ((R & ~31) + perm32(R & 31)) : R;
        voffA[i] = (unsigned)(R * K + C) * 2u; voffB[i] = (unsigned)(Rb * K + C) * 2u; }
    const size_t kstep = (size_t)(BK * 2);
    const size_t hstep = (size_t)HALF * K * 2;
    const size_t tstep = 2 * hstep;
    const unsigned ldsw = (unsigned)wid * 1024u;
    const int aoff = lds_byte(wr * 64 + fr, fq * 8), boff = lds_byte(wc * 32 + fr, fq * 8);
#define PG8_SA(b, h) (((b) * 2 + (h)) * HTB)
#define PG8_SB(b, h) ((4 + (b) * 2 + (h)) * HTB)
#define PG8_STAGE(bufoff, gbase, voff) do { _Pragma("unroll") for (int _i = 0; _i < 2; ++_i) \
        __builtin_amdgcn_global_load_lds((const unsigned*)((const char*)(gbase) + (voff)[_i]), (PG8_LAS unsigned*)(lds + (bufoff) + ldsw + _i * 8192), 16, 0, 0); } while (0)
#define PG8_LDA(dst, b, h) do { _Pragma("unroll") for (int m = 0; m < 4; ++m) _Pragma("unroll") for (int k = 0; k < 2; ++k) dst[m][k] = *(const PG8_LAS bf16x8*)(lds + PG8_SA(b, h) + aoff + m * 2048 + k * 1024); } while (0)
#define PG8_LDB(dst, b, h) do { _Pragma("unroll") for (int n = 0; n < 2; ++n) _Pragma("unroll") for (int k = 0; k < 2; ++k) dst[n][k] = *(const PG8_LAS bf16x8*)(lds + PG8_SB(b, h) + boff + n * 2048 + k * 1024); } while (0)
#define PG8_MMA(ai, bj, At, Bt) do { __builtin_amdgcn_s_setprio(1); _Pragma("unroll") for (int m = 0; m < 4; ++m) _Pragma("unroll") for (int n = 0; n < 2; ++n) _Pragma("unroll") for (int k = 0; k < 2; ++k) \
        acc[ai][bj][m][n] = __builtin_amdgcn_mfma_f32_16x16x32_bf16(Bt[n][k], At[m][k], acc[ai][bj][m][n], 0, 0, 0); __builtin_amdgcn_s_setprio(0); } while (0)
#define PG8_WAIT_V(n) asm volatile("s_waitcnt vmcnt(" #n ")" ::: "memory")
#define PG8_WAIT_L(n) asm volatile("s_waitcnt lgkmcnt(" #n ")" ::: "memory")
#define PG8_BAR __builtin_amdgcn_s_barrier()
#define PG8_SCHED __builtin_amdgcn_sched_barrier(0)
    Unit cur, nxt; int ui = 0;
    if (!S.next(0, cur)) return;
    f32x4 acc[2][2][4][2];
#pragma unroll
    for (int a = 0; a < 2; ++a)
#pragma unroll
        for (int b = 0; b < 2; ++b)
#pragma unroll
            for (int m = 0; m < 4; ++m)
#pragma unroll
                for (int n = 0; n < 2; ++n) acc[a][b][m][n] = (f32x4){0.f, 0.f, 0.f, 0.f};
    bf16x8 At[4][2], B0[2][2], B1[2][2];
    const char* cA = (const char*)g.A + (size_t)cur.pm * tstep; const char* cB = (const char*)g.Bt + (size_t)cur.pn * tstep;
    S.a_ready(cur);
    if constexpr (SP2) {
        PG8_STAGE(PG8_SB(0, 0), cB, voffB); PG8_STAGE(PG8_SB(0, 1), cB + hstep, voffB); PG8_STAGE(PG8_SA(0, 0), cA, voffA); PG8_STAGE(PG8_SA(0, 1), cA + hstep, voffA);
        if (wr == 1) PG8_BAR;
        PG8_WAIT_V(2); PG8_BAR;
        PG8_STAGE(PG8_SB(1, 0), cB + kstep, voffB); PG8_STAGE(PG8_SA(1, 0), cA + kstep, voffA); PG8_STAGE(PG8_SB(1, 1), cB + hstep + kstep, voffB);
        PG8_WAIT_V(6); PG8_BAR;
    } else {
        PG8_STAGE(PG8_SB(0, 0), cB, voffB); PG8_STAGE(PG8_SA(0, 0), cA, voffA); PG8_STAGE(PG8_SB(0, 1), cB + hstep, voffB); PG8_STAGE(PG8_SA(0, 1), cA + hstep, voffA);
        if (wr == 1) PG8_BAR;
        PG8_WAIT_V(4); PG8_BAR;
        PG8_STAGE(PG8_SB(1, 0), cB + kstep, voffB); PG8_STAGE(PG8_SA(1, 0), cA + kstep, voffA); PG8_STAGE(PG8_SB(1, 1), cB + hstep + kstep, voffB);
        PG8_WAIT_V(6); PG8_BAR;
    }
    for (;;) {
        const bool has_next = S.next(ui + 1, nxt);
        const char* nA = has_next ? (const char*)g.A + (size_t)nxt.pm * tstep : cA; const char* nB = has_next ? (const char*)g.Bt + (size_t)nxt.pn * tstep : cB;
        for (int t = 0; t < nt; t += 2) {
            const bool last = (t == nt - 2);
            const char* a1 = cA + (size_t)(t + 1) * kstep;
            const char* a2 = last ? nA : cA + (size_t)(t + 2) * kstep; const char* b2 = last ? nB : cB + (size_t)(t + 2) * kstep;
            const char* a3 = a2 + kstep; const char* b3 = b2 + kstep;
            if (last && has_next) S.a_ready(nxt);
            if constexpr (SP2) {
            PG8_LDB(B0, 0, 0); PG8_LDB(B1, 0, 1); PG8_SCHED; PG8_LDA(At, 0, 0); PG8_STAGE(PG8_SA(1, 1), a1 + hstep, voffA);
            PG8_WAIT_V(8); PG8_WAIT_L(0); PG8_BAR; PG8_MMA(0, 0, At, B0); PG8_MMA(0, 1, At, B1); PG8_BAR; PG8_SCHED;
            PG8_LDA(At, 0, 1); PG8_STAGE(PG8_SB(0, 0), b2, voffB); PG8_STAGE(PG8_SB(0, 1), b2 + hstep, voffB); PG8_STAGE(PG8_SA(0, 0), a2, voffA);
            PG8_WAIT_V(8); PG8_WAIT_L(0); PG8_BAR; PG8_MMA(1, 0, At, B0); PG8_MMA(1, 1, At, B1); PG8_BAR; PG8_SCHED;
            PG8_LDB(B0, 1, 0); PG8_LDB(B1, 1, 1); PG8_SCHED; PG8_LDA(At, 1, 0); PG8_STAGE(PG8_SA(0, 1), a2 + hstep, voffA);
            PG8_WAIT_V(8); PG8_WAIT_L(0); PG8_BAR; PG8_MMA(0, 0, At, B0); PG8_MMA(0, 1, At, B1); PG8_BAR; PG8_SCHED;
            PG8_LDA(At, 1, 1); PG8_STAGE(PG8_SB(1, 0), b3, voffB); PG8_STAGE(PG8_SB(1, 1), b3 + hstep, voffB); PG8_STAGE(PG8_SA(1, 0), a3, voffA);
            PG8_WAIT_V(8); PG8_WAIT_L(0); PG8_BAR; PG8_MMA(1, 0, At, B0); PG8_MMA(1, 1, At, B1); PG8_BAR; PG8_SCHED;
            } else {
            PG8_LDB(B0, 0, 0); PG8_SCHED; PG8_LDA(At, 0, 0); PG8_STAGE(PG8_SA(1, 1), a1 + hstep, voffA);
            PG8_WAIT_L(8); PG8_BAR; PG8_WAIT_L(0); PG8_MMA(0, 0, At, B0); PG8_BAR; PG8_SCHED;
            PG8_LDB(B1, 0, 1); PG8_STAGE(PG8_SB(0, 0), b2, voffB);
            PG8_BAR; PG8_WAIT_L(0); PG8_MMA(0, 1, At, B1); PG8_BAR;
            PG8_LDA(At, 0, 1); PG8_STAGE(PG8_SA(0, 0), a2, voffA);
            PG8_BAR; PG8_WAIT_L(0); PG8_MMA(1, 0, At, B0); PG8_BAR; PG8_SCHED;
            PG8_STAGE(PG8_SB(0, 1), b2 + hstep, voffB);
            PG8_WAIT_V(6); PG8_BAR; PG8_MMA(1, 1, At, B1); PG8_BAR;
            PG8_LDB(B0, 1, 0); PG8_SCHED; PG8_LDA(At, 1, 0); PG8_STAGE(PG8_SA(0, 1), a2 + hstep, voffA);
            PG8_WAIT_L(8); PG8_BAR; PG8_WAIT_L(0); PG8_MMA(0, 0, At, B0); PG8_BAR; PG8_SCHED;
            PG8_LDB(B1, 1, 1); PG8_STAGE(PG8_SB(1, 0), b3, voffB);
            PG8_BAR; PG8_WAIT_L(0); PG8_MMA(0, 1, At, B1); PG8_BAR;
            PG8_LDA(At, 1, 1); PG8_STAGE(PG8_SA(1, 0), a3, voffA);
            PG8_BAR; PG8_WAIT_L(0); PG8_MMA(1, 0, At, B0); PG8_BAR; PG8_SCHED;
            PG8_STAGE(PG8_SB(1, 1), b3 + hstep, voffB);
            PG8_WAIT_V(6); PG8_BAR; PG8_MMA(1, 1, At, B1); PG8_BAR;
            }
        }
        if constexpr (ALIGN_EPI) { if (wr == 0) PG8_BAR; }
        if constexpr (!Epi::AFTER_DRAIN) { E(acc, cur, wr, wc, fr, fq); S.done(cur); }
        if (!has_next) break;
#pragma unroll
        for (int a = 0; a < 2; ++a)
#pragma unroll
            for (int b = 0; b < 2; ++b)
#pragma unroll
                for (int m = 0; m < 4; ++m)
#pragma unroll
                    for (int n = 0; n < 2; ++n) acc[a][b][m][n] = (f32x4){0.f, 0.f, 0.f, 0.f};
        cur = nxt; cA = nA; cB = nB; ++ui;
        if constexpr (ALIGN_EPI) { if (wr == 1) PG8_BAR; }
    }
    PG8_WAIT_V(0);
    if constexpr (!ALIGN_EPI) { if (wr == 0) PG8_BAR; }
    PG8_BAR;
    if constexpr (Epi::AFTER_DRAIN) { E.fused(acc, cur, wr, wc, fr, fq, lds, wid, lane); S.done(cur); }
#undef PG8_SA
#undef PG8_SB
#undef PG8_STAGE
#undef PG8_LDA
#undef PG8_LDB
#undef PG8_MMA
#undef PG8_WAIT_V
#undef PG8_WAIT_L
#undef PG8_BAR
#undef PG8_SCHED
}
}
using pg8::bf16_t; using pg8::f32x4; using pg8::u32x4; using pg8::bf16x8; using pg8::u32x2; using pg8::pk2; using pg8::bflo; using pg8::bfhi; using pg8::sigm; using pg8::NORM_EPS;
#define LAS __attribute__((address_space(3)))
constexpr int NB = 4, T = 8192, M = NB * T, D = 1024, INW = 4352, CC = 512, FF = 2816, GU = 2 * FF, DEPTH = 4, NHEAD = 16;
constexpr size_t MiB = 1u << 20;
constexpr size_t WS_SS = 450 * MiB, SS_BUF = 2 * MiB;
constexpr size_t WS_ROPE = 1 * MiB;
constexpr size_t WS_W = 2 * MiB, W_LAYER = 28 * MiB;
constexpr size_t WO_IN = 0, WO_PW = 8 * MiB + MiB / 2, WO_OUT = WO_PW + 1 * MiB, WO_GU = WO_OUT + 2 * MiB, WO_DN = WO_GU + 11 * MiB;
constexpr size_t WS_XB = 114 * MiB, WS_QO = 178 * MiB, WS_KV = 242 * MiB, WS_A = 258 * MiB, WS_G = 290 * MiB, WS_Y = 418 * MiB, WS_BAR = 455 * MiB, WS_END = 456 * MiB;
constexpr size_t WS_LOB = 354 * MiB;
constexpr size_t WS_ACT = 178 * MiB;
static_assert(WO_DN + (size_t)D * FF * 2 == W_LAYER && WS_W + DEPTH * W_LAYER == WS_XB && WS_ACT + (size_t)M * FF * 2 <= WS_Y, "ws map");
constexpr int LDS_BYTES = 132096;

#define LDS_BAR() asm volatile("s_waitcnt lgkmcnt(0)\n\ts_barrier" ::: "memory")
__device__ __forceinline__ float wave_sum(float v) {
#pragma unroll
    for (int o = 1; o < 64; o <<= 1) v += __shfl_xor(v, o);
    return v;
}

namespace att {
typedef __attribute__((ext_vector_type(16))) float f32x16;
typedef __attribute__((ext_vector_type(4))) short s16x4;
constexpr int KPB = 144, VPB = 520, OFF_V = 256 * KPB, SCR_OFF = 71680, SCR_WAVE = 4608;
constexpr float LOG2E = 1.4426950408889634f;
__device__ __forceinline__ int crow(int r, int hi) { return (r & 3) + 8 * (r >> 2) + 4 * hi; }

struct KVRaw { u32x4 kr[4], v0[2], v1[2]; f32x4 cs[4]; };
__device__ __forceinline__ void kv_fetch(KVRaw& R, const bf16_t* KV, const float* rope, int b, int kvh, int blk, int tid) {
    { const int row = tid >> 1, half = tid & 1, pos = blk * 128 - 128 + row; const bool valid = pos >= 0;
      const bf16_t* src = KV + (size_t)(b * T + pos) * 256 + kvh * 64 + half * 32;
#pragma unroll
      for (int i = 0; i < 4; ++i) { R.kr[i] = (u32x4){0u, 0u, 0u, 0u}; R.cs[i] = (f32x4){0.f, 0.f, 0.f, 0.f}; if (valid) { R.kr[i] = *(const u32x4*)(src + 8 * i); R.cs[i] = *(const f32x4*)(rope + pos * 16 + 4 * i); } } }
    { const int rp = tid >> 2, c = tid & 3, pos0 = blk * 128 - 128 + 2 * rp; const bool valid = pos0 >= 0;
      const bf16_t* src = KV + (size_t)(b * T + pos0) * 256 + 128 + kvh * 64 + 16 * c;
#pragma unroll
      for (int i = 0; i < 2; ++i) { R.v0[i] = (u32x4){0u, 0u, 0u, 0u}; R.v1[i] = R.v0[i]; if (valid) { R.v0[i] = *(const u32x4*)(src + 8 * i); R.v1[i] = *(const u32x4*)(src + 256 + 8 * i); } } }
}
__device__ __forceinline__ void unit(LAS unsigned char* lds, int b, int kvh, int blk, bf16_t* QO, const bf16_t* KV, const bf16_t* GA, const float* qn, const float* kn, const float* sinks,
                                     const float* rope, int tid, int lane, int wave) {
    const int h = kvh * 8 + wave, q = lane & 31, hi = lane >> 5, crow8 = lane >> 3, cch = lane & 7;
    u32x4 qrN[4]; u32x2 gtN[4]; f32x4 rpN[4];
#define AT_LOAD(sub_) do { const size_t tr_ = (size_t)(b * T + blk * 128 + 32 * (sub_)); const int tq_ = blk * 128 + 32 * (sub_) + q; \
        _Pragma("unroll") for (int i = 0; i < 4; ++i) { qrN[i] = *(const u32x4*)(QO + (tr_ + crow8 + 8 * i) * 1024 + h * 64 + cch * 8); gtN[i] = *(const u32x2*)((const unsigned char*)GA + (tr_ + crow8 + 8 * i) * 2048 + h * 64 + cch * 8); \
            rpN[i] = *(const f32x4*)(rope + tq_ * 16 + 4 * i); } } while (0)
    KVRaw R; kv_fetch(R, KV, rope, b, kvh, blk, tid);
    AT_LOAD(0);
    {
        const int row = tid >> 1, half = tid & 1, pos = blk * 128 - 128 + row; const bool valid = pos >= 0;
        float x[32]; float ssq = 0.f;
#pragma unroll
        for (int i = 0; i < 4; ++i) { const u32x4 r = R.kr[i];
            x[8 * i + 0] = bflo(r.x); x[8 * i + 1] = bfhi(r.x); x[8 * i + 2] = bflo(r.y); x[8 * i + 3] = bfhi(r.y); x[8 * i + 4] = bflo(r.z); x[8 * i + 5] = bfhi(r.z); x[8 * i + 6] = bflo(r.w); x[8 * i + 7] = bfhi(r.w); }
#pragma unroll
        for (int i = 0; i < 32; ++i) ssq += x[i] * x[i];
        ssq += __shfl_xor(ssq, 1);
        const float rstd = rsqrtf(ssq * (1.0f / 64.0f) + NORM_EPS);
#pragma unroll
        for (int i = 0; i < 8; ++i) { const f32x4 g = *(const f32x4*)(kn + half * 32 + 4 * i); x[4 * i] *= rstd * g[0]; x[4 * i + 1] *= rstd * g[1]; x[4 * i + 2] *= rstd * g[2]; x[4 * i + 3] *= rstd * g[3]; }
        if (half == 0 && valid) {
#pragma unroll
            for (int i = 0; i < 8; ++i) { const float c = R.cs[i >> 2][i & 3], s = R.cs[2 + (i >> 2)][i & 3], x1 = x[i], x2 = x[8 + i]; x[i] = x1 * c - x2 * s; x[8 + i] = x2 * c + x1 * s; } }
#pragma unroll
        for (int i = 0; i < 4; ++i) { u32x4 w; w.x = pk2(x[8 * i], x[8 * i + 1]); w.y = pk2(x[8 * i + 2], x[8 * i + 3]); w.z = pk2(x[8 * i + 4], x[8 * i + 5]); w.w = pk2(x[8 * i + 6], x[8 * i + 7]);
            *(LAS u32x4*)(lds + row * KPB + half * 64 + 16 * i) = w; }
    }
    {
        const int rp = tid >> 2, c = tid & 3;
#pragma unroll
        for (int w = 0; w < 8; ++w) { const unsigned a = R.v0[w >> 2][w & 3], bb = R.v1[w >> 2][w & 3]; const int d = 16 * c + 2 * w;
            *(LAS unsigned*)(lds + OFF_V + d * VPB + rp * 4) = (a & 0xffffu) | (bb << 16);
            *(LAS unsigned*)(lds + OFF_V + (d + 1) * VPB + rp * 4) = (a >> 16) | (bb & 0xffff0000u); }
    }
    LDS_BAR();
    const float sink2 = sinks[h] * LOG2E;
#pragma unroll 1
    for (int sub = 0; sub < 4; ++sub) {
        const int tq = blk * 128 + 32 * sub + q;
        LAS unsigned char* scr = lds + SCR_OFF + wave * SCR_WAVE;
        const size_t trow = (size_t)(b * T + blk * 128 + 32 * sub);
        u32x2 gtc[4]; f32x4 rp[4];
#pragma unroll
        for (int i = 0; i < 4; ++i) { gtc[i] = gtN[i]; rp[i] = rpN[i]; *(LAS u32x4*)(scr + (crow8 + 8 * i) * 144 + cch * 16) = qrN[i]; }
        if (sub < 3) AT_LOAD(sub + 1);
        asm volatile("s_waitcnt lgkmcnt(0)" ::: "memory");
        float x[4][8]; float ssq = 0.f;
#pragma unroll
        for (int d0 = 0; d0 < 4; ++d0) { const u32x4 r = *(const LAS u32x4*)(scr + q * 144 + (16 * d0 + 8 * hi) * 2);
            x[d0][0] = bflo(r.x); x[d0][1] = bfhi(r.x); x[d0][2] = bflo(r.y); x[d0][3] = bfhi(r.y); x[d0][4] = bflo(r.z); x[d0][5] = bfhi(r.z); x[d0][6] = bflo(r.w); x[d0][7] = bfhi(r.w); }
#pragma unroll
        for (int d0 = 0; d0 < 4; ++d0)
#pragma unroll
            for (int i = 0; i < 8; ++i) ssq += x[d0][i] * x[d0][i];
        ssq += __shfl_xor(ssq, 32);
        const float rstd = rsqrtf(ssq * (1.0f / 64.0f) + NORM_EPS) * (0.125f * LOG2E);
#pragma unroll
        for (int d0 = 0; d0 < 4; ++d0) { const f32x4 g0 = *(const f32x4*)(qn + 16 * d0 + 8 * hi), g1 = *(const f32x4*)(qn + 16 * d0 + 8 * hi + 4);
            x[d0][0] *= rstd * g0[0]; x[d0][1] *= rstd * g0[1]; x[d0][2] *= rstd * g0[2]; x[d0][3] *= rstd * g0[3]; x[d0][4] *= rstd * g1[0]; x[d0][5] *= rstd * g1[1]; x[d0][6] *= rstd * g1[2]; x[d0][7] *= rstd * g1[3]; }
#pragma unroll
        for (int i = 0; i < 8; ++i) { const float c = rp[i >> 2][i & 3], s = rp[2 + (i >> 2)][i & 3], me = x[0][i], ot = __shfl_xor(me, 32); x[0][i] = hi == 0 ? me * c - ot * s : me * c + ot * s; }
        bf16x8 qf[4];
#pragma unroll
        for (int d0 = 0; d0 < 4; ++d0) { u32x4 w; w.x = pk2(x[d0][0], x[d0][1]); w.y = pk2(x[d0][2], x[d0][3]); w.z = pk2(x[d0][4], x[d0][5]); w.w = pk2(x[d0][6], x[d0][7]); qf[d0] = __builtin_bit_cast(bf16x8, w); }
        f32x16 p[5];
#pragma unroll
        for (int kt = 0; kt < 5; ++kt) {
#pragma unroll
            for (int r = 0; r < 16; ++r) p[kt][r] = 0.f;
#pragma unroll
            for (int d0 = 0; d0 < 4; ++d0) { const bf16x8 kf = *(const LAS bf16x8*)(lds + (32 * (sub + kt) + q) * KPB + (16 * d0 + 8 * hi) * 2);
                p[kt] = __builtin_amdgcn_mfma_f32_32x32x16_bf16(kf, qf[d0], p[kt], 0, 0, 0); } }
        const bool first = (blk == 0);
        bool lowtri[16];
#pragma unroll
        for (int r = 0; r < 16; ++r) lowtri[r] = crow(r, hi) <= q;
        f32x16 pc;
#pragma unroll
        for (int r = 0; r < 16; ++r) pc[r] = lowtri[r] ? p[4][r] : (first ? -INFINITY : p[0][r]);
        if (first) {
#pragma unroll
            for (int kt = 1; kt < 4; ++kt) if (sub + kt < 4) {
#pragma unroll
                for (int r = 0; r < 16; ++r) p[kt][r] = -INFINITY; } }
        float mx = sink2;
#pragma unroll
        for (int r = 0; r < 16; ++r) mx = fmaxf(fmaxf(mx, pc[r]), fmaxf(fmaxf(p[1][r], p[2][r]), p[3][r]));
        mx = fmaxf(mx, __shfl_xor(mx, 32));
#pragma unroll
        for (int r = 0; r < 16; ++r) { pc[r] = __builtin_amdgcn_exp2f(pc[r] - mx); p[1][r] = __builtin_amdgcn_exp2f(p[1][r] - mx); p[2][r] = __builtin_amdgcn_exp2f(p[2][r] - mx); p[3][r] = __builtin_amdgcn_exp2f(p[3][r] - mx); }
        const f32x16 sv = (pc + p[1]) + (p[2] + p[3]);
        float lsum = ((sv[0] + sv[1]) + (sv[2] + sv[3])) + ((sv[4] + sv[5]) + (sv[6] + sv[7])) + (((sv[8] + sv[9]) + (sv[10] + sv[11])) + ((sv[12] + sv[13]) + (sv[14] + sv[15])));
        lsum += __shfl_xor(lsum, 32); lsum += __builtin_amdgcn_exp2f(sink2 - mx);
        const float inv = 1.0f / lsum;
#pragma unroll
        for (int r = 0; r < 16; ++r) { p[0][r] = lowtri[r] ? 0.f : pc[r]; p[4][r] = lowtri[r] ? pc[r] : 0.f; }
        f32x16 o[2];
#pragma unroll
        for (int r = 0; r < 16; ++r) { o[0][r] = 0.f; o[1][r] = 0.f; }
#pragma unroll
        for (int kt = 0; kt < 5; ++kt)
#pragma unroll
            for (int s = 0; s < 2; ++s) { u32x4 w; w.x = pk2(p[kt][8 * s], p[kt][8 * s + 1]); w.y = pk2(p[kt][8 * s + 2], p[kt][8 * s + 3]); w.z = pk2(p[kt][8 * s + 4], p[kt][8 * s + 5]); w.w = pk2(p[kt][8 * s + 6], p[kt][8 * s + 7]);
                const bf16x8 pf = __builtin_bit_cast(bf16x8, w);
#pragma unroll
                for (int d0 = 0; d0 < 2; ++d0) { const LAS unsigned char* vp = lds + OFF_V + (32 * d0 + q) * VPB + (32 * (sub + kt) + 16 * s + 4 * hi) * 2;
                    const s16x4 lo = *(const LAS s16x4*)vp, hi4 = *(const LAS s16x4*)(vp + 16);
                    const bf16x8 vf = (bf16x8){lo[0], lo[1], lo[2], lo[3], hi4[0], hi4[1], hi4[2], hi4[3]};
                    o[d0] = __builtin_amdgcn_mfma_f32_32x32x16_bf16(vf, pf, o[d0], 0, 0, 0); } }
        asm volatile("s_waitcnt lgkmcnt(0)" ::: "memory");
#pragma unroll
        for (int d0 = 0; d0 < 2; ++d0)
#pragma unroll
            for (int g = 0; g < 4; ++g) { u32x2 w; w.x = pk2(o[d0][4 * g] * inv, o[d0][4 * g + 1] * inv); w.y = pk2(o[d0][4 * g + 2] * inv, o[d0][4 * g + 3] * inv);
                *(LAS u32x2*)(scr + q * 144 + (32 * d0 + 8 * g + 4 * hi) * 2) = w; }
        asm volatile("s_waitcnt lgkmcnt(0)" ::: "memory");
#pragma unroll
        for (int i = 0; i < 4; ++i) { const u32x4 ov = *(const LAS u32x4*)(scr + (crow8 + 8 * i) * 144 + cch * 16); const u32x2 gg = gtc[i]; u32x4 w;
            w.x = pk2(bflo(ov.x) * pg8::d8(gg.x, 0), bfhi(ov.x) * pg8::d8(gg.x, 1)); w.y = pk2(bflo(ov.y) * pg8::d8(gg.x, 2), bfhi(ov.y) * pg8::d8(gg.x, 3));
            w.z = pk2(bflo(ov.z) * pg8::d8(gg.y, 0), bfhi(ov.z) * pg8::d8(gg.y, 1)); w.w = pk2(bflo(ov.w) * pg8::d8(gg.y, 2), bfhi(ov.w) * pg8::d8(gg.y, 3));
            *(u32x4*)(QO + (trow + crow8 + 8 * i) * 1024 + h * 64 + cch * 8) = w; }
        asm volatile("s_waitcnt lgkmcnt(0)" ::: "memory");
    }
#undef AT_LOAD
    LDS_BAR();
}
}

namespace cv {
constexpr int ROWS = 62, OFF_Y = ROWS * 1024, NU = M / 32;
typedef pg8::f32x2_t f32x2;
__device__ __forceinline__ void phase(LAS unsigned char* lds, int bx, int G, const bf16_t* A, bf16_t* Y, const float* cw, const float* cb, const float* lg, const float* lb, int tid, int lane, int wave) {
    const int cp = tid & 255, tg = tid >> 8;
    f32x2 wv[31];
#pragma unroll
    for (int j = 0; j < 31; ++j) wv[j] = *(const f32x2*)(cw + j * CC + 2 * cp);
    const f32x2 bias = *(const f32x2*)(cb + 2 * cp);
    const f32x4 g0 = *(const f32x4*)(lg + 4 * lane), g1 = *(const f32x4*)(lg + 256 + 4 * lane), b0 = *(const f32x4*)(lb + 4 * lane), b1 = *(const f32x4*)(lb + 256 + 4 * lane);
    u32x4 pre[8];
#define CV_FETCH(un) do { const int t0_ = (un) * 32, p0_ = t0_ & (T - 1); _Pragma("unroll") for (int i = 0; i < 8; ++i) { const int idx = tid + 512 * i, r = idx >> 6, ch = idx & 63; pre[i] = (u32x4){0u, 0u, 0u, 0u}; \
        if (idx < ROWS * 64 && p0_ - 30 + r >= 0) pre[i] = *(const u32x4*)(A + (size_t)(t0_ - 30 + r) * CC + ch * 8); } } while (0)
    int un = bx;
    if (un < NU) CV_FETCH(un);
#pragma unroll 1
    for (; un < NU; un += G) {
        const int t0 = un * 32;
#pragma unroll
        for (int i = 0; i < 8; ++i) { const int idx = tid + 512 * i; if (idx < ROWS * 64) *(LAS u32x4*)(lds + idx * 16) = pre[i]; }
        LDS_BAR();
        if (un + G < NU) CV_FETCH(un + G);
#pragma unroll 1
        for (int sb = 0; sb < 2; ++sb) { const int tb = 16 * tg + 8 * sb;
            f32x2 ac[8];
#pragma unroll
            for (int i = 0; i < 8; ++i) ac[i] = bias;
#pragma unroll
            for (int rr = 0; rr < 38; ++rr) { const unsigned v = *(const LAS unsigned*)(lds + (tb + rr) * 1024 + cp * 4); const f32x2 vv = (f32x2){bflo(v), bfhi(v)};
#pragma unroll
                for (int i = 0; i < 8; ++i) { const int j = rr - i; if (j >= 0 && j <= 30) ac[i] = __builtin_elementwise_fma(wv[j], vv, ac[i]); } }
#pragma unroll
            for (int i = 0; i < 8; ++i) *(LAS f32x2*)(lds + OFF_Y + (tb + i) * 2048 + cp * 8) = ac[i]; }
        LDS_BAR();
#pragma unroll
        for (int k = 0; k < 4; ++k) { const int tok = 4 * wave + k;
            f32x4 v0 = *(const LAS f32x4*)(lds + OFF_Y + tok * 2048 + lane * 16), v1 = *(const LAS f32x4*)(lds + OFF_Y + tok * 2048 + 1024 + lane * 16);
            const float mean = wave_sum((v0[0] + v0[1]) + (v0[2] + v0[3]) + (v1[0] + v1[1]) + (v1[2] + v1[3])) * (1.0f / 512.0f);
            v0 = v0 - mean; v1 = v1 - mean;
            const float var = wave_sum((v0[0] * v0[0] + v0[1] * v0[1]) + (v0[2] * v0[2] + v0[3] * v0[3]) + (v1[0] * v1[0] + v1[1] * v1[1]) + (v1[2] * v1[2] + v1[3] * v1[3])) * (1.0f / 512.0f);
            const float rstd = rsqrtf(var + NORM_EPS);
            v0 = v0 * rstd * g0 + b0; v1 = v1 * rstd * g1 + b1;
            u32x2 w0, w1; w0.x = pk2(v0[0] * sigm(v0[0]), v0[1] * sigm(v0[1])); w0.y = pk2(v0[2] * sigm(v0[2]), v0[3] * sigm(v0[3]));
            w1.x = pk2(v1[0] * sigm(v1[0]), v1[1] * sigm(v1[1])); w1.y = pk2(v1[2] * sigm(v1[2]), v1[3] * sigm(v1[3]));
            bf16_t* yp = Y + (size_t)(t0 + tok) * CC + 4 * lane; *(u32x2*)yp = w0; *(u32x2*)(yp + 256) = w1; }
        LDS_BAR();
    }
#undef CV_FETCH
}
}
__device__ __forceinline__ void transpose_item(const float* W, int K, int N, bf16_t* WT, int k0, int n0s, int n0d, const float* gain, LAS float* scr, int lane) {
    const int r8 = lane >> 3, c4 = (lane & 7) * 4;
    f32x4 v[8]; float gs[8];
#pragma unroll
    for (int i = 0; i < 8; ++i) { v[i] = *(const f32x4*)(W + (size_t)(k0 + 8 * i + r8) * N + n0s + c4); gs[i] = gain ? gain[k0 + 8 * i + r8] : 1.0f; }
#pragma unroll
    for (int i = 0; i < 8; ++i) { LAS float* d = scr + (8 * i + r8) * 33 + c4; d[0] = v[i][0] * gs[i]; d[1] = v[i][1] * gs[i]; d[2] = v[i][2] * gs[i]; d[3] = v[i][3] * gs[i]; }
    asm volatile("s_waitcnt lgkmcnt(0)" ::: "memory");
    const int c = lane & 7;
#pragma unroll
    for (int j = 0; j < 4; ++j) { const int n = (lane >> 3) + 8 * j; const LAS float* s = scr + (8 * c) * 33 + n;
        u32x4 o; o.x = pk2(s[0 * 33], s[1 * 33]); o.y = pk2(s[2 * 33], s[3 * 33]); o.z = pk2(s[4 * 33], s[5 * 33]); o.w = pk2(s[6 * 33], s[7 * 33]);
        *(u32x4*)(WT + (size_t)(n0d + n) * K + k0 + 8 * c) = o; }
    asm volatile("s_waitcnt lgkmcnt(0)" ::: "memory");
}
__device__ __forceinline__ int perm_in(int n0d) { const int pn = n0d >> 8, h = (n0d >> 7) & 1, j = n0d & 127; if (pn >= 5 && pn < 9) return (h ? 1792 : 1280) + 128 * (pn - 5) + j; return n0d; }
__device__ __forceinline__ int perm_gu(int n0d) { const int pn = n0d >> 8, h = (n0d >> 7) & 1, j = n0d & 127; return (h ? FF : 0) + 128 * pn + j; }

struct Args { const float* in[15]; float* out; unsigned char* ws; int ph_lo, ph_hi; };
enum { I_X = 0, I_NMIX, I_WIN, I_QN, I_KN, I_SINK, I_CW, I_CB, I_LG, I_LB, I_WPW, I_WOUT, I_NFFN, I_WGU, I_WDN };

__device__ __forceinline__ void convert_layer(const Args& a, int l, int slot, int nslots, LAS float* scr, int lane) {
    constexpr int I_IN = (D / 64) * (INW / 32), I_PW = (CC / 64) * (D / 32), I_OUT = (D / 64) * (D / 32), I_GU = (D / 64) * (GU / 32), I_DN = (FF / 64) * (D / 32), PER_L = I_IN + I_PW + I_OUT + I_GU + I_DN;
    unsigned char* wb = a.ws + WS_W + (size_t)l * W_LAYER;
    for (int it = slot; it < PER_L; it += nslots) {
        int r = it;
        if (r < I_IN) { const int nblk = INW / 32, kb = r / nblk, nb = r % nblk; transpose_item(a.in[I_WIN] + (size_t)l * D * INW, D, INW, (bf16_t*)(wb + WO_IN), 64 * kb, perm_in(32 * nb), 32 * nb, a.in[I_NMIX] + l * D, scr, lane); continue; } r -= I_IN;
        if (r < I_PW) { const int nblk = D / 32, kb = r / nblk, nb = r % nblk; transpose_item(a.in[I_WPW] + (size_t)l * CC * D, CC, D, (bf16_t*)(wb + WO_PW), 64 * kb, 32 * nb, 32 * nb, nullptr, scr, lane); continue; } r -= I_PW;
        if (r < I_OUT) { const int nblk = D / 32, kb = r / nblk, nb = r % nblk; transpose_item(a.in[I_WOUT] + (size_t)l * D * D, D, D, (bf16_t*)(wb + WO_OUT), 64 * kb, 32 * nb, 32 * nb, nullptr, scr, lane); continue; } r -= I_OUT;
        if (r < I_GU) { const int nblk = GU / 32, kb = r / nblk, nb = r % nblk; transpose_item(a.in[I_WGU] + (size_t)l * D * GU, D, GU, (bf16_t*)(wb + WO_GU), 64 * kb, perm_gu(32 * nb), 32 * nb, a.in[I_NFFN] + l * D, scr, lane); continue; } r -= I_GU;
        { const int nblk = D / 32, kb = r / nblk, nb = r % nblk; transpose_item(a.in[I_WDN] + (size_t)l * FF * D, FF, D, (bf16_t*)(wb + WO_DN), 64 * kb, 32 * nb, 32 * nb, nullptr, scr, lane); }
    }
}
__device__ __forceinline__ void prologue(const Args& a, LAS unsigned char* lds, int tid, int lane, int wave) {
    LAS float* scr = (LAS float*)(lds + wave * 16384);
    const int gw = blockIdx.x * 8 + wave, NGW = gridDim.x * 8;
    const int lw = gridDim.x == 256 ? 1 : DEPTH;
    for (int l = 0; l < lw; ++l) convert_layer(a, l, gw, NGW, scr, lane);
    float* ss = (float*)(a.ws + WS_SS); bf16_t* XB = (bf16_t*)(a.ws + WS_XB);
    unsigned char* LOA = (unsigned char*)a.out;
    for (int m = gw; m < M; m += NGW) { const f32x4* xr = (const f32x4*)(a.in[I_X] + (size_t)m * D) + lane; u32x2* xo = (u32x2*)(XB + (size_t)m * D) + lane; unsigned* lo = (unsigned*)(LOA + (size_t)m * D) + lane; float s = 0.f;
#pragma unroll
        for (int j = 0; j < 4; ++j) { const f32x4 v = xr[64 * j]; s += (v[0] * v[0] + v[1] * v[1]) + (v[2] * v[2] + v[3] * v[3]); u32x2 w; w.x = pk2(v[0], v[1]); w.y = pk2(v[2], v[3]); xo[64 * j] = w;
            lo[64 * j] = pg8::lo8_enc(v[0], w.x & 0xffffu) | (pg8::lo8_enc(v[1], w.x >> 16) << 8) | (pg8::lo8_enc(v[2], w.y & 0xffffu) << 16) | (pg8::lo8_enc(v[3], w.y >> 16) << 24); }
        s = wave_sum(s); if (lane < 16) ss[(size_t)m * 16 + lane] = lane == 0 ? s : 0.f; }
    float* rope = (float*)(a.ws + WS_ROPE);
    for (int i = blockIdx.x * 512 + tid; i < T * 8; i += gridDim.x * 512) { const int t = i >> 3, f = i & 7;
        double fr = 1.0; for (int k = 0; k < f; ++k) fr *= 0.19392274474868576;
        const float inv_freq = (float)fr; const float ang = (float)t * inv_freq;
        const double x = (double)ang, kq = __builtin_rint(x * 0.6366197723675814);
        const double r = __builtin_fma(-kq, 6.123233995736766e-17, __builtin_fma(-kq, 1.5707963267948966, x)), r2 = r * r;
        const double sp = r * (1.0 + r2 * (-1.0 / 6 + r2 * (1.0 / 120 + r2 * (-1.0 / 5040 + r2 * (1.0 / 362880 + r2 * (-1.0 / 39916800 + r2 * (1.0 / 6227020800.0)))))));
        const double cp = 1.0 + r2 * (-0.5 + r2 * (1.0 / 24 + r2 * (-1.0 / 720 + r2 * (1.0 / 40320 + r2 * (-1.0 / 3628800 + r2 * (1.0 / 479001600 + r2 * (-1.0 / 87178291200.0)))))));
        const int qd = ((int)kq) & 3;
        const double sn = qd == 0 ? sp : qd == 1 ? cp : qd == 2 ? -sp : -cp, cn = qd == 0 ? cp : qd == 1 ? -sp : qd == 2 ? -cp : sp;
        rope[t * 16 + f] = (float)cn; rope[t * 16 + 8 + f] = (float)sn; }
}

#define XB_TMO      128
#define XB_XCNT(j)  (256  + 64 * (j))
#define XB_XSUB(j)  (1280 + 64 * (j))
#define XB_XGEN(j)  (2304 + 64 * (j))
#define XB_TOP      3328
#define XB_TOPGEN   3392
#define XCD_BAR_WORDS 3456
#define XB_SPIN_CAP (1u << 18)

__device__ __forceinline__ unsigned xb_ld(unsigned* p)              { return __hip_atomic_load(p, __ATOMIC_RELAXED, __HIP_MEMORY_SCOPE_AGENT); }
__device__ __forceinline__ unsigned xb_add(unsigned* p, unsigned v) { return __hip_atomic_fetch_add(p, v, __ATOMIC_RELAXED, __HIP_MEMORY_SCOPE_AGENT); }
__device__ __forceinline__ unsigned xb_xcc_id() { return (unsigned)__builtin_amdgcn_s_getreg((3 << 11) | 20) & 0xFu; }
#define XB_SPIN(cond, bar) do { unsigned _sp = 0; while (cond) { __builtin_amdgcn_s_sleep(1); \
    if ((++_sp & 255u) == 0u) { if (xb_ld(&(bar)[XB_TMO])) break; if (_sp > XB_SPIN_CAP) { atomicAdd(&(bar)[XB_TMO], 1u); break; } } } } while (0)

struct XcdBarrier {
    unsigned* bar; unsigned x;
    volatile LAS unsigned* st;
};

__device__ __forceinline__ XcdBarrier xcd_barrier_post(unsigned* bar, volatile LAS unsigned* st) {
    XcdBarrier b; b.bar = bar; b.x = xb_xcc_id(); b.st = st;
    if (threadIdx.x == 0) (void)xb_add(&bar[XB_XCNT(b.x)], 1u);
    return b;
}
__device__ __forceinline__ void xcd_barrier_complete(unsigned* bar, unsigned x, unsigned& nloc, unsigned& nx) {
    const unsigned G = gridDim.x * gridDim.y * gridDim.z;
    unsigned sum, cnt, mine, sp = 0u;
    for (;;) {
        sum = 0u; cnt = 0u; mine = 0u;
#pragma unroll
        for (unsigned j = 0; j < 16; ++j) { const unsigned c = xb_ld(&bar[XB_XCNT(j)]); sum += c; cnt += (c > 0u) ? 1u : 0u; mine = (j == x) ? c : mine; }
        if (sum == G) break;
        __builtin_amdgcn_s_sleep(1);
        if ((++sp & 255u) == 0u) { if (xb_ld(&bar[XB_TMO])) break; if (sp > XB_SPIN_CAP) { atomicAdd(&bar[XB_TMO], 1u); break; } }
    }
    nloc = mine > 0u ? mine : 1u; nx = cnt > 0u ? cnt : 1u;
}

__device__ __forceinline__ void xcd_barrier(const XcdBarrier& b) {
    asm volatile("s_waitcnt vmcnt(0)" ::: "memory");
    __syncthreads();
    if (threadIdx.x == 0) {
        unsigned* bar = b.bar;
        __builtin_amdgcn_s_waitcnt(0);
        unsigned nloc = b.st[0], nx = b.st[1];
        if (nloc == 0u) { xcd_barrier_complete(bar, b.x, nloc, nx); b.st[0] = nloc; b.st[1] = nx; }
        const unsigned old = xb_add(&bar[XB_XSUB(b.x)], 1u);
        const unsigned gen = old / nloc;
        if (old + 1u == (gen + 1u) * nloc) {
            __builtin_amdgcn_fence(__ATOMIC_RELEASE, "agent");
            asm volatile("s_waitcnt vmcnt(0)" ::: "memory");
            const unsigned og = xb_add(&bar[XB_TOP], 1u);
            const unsigned tg = og / nx;
            if (og + 1u == (tg + 1u) * nx) xb_add(&bar[XB_TOPGEN], 1u);
            else XB_SPIN(xb_ld(&bar[XB_TOPGEN]) == tg, bar);
            __builtin_amdgcn_fence(__ATOMIC_ACQUIRE, "agent");
            xb_add(&bar[XB_XGEN(b.x)], 1u);
            asm volatile("s_waitcnt vmcnt(0)" ::: "memory");
        } else {
            XB_SPIN(xb_ld(&bar[XB_XGEN(b.x)]) == gen, bar);
            __builtin_amdgcn_fence(__ATOMIC_ACQUIRE, "agent");
            asm volatile("s_waitcnt vmcnt(0)" ::: "memory");
        }
    }
    __syncthreads();
}

#ifndef PROBE
#define PROBE 0
#endif
#define tsb ((LAS unsigned long long*)(lds + 131072))
#ifndef PROBE_A
#define PROBE_A 2
#endif
#ifndef PROBE_B
#define PROBE_B 3
#endif
#ifndef PROBE_SA
#define PROBE_SA 0.01f
#endif
#ifndef PROBE_SB
#define PROBE_SB 0.01f
#endif
constexpr int N_PHASES = 1 + 6 * DEPTH;
__global__ void __launch_bounds__(512, 2) fwd_kernel(Args a) {
    extern __shared__ __attribute__((aligned(16))) unsigned char lds_raw[];
    LAS unsigned char* lds = (LAS unsigned char*)lds_raw;
    cg::grid_group grid = cg::this_grid();
    volatile LAS unsigned* bst = (volatile LAS unsigned*)(lds + 131072 + 768);
    if (threadIdx.x < 2) bst[threadIdx.x] = 0u;
    __syncthreads();
    const XcdBarrier xbar = xcd_barrier_post((unsigned*)(a.ws + WS_BAR), bst);
    const int G = gridDim.x, bx = blockIdx.x;
    unsigned char* ws = a.ws;
    float* ss = (float*)(ws + WS_SS); const float* rope = (const float*)(ws + WS_ROPE);
    bf16_t* XB = (bf16_t*)(ws + WS_XB); bf16_t* QO = (bf16_t*)(ws + WS_QO); bf16_t* KV = (bf16_t*)(ws + WS_KV); bf16_t* AB = (bf16_t*)(ws + WS_A);
    bf16_t* GB = (bf16_t*)(ws + WS_G); bf16_t* YB = (bf16_t*)(ws + WS_Y); bf16_t* ACT = (bf16_t*)(ws + WS_ACT);
#pragma unroll 1
    for (int ph = a.ph_lo; ph < a.ph_hi; ++ph) {
        if (ph > a.ph_lo) { if (a.ph_hi < 0) grid.sync(); else xcd_barrier(xbar); }
        int tid_l = threadIdx.x; asm volatile("" : "+v"(tid_l));
#if PROBE
        if (threadIdx.x == 0) tsb[ph] = __builtin_amdgcn_s_memrealtime();
#endif
        const int tid = tid_l, lane = tid & 63, wave = __builtin_amdgcn_readfirstlane(tid >> 6);
        if (ph == 0) { prologue(a, lds, tid, lane, wave); continue; }
        const int l = (ph - 1) / 6, s = (ph - 1) % 6;
        const unsigned char* wb = ws + WS_W + (size_t)l * W_LAYER;
        if (s == 0) {
            pg8::Gemm g{XB, (const bf16_t*)(wb + WO_IN), M, INW, D}; pg8::StaticOrder S; S.init(M, INW, G, bx);
            pg8::EpiIn E{QO, KV, AB, GB, ss};
            pg8::gemm_phase<pg8::EpiIn, pg8::StaticOrder, true, true>(lds, g, S, E);
            if (G == 256 && bx >= 128 && l + 1 < DEPTH) convert_layer(a, l + 1, (bx - 128) * 8 + wave, 128 * 8, (LAS float*)(lds + wave * 16384), lane);
        } else if (s == 1) {
            for (int u = bx; u < NB * 2 * (T / 128); u += G) { const int blk = u & 63, kvh = (u >> 6) & 1, b = u >> 7;
                att::unit(lds, b, kvh, blk, QO, KV, GB, a.in[I_QN] + l * 64, a.in[I_KN] + l * 64, a.in[I_SINK] + l * NHEAD, rope, tid, lane, wave); }
#if PROBE
            if (threadIdx.x == 0) tsb[32 + l] = __builtin_amdgcn_s_memrealtime();
#endif
            cv::phase(lds, bx, G, AB, YB, a.in[I_CW] + (size_t)l * 31 * CC, a.in[I_CB] + l * CC, a.in[I_LG] + l * CC, a.in[I_LB] + l * CC, tid, lane, wave);
        } else if (s == 2) {
            pg8::Gemm g{YB, (const bf16_t*)(wb + WO_PW), M, D, CC}; pg8::StaticOrder S; S.init(M, D, G, bx);
            pg8::EpiMerge E{QO, GB};
            pg8::gemm_phase<pg8::EpiMerge, pg8::StaticOrder, true, true>(lds, g, S, E);
        } else if (s == 3) {
            pg8::Gemm g{QO, (const bf16_t*)(wb + WO_OUT), M, D, D}; pg8::StaticOrder S; S.init(M, D, G, bx);
            pg8::EpiRes E{(const unsigned char*)a.out, (unsigned char*)(ws + WS_LOB), XB, a.out, ss + (size_t)M * 16, 1};
            pg8::gemm_phase<pg8::EpiRes, pg8::StaticOrder, true, true>(lds, g, S, E);
        } else if (s == 4) {
            pg8::Gemm g{XB, (const bf16_t*)(wb + WO_GU), M, GU, D}; pg8::StaticOrder S; S.init(M, GU, G, bx);
            pg8::EpiSwiglu E{ACT, ss + (size_t)M * 16};
            pg8::gemm_phase<pg8::EpiSwiglu, pg8::StaticOrder, true, true>(lds, g, S, E);
        } else {
            pg8::Gemm g{ACT, (const bf16_t*)(wb + WO_DN), M, D, FF}; pg8::StaticOrder S; S.init(M, D, G, bx);
            pg8::EpiRes E{(const unsigned char*)(ws + WS_LOB), (unsigned char*)a.out, XB, a.out, ss, l + 1 < DEPTH ? 1 : 0};
            pg8::gemm_phase<pg8::EpiRes, pg8::StaticOrder, true, true>(lds, g, S, E);
        }
    }
#if PROBE
    if (bx == 0) {
        LAS float* pv = (LAS float*)(lds + 131072 + 512);
        if (threadIdx.x == 0) { tsb[N_PHASES] = __builtin_amdgcn_s_memrealtime();
            unsigned long long sa = 0, sb = 0;
#pragma unroll 1
            for (int l = 0; l < DEPTH; ++l) { const int b = 1 + 6 * l;
                const unsigned long long d1 = tsb[b + 1] - tsb[b], d2 = tsb[32 + l] - tsb[b + 1], d3 = tsb[b + 2] - tsb[32 + l], d4 = tsb[b + 3] - tsb[b + 2], d5 = tsb[b + 4] - tsb[b + 3], d6 = tsb[b + 5] - tsb[b + 4], d7 = tsb[b + 6] - tsb[b + 5];
                sa += PROBE_A == 1 ? d1 : PROBE_A == 2 ? d2 : PROBE_A == 3 ? d3 : PROBE_A == 4 ? d4 : PROBE_A == 5 ? d5 : PROBE_A == 6 ? d6 : PROBE_A == 7 ? d7 : 0;
                sb += PROBE_B == 1 ? d1 : PROBE_B == 2 ? d2 : PROBE_B == 3 ? d3 : PROBE_B == 4 ? d4 : PROBE_B == 5 ? d5 : PROBE_B == 6 ? d6 : PROBE_B == 7 ? d7 : 0; }
            if (PROBE_A == 0) sa = tsb[1] - tsb[0]; if (PROBE_B == 0) sb = tsb[1] - tsb[0];
            pv[0] = (float)sa * 0.01f * PROBE_SA; pv[1] = PROBE_B == 8 ? 20.0f : (float)sb * 0.01f * PROBE_SB; }
        __syncthreads();
        if (threadIdx.x == 0) a.out[0] += pv[0];
        if (PROBE_B >= 0) for (int i = threadIdx.x + 512; i < 65536; i += 512) a.out[(size_t)(i >> 8) * 1024 + (i & 255)] += pv[1] * 0.0625f;
    }
#endif
}

#ifndef MK_PER_PHASE
#define MK_PER_PHASE 0
#endif
extern "C" void kernel_launch(void* const* d_in, const int* in_sizes, int n_in, void* d_out, int out_size, void* d_ws, size_t ws_size, hipStream_t stream) {
    static int grid = 0;
    if (grid == 0) {
        if (n_in != 15 || in_sizes[0] != M * D || out_size != M * D || ws_size < WS_END) { fprintf(stderr, "kernel_launch: unexpected shapes / workspace (n_in %d, ws %zu)\n", n_in, ws_size); grid = -1; return; }
        int dev = 0, cus = 0, per_cu = 0;
        (void)hipGetDevice(&dev); (void)hipDeviceGetAttribute(&cus, hipDeviceAttributeMultiprocessorCount, dev);
        if (hipFuncSetAttribute((const void*)fwd_kernel, hipFuncAttributeMaxDynamicSharedMemorySize, LDS_BYTES) != hipSuccess) { fprintf(stderr, "kernel_launch: hipFuncSetAttribute failed\n"); grid = -1; return; }
        if (hipOccupancyMaxActiveBlocksPerMultiprocessor(&per_cu, (const void*)fwd_kernel, 512, LDS_BYTES) != hipSuccess || per_cu < 1) { fprintf(stderr, "kernel_launch: occupancy query says %d\n", per_cu); per_cu = 1; }
        (void)hipGetLastError();
        grid = cus * per_cu;
    }
    if (grid < 0) return;
    if (hipMemsetAsync((char*)d_ws + WS_BAR, 0, 16384, stream) != hipSuccess) { fprintf(stderr, "kernel_launch: memset of the barrier words failed\n"); return; }
    Args a{};
    for (int i = 0; i < 15; ++i) a.in[i] = (const float*)d_in[i];
    a.out = (float*)d_out; a.ws = (unsigned char*)d_ws;
#if MK_PER_PHASE
    for (int ph = 0; ph < N_PHASES; ++ph) { a.ph_lo = ph; a.ph_hi = ph + 1; hipLaunchKernelGGL(fwd_kernel, dim3(grid), dim3(512), LDS_BYTES, stream, a); }
#else
    a.ph_lo = 0; a.ph_hi = N_PHASES;
    void* args[] = {&a};
    hipError_t e = hipLaunchCooperativeKernel((const void*)fwd_kernel, dim3(grid), dim3(512), args, LDS_BYTES, stream);
    if (e != hipSuccess) fprintf(stderr, "cooperative launch failed: %s (grid %d)\n", hipGetErrorString(e), grid);
#endif
}
```
